# Optimizing an MI355X kernel written in HIP

```python
import math
import jax, jax.numpy as jnp
from jax import lax
import numpy as np

D_MODEL = 1024
BATCH = 4
SEQ = 4096
DEPTH = 1

M_HEADS = 4
M_HEAD_DIM = D_MODEL // (2 * M_HEADS)
M_CHUNK = 64
CONV_W = 4
A_HEADS = 8
A_KV_GROUPS = 2
A_HPG = A_HEADS // A_KV_GROUPS
A_HEAD_DIM = D_MODEL // (2 * A_HEADS)
CMP_BLOCK = 32
CMP_STRIDE = 16
SEL_BLOCK = 64
SEL_TOP_N = 16
WINDOW = 512
Q_BLOCK = 128
FORCED_BONUS = 1e3
NUM_BUCKETS = 32
MAX_DISTANCE = 128
N_EXPERTS = 32
TOP_K = 4
D_EXPERT = D_MODEL
SWIGLU_LIMIT = 7.0
SWIGLU_ALPHA = 1.702
EXPERT_ROWS = 128
EPS = 1e-6
D_MIX = M_HEADS * M_HEAD_DIM + A_HEADS * A_HEAD_DIM
SPLIT_SIZES = (
    M_HEADS * M_HEAD_DIM,
    M_HEADS * M_HEAD_DIM,
    M_HEADS * M_HEAD_DIM,
    M_HEADS * M_HEAD_DIM,
    M_HEADS,
    M_HEADS,
    A_HEADS * A_HEAD_DIM,
    A_KV_GROUPS * A_HEAD_DIM,
    A_KV_GROUPS * A_HEAD_DIM,
    A_KV_GROUPS * A_HEAD_DIM,
    A_KV_GROUPS * A_HEAD_DIM,
    A_KV_GROUPS * A_HEAD_DIM,
    A_KV_GROUPS * A_HEAD_DIM,
    A_HEADS * 3,
)
D_IN = sum(SPLIT_SIZES)

kernel_name = "hybrid_mlstm_nsa_moe_block"


def rmsnorm(x, g):
    xf = x.astype(jnp.float32)
    y = xf * lax.rsqrt(jnp.mean(xf * xf, axis=-1, keepdims=True) + EPS)
    return (y * g.astype(jnp.float32)).astype(x.dtype)


def t5_bucket(dist):
    n = jnp.maximum(dist, 0)
    max_exact = NUM_BUCKETS // 2
    nf = jnp.maximum(n, 1).astype(jnp.float32)
    large = max_exact + (jnp.log(nf / max_exact) / math.log(MAX_DISTANCE / max_exact)
                         * (NUM_BUCKETS - max_exact)).astype(jnp.int32)
    large = jnp.minimum(large, NUM_BUCKETS - 1)
    return jnp.where(n < max_exact, n, large)


def masked_softmax(logits, valid):
    l = jnp.where(valid, logits, -jnp.inf)
    m = jnp.max(l, axis=-1, keepdims=True)
    m = jnp.where(jnp.isfinite(m), m, 0.0)
    e = jnp.where(valid, jnp.exp(l - m), 0.0)
    s = jnp.sum(e, axis=-1, keepdims=True)
    return e / jnp.where(s > 0, s, 1.0)


def causal_depthwise_conv(x, w):
    return lax.conv_general_dilated(
        x, w[:, None, :].astype(x.dtype), window_strides=(1,), padding=[(CONV_W - 1, 0)],
        dimension_numbers=('NWC', 'WIO', 'NWC'), feature_group_count=x.shape[-1])


def mlstm(q, k, v, i_pre, f_pre):
    dtype = q.dtype
    B_, S_, H_, Dh = q.shape
    nc = S_ // M_CHUNK
    f32 = jnp.float32

    def chunks(a):
        return a.astype(f32).reshape(B_, nc, M_CHUNK, H_, -1).transpose(0, 3, 1, 2, 4)

    qc = chunks(q)
    kc = chunks(k) * (Dh ** -0.5)
    vc = chunks(v)
    ig = i_pre.astype(f32).reshape(B_, nc, M_CHUNK, H_).transpose(0, 3, 1, 2)
    lf = jax.nn.log_sigmoid(f_pre.astype(f32)).reshape(B_, nc, M_CHUNK, H_).transpose(0, 3, 1, 2)
    g = jnp.cumsum(lf, axis=-1)
    G = g[..., -1]
    w_state = G[..., None] - g + ig

    def step(carry, xs):
        C, n, m = carry
        k_c, v_c, w_c, G_c = xs
        m_new = jnp.maximum(G_c + m, jnp.max(w_c, axis=-1))
        decay = jnp.exp(G_c + m - m_new)
        wexp = jnp.exp(w_c - m_new[..., None])
        C_new = decay[..., None, None] * C + jnp.einsum('bhl,bhld,bhle->bhde', wexp, k_c, v_c)
        n_new = decay[..., None] * n + jnp.einsum('bhl,bhld->bhd', wexp, k_c)
        return (C_new, n_new, m_new), (C, n, m)

    init = (jnp.zeros((B_, H_, Dh, Dh), f32), jnp.zeros((B_, H_, Dh), f32),
            jnp.full((B_, H_), -jnp.inf, f32))
    xs = (kc.transpose(2, 0, 1, 3, 4), vc.transpose(2, 0, 1, 3, 4),
          w_state.transpose(2, 0, 1, 3), G.transpose(2, 0, 1))
    _, (Cp, Np, Mp) = lax.scan(step, init, xs)
    Cp = Cp.transpose(1, 2, 0, 3, 4)
    Np = Np.transpose(1, 2, 0, 3)
    Mp = Mp.transpose(1, 2, 0)

    causal = jnp.tril(jnp.ones((M_CHUNK, M_CHUNK), bool))
    Dm = jnp.where(causal, g[..., :, None] - g[..., None, :] + ig[..., None, :], -jnp.inf)
    inter = g + Mp[..., None]
    m_tau = jnp.maximum(inter, jnp.max(Dm, axis=-1))
    Wm = jnp.exp(Dm - m_tau[..., None]) * jnp.einsum('bhcld,bhcsd->bhcls', qc, kc)
    inter_w = jnp.exp(inter - m_tau)
    num = (jnp.einsum('bhcls,bhcse->bhcle', Wm, vc)
           + inter_w[..., None] * jnp.einsum('bhcld,bhcde->bhcle', qc, Cp))
    den = jnp.sum(Wm, axis=-1) + inter_w * jnp.einsum('bhcld,bhcd->bhcl', qc, Np)
    h = num / jnp.maximum(jnp.abs(den), jnp.exp(-m_tau))[..., None]
    return h.transpose(0, 2, 3, 1, 4).reshape(B_, S_, H_ * Dh).astype(dtype)


def compress(k, pos_emb, w):
    S_ = k.shape[1]
    n_cmp = (S_ - CMP_BLOCK) // CMP_STRIDE + 1
    idx = jnp.arange(n_cmp)[:, None] * CMP_STRIDE + jnp.arange(CMP_BLOCK)[None, :]
    blocks = k[:, idx] + pos_emb[None, None, :, None, :]
    return jnp.einsum('bilgd,lde->bige', blocks, w)


def nsa(q, kc, vc, ks, vs, kw, vw, gates, rel_bias):
    B_, S_, G_, HPG_, Dh = q.shape
    scale = Dh ** -0.5
    f32 = jnp.float32
    n_cmp = kc.shape[1]
    n_sel = S_ // SEL_BLOCK
    top_n = min(SEL_TOP_N, n_sel)
    n_tok = top_n * SEL_BLOCK
    cmp_end = jnp.arange(n_cmp) * CMP_STRIDE + CMP_BLOCK - 1
    cmp_pos = jnp.arange(n_cmp)[:, None] * CMP_STRIDE + jnp.arange(CMP_BLOCK)[None, :]
    overlap = jnp.sum(jax.nn.one_hot(cmp_pos // SEL_BLOCK, n_sel, dtype=f32), axis=1) / CMP_BLOCK
    ks_blk = ks.reshape(B_, n_sel, SEL_BLOCK, G_, Dh).transpose(0, 3, 1, 2, 4).reshape(B_, G_, n_sel, SEL_BLOCK * Dh)
    vs_blk = vs.reshape(B_, n_sel, SEL_BLOCK, G_, Dh).transpose(0, 3, 1, 2, 4).reshape(B_, G_, n_sel, SEL_BLOCK * Dh)
    kw_pad = jnp.pad(kw, ((0, 0), (WINDOW, 0), (0, 0), (0, 0)))
    vw_pad = jnp.pad(vw, ((0, 0), (WINDOW, 0), (0, 0), (0, 0)))
    rb = rel_bias.reshape(NUM_BUCKETS, G_, HPG_)
    g_idx = jnp.arange(G_)[None, None, :, None]
    blk = jnp.arange(n_sel)
    sel_off = jnp.arange(SEL_BLOCK)
    win_off = jnp.arange(Q_BLOCK + WINDOW) - WINDOW

    def block(qb):
        q0 = qb * Q_BLOCK
        t = q0 + jnp.arange(Q_BLOCK)
        qq = lax.dynamic_slice_in_dim(q, q0, Q_BLOCK, axis=1)
        lc = jnp.einsum('bqghd,bigd->bqghi', qq, kc, preferred_element_type=f32) * scale
        lc = lc + rb[t5_bucket(t[:, None] - cmp_end[None, :])].transpose(0, 2, 3, 1)[None]
        valid_c = (cmp_end[None, :] <= t[:, None])[None, :, None, None, :]
        pc = masked_softmax(lc, valid_c)
        oc = jnp.einsum('bqghi,bigd->bqghd', pc, vc)
        ps = jnp.einsum('bqghi,ij->bqgj', pc, overlap)
        cur = t // SEL_BLOCK
        forced = (blk[None, :] == 0) | (blk[None, :] == cur[:, None]) | (blk[None, :] == cur[:, None] - 1)
        valid_b = blk[None, :] * SEL_BLOCK <= t[:, None]
        score = jnp.where(valid_b[None, :, None, :],
                          ps + jnp.where(forced, FORCED_BONUS, 0.0)[None, :, None, :], -jnp.inf)
        _, sel = lax.top_k(score, top_n)
        sel_t = sel.transpose(0, 2, 1, 3).reshape(B_, G_, Q_BLOCK * top_n)[..., None]
        kg = jnp.take_along_axis(ks_blk, sel_t, axis=2).reshape(B_, G_, Q_BLOCK, n_tok, Dh)
        vg = jnp.take_along_axis(vs_blk, sel_t, axis=2).reshape(B_, G_, Q_BLOCK, n_tok, Dh)
        tok = (sel[..., None] * SEL_BLOCK + sel_off).reshape(B_, Q_BLOCK, G_, n_tok)
        ls = jnp.einsum('bqghd,bgqnd->bqghn', qq, kg, preferred_element_type=f32) * scale
        bs = rb[t5_bucket(t[None, :, None, None] - tok), g_idx]
        ls = ls + bs.transpose(0, 1, 2, 4, 3)
        pss = masked_softmax(ls, (tok <= t[None, :, None, None])[:, :, :, None, :])
        osel = jnp.einsum('bqghn,bgqnd->bqghd', pss, vg)
        kwb = lax.dynamic_slice_in_dim(kw_pad, q0, Q_BLOCK + WINDOW, axis=1)
        vwb = lax.dynamic_slice_in_dim(vw_pad, q0, Q_BLOCK + WINDOW, axis=1)
        j = q0 + win_off
        dist = t[:, None] - j[None, :]
        valid_w = (j[None, :] >= 0) & (dist >= 0) & (dist < WINDOW)
        lw = jnp.einsum('bqghd,bkgd->bqghk', qq, kwb, preferred_element_type=f32) * scale
        lw = lw + rb[t5_bucket(dist)].transpose(0, 2, 3, 1)[None]
        pw = masked_softmax(lw, valid_w[None, :, None, None, :])
        ow = jnp.einsum('bqghk,bkgd->bqghd', pw, vwb)
        gg = lax.dynamic_slice_in_dim(gates, q0, Q_BLOCK, axis=1).astype(f32)
        o = gg[..., 0:1] * oc + gg[..., 1:2] * osel + gg[..., 2:3] * ow
        return o.reshape(B_, Q_BLOCK, G_ * HPG_ * Dh).astype(q.dtype)

    out = lax.map(block, jnp.arange(S_ // Q_BLOCK))
    return out.transpose(1, 0, 2, 3).reshape(B_, S_, G_ * HPG_ * Dh)


def moe(h, w_router, b_router, w_up, b_up, w_down, b_down):
    B_, S_, D_ = h.shape
    N = B_ * S_
    NK = N * TOP_K
    xf = h.reshape(N, D_)
    logits = jnp.dot(xf, w_router, preferred_element_type=jnp.float32) + b_router.astype(jnp.float32)
    vals, idx = lax.top_k(logits, TOP_K)
    gate = jax.nn.softmax(vals, axis=-1)
    e_flat = idx.reshape(NK)
    tok_flat = jnp.arange(NK) // TOP_K
    gate_flat = gate.reshape(NK)
    order = jnp.argsort(e_flat)
    sorted_e = e_flat[order]
    counts = jnp.bincount(e_flat, length=N_EXPERTS)
    starts = jnp.cumsum(counts) - counts
    padded = (counts + EXPERT_ROWS - 1) // EXPERT_ROWS * EXPERT_ROWS
    pends = jnp.cumsum(padded)
    pstarts = pends - padded
    dest = pstarts[sorted_e] + (jnp.arange(NK) - starts[sorted_e])
    R = NK + N_EXPERTS * EXPERT_ROWS
    n_blk = R // EXPERT_ROWS
    row_tok = jnp.full((R,), N, jnp.int32).at[dest].set(tok_flat[order])
    row_gate = jnp.zeros((R,), jnp.float32).at[dest].set(gate_flat[order])
    blk_e = jnp.minimum(jnp.sum(jnp.arange(n_blk)[:, None] * EXPERT_ROWS >= pends[None, :], axis=1),
                        N_EXPERTS - 1)
    x_pad = jnp.concatenate([xf, jnp.zeros((1, D_), xf.dtype)], axis=0)
    xin = x_pad[row_tok].reshape(n_blk, EXPERT_ROWS, D_)

    def expert_block(args):
        xb, eb = args
        up = jnp.dot(xb, w_up[eb]) + b_up[eb]
        glu, lin = jnp.split(up, 2, axis=-1)
        glu = jnp.minimum(glu, SWIGLU_LIMIT)
        lin = jnp.clip(lin, -SWIGLU_LIMIT, SWIGLU_LIMIT)
        act = glu * jax.nn.sigmoid(SWIGLU_ALPHA * glu) * (lin + 1.0)
        return jnp.dot(act, w_down[eb]) + b_down[eb]

    yb = lax.map(expert_block, (xin, blk_e)).reshape(R, D_)
    out = jnp.zeros((N + 1, D_), h.dtype).at[row_tok].add(yb * row_gate[:, None].astype(h.dtype))
    return out[:N].reshape(B_, S_, D_)


def setup_inputs(seed: int = 0) -> dict:
    key = jax.random.key(seed)
    ks = jax.random.split(key, 24)
    nrm = lambda k, shape, s: jax.random.normal(k, shape, jnp.float32) * s
    L = DEPTH
    gate_base = jnp.concatenate([jnp.zeros((M_HEADS,), jnp.float32),
                                 jnp.linspace(3.0, 6.0, M_HEADS, dtype=jnp.float32)])
    return {
        "x": nrm(ks[0], (BATCH, SEQ, D_MODEL), 1.0),
        "c": nrm(ks[1], (BATCH, D_MODEL), 1.0),
        "w_ada": nrm(ks[2], (L, D_MODEL, 6 * D_MODEL), 0.5 * D_MODEL ** -0.5),
        "b_ada": nrm(ks[3], (L, 6 * D_MODEL), 0.02),
        "g_pre_mix": 1.0 + nrm(ks[4], (L, D_MODEL), 0.05),
        "g_post_mix": 1.0 + nrm(ks[5], (L, D_MODEL), 0.05),
        "g_pre_ffn": 1.0 + nrm(ks[6], (L, D_MODEL), 0.05),
        "g_post_ffn": 1.0 + nrm(ks[7], (L, D_MODEL), 0.05),
        "w_in": nrm(ks[8], (L, D_MODEL, D_IN), D_MODEL ** -0.5),
        "b_gates": gate_base + nrm(ks[9], (L, 2 * M_HEADS), 0.1),
        "conv_qk": nrm(ks[10], (L, CONV_W, 2 * M_HEADS * M_HEAD_DIM), CONV_W ** -0.5),
        "w_cmp_k": nrm(ks[11], (L, CMP_BLOCK, A_HEAD_DIM, A_HEAD_DIM), (CMP_BLOCK * A_HEAD_DIM) ** -0.5),
        "w_cmp_v": nrm(ks[12], (L, CMP_BLOCK, A_HEAD_DIM, A_HEAD_DIM), (CMP_BLOCK * A_HEAD_DIM) ** -0.5),
        "pos_cmp_k": nrm(ks[13], (L, CMP_BLOCK, A_HEAD_DIM), 0.1),
        "pos_cmp_v": nrm(ks[14], (L, CMP_BLOCK, A_HEAD_DIM), 0.1),
        "rel_bias": nrm(ks[15], (NUM_BUCKETS, A_HEADS), 0.5),
        "w_out": nrm(ks[16], (L, D_MIX, D_MODEL), D_MIX ** -0.5),
        "w_router": nrm(ks[17], (L, D_MODEL, N_EXPERTS), D_MODEL ** -0.5),
        "b_router": nrm(ks[18], (L, N_EXPERTS), 0.01),
        "w_up": nrm(ks[19], (L, N_EXPERTS, D_MODEL, 2 * D_EXPERT), D_MODEL ** -0.5),
        "b_up": nrm(ks[20], (L, N_EXPERTS, 2 * D_EXPERT), 0.01),
        "w_down": nrm(ks[21], (L, N_EXPERTS, D_EXPERT, D_MODEL), D_EXPERT ** -0.5),
        "b_down": nrm(ks[22], (L, N_EXPERTS, D_MODEL), 0.01),
    }


def reference(x, c, w_ada, b_ada, g_pre_mix, g_post_mix, g_pre_ffn, g_post_ffn, w_in, b_gates,
              conv_qk, w_cmp_k, w_cmp_v, pos_cmp_k, pos_cmp_v, rel_bias, w_out, w_router, b_router,
              w_up, b_up, w_down, b_down):
    B_, S_, _ = x.shape
    split_at = np.cumsum(SPLIT_SIZES)[:-1].tolist()
    for l in range(DEPTH):
        mod = jnp.dot(jax.nn.silu(c), w_ada[l]) + b_ada[l]
        sh1, sc1, gt1, sh2, sc2, gt2 = [m[:, None, :] for m in jnp.split(mod, 6, axis=-1)]
        h = rmsnorm(x, g_pre_mix[l]) * (1.0 + sc1) + sh1
        z = jnp.dot(h, w_in[l])
        (q_m, k_m, v_m, o_m, i_m, f_m, q_a, kc_a, vc_a, ks_a, vs_a, kw_a, vw_a, g_a) = \
            jnp.split(z, split_at, axis=-1)
        qk = jax.nn.silu(causal_depthwise_conv(jnp.concatenate([q_m, k_m], axis=-1), conv_qk[l]))
        q_m, k_m = jnp.split(qk, 2, axis=-1)
        mh = lambda a: a.reshape(B_, S_, M_HEADS, M_HEAD_DIM)
        y_m = mlstm(mh(q_m), mh(k_m), mh(v_m),
                    i_m + b_gates[l, :M_HEADS], f_m + b_gates[l, M_HEADS:])
        y_m = y_m * jax.nn.sigmoid(o_m)
        kv = lambda a: a.reshape(B_, S_, A_KV_GROUPS, A_HEAD_DIM)
        kc = compress(kv(kc_a), pos_cmp_k[l], w_cmp_k[l])
        vc = compress(kv(vc_a), pos_cmp_v[l], w_cmp_v[l])
        y_a = nsa(q_a.reshape(B_, S_, A_KV_GROUPS, A_HPG, A_HEAD_DIM), kc, vc,
                  kv(ks_a), kv(vs_a), kv(kw_a), kv(vw_a),
                  jax.nn.sigmoid(g_a).reshape(B_, S_, A_KV_GROUPS, A_HPG, 3), rel_bias)
        y = jnp.dot(jnp.concatenate([y_m, y_a], axis=-1), w_out[l])
        x = x + gt1 * rmsnorm(y, g_post_mix[l])
        h2 = rmsnorm(x, g_pre_ffn[l]) * (1.0 + sc2) + sh2
        y2 = moe(h2, w_router[l], b_router[l], w_up[l], b_up[l], w_down[l], b_down[l])
        x = x + gt2 * rmsnorm(y2, g_post_ffn[l])
    return x
```

```cpp
#include <hip/hip_runtime.h>
#include <cstdio>
#include <cstdint>
#include <cmath>

#define GAS __attribute__((address_space(1)))
#define LAS __attribute__((address_space(3)))
typedef unsigned short bf16;
typedef short bf16x8 __attribute__((ext_vector_type(8)));
typedef short s16x4 __attribute__((ext_vector_type(4)));
typedef float f32x4 __attribute__((ext_vector_type(4)));
typedef float f32x2 __attribute__((ext_vector_type(2)));
typedef float f32x16 __attribute__((ext_vector_type(16)));
typedef unsigned u32x4 __attribute__((ext_vector_type(4)));
typedef unsigned u32x2 __attribute__((ext_vector_type(2)));

#ifndef MK_PER_PHASE
#define MK_PER_PHASE 0
#endif

constexpr int BATCH = 4, SEQ = 4096, D = 1024, M = BATCH * SEQ;
constexpr int D_IN = 3360, ZP = 3584;
constexpr int ZC_QM = 0, ZC_KM = 512, ZC_VM = 1024, ZC_OM = 1536, ZC_QA = 2048, ZC_KC = 2560, ZC_VC = 2688, ZC_KS = 2816, ZC_VS = 2944,
              ZC_KW = 3072, ZC_VW = 3200, ZC_IG = 3328, ZC_FG = 3332, ZC_GA = 3336;
constexpr int NEXP = 32, TOPK = 4, ECAP = 16384, MAXT = 288;
constexpr float EPS = 1e-6f;
constexpr int NWAVES = 8, NTHR = 512;

constexpr size_t MiB = 1u << 20;
constexpr size_t WS_CTL = 0, CTL_ZERO_BYTES = 1 * MiB;
constexpr size_t WS_MODP = 1 * MiB;
constexpr size_t WS_MODF = 2 * MiB;
constexpr size_t WS_CMPB = 2 * MiB + 128 * 1024;
constexpr size_t WS_WCMP = 3 * MiB;
constexpr size_t WS_WIN = 4 * MiB;
constexpr size_t WS_WOUT = 12 * MiB;
constexpr size_t WS_WRT = 14 * MiB;
constexpr size_t WS_WUP = 16 * MiB;
constexpr size_t WS_WDN = 144 * MiB;
constexpr size_t WS_H = 208 * MiB;
constexpr size_t WS_Z = 240 * MiB;
constexpr size_t WS_YMIX = 352 * MiB;
constexpr size_t WS_Y = 384 * MiB;
constexpr size_t WS_DC = 416 * MiB;
constexpr size_t WS_DN = 480 * MiB;
constexpr size_t WS_SC = 481 * MiB;
constexpr size_t WS_KC = 482 * MiB;
constexpr size_t WS_VC = 483 * MiB;
constexpr size_t WS_ACT = 484 * MiB;
constexpr size_t WS_YB = 628 * MiB;
constexpr size_t WS_TOKE = 772 * MiB;
constexpr size_t WS_TOKR = 772 * MiB + 256 * 1024;
constexpr size_t WS_TOKG = 772 * MiB + 512 * 1024;
constexpr size_t WS_ROWTOK = 774 * MiB;
constexpr size_t WS_CP = 776 * MiB;
constexpr size_t WS_NP = 840 * MiB;
constexpr size_t WS_END = 841 * MiB;
constexpr int CW_TMO = 0, CW_BAR = 4096, CW_CNT = 16384;

constexpr int RING_BYTES = 131072;
constexpr int LDSCTL_OFF = RING_BYTES, MISC_OFF = LDSCTL_OFF + 320;
constexpr int TAB_OFF = LDSCTL_OFF + 1024;
constexpr int LDS_BYTES = 163840;

#define RLX_AGENT __ATOMIC_RELAXED, __HIP_MEMORY_SCOPE_AGENT
__device__ __forceinline__ float bf2f(unsigned v) { return __uint_as_float(v << 16); }
__device__ __forceinline__ unsigned f2bf(float f) { unsigned u = __float_as_uint(f); return (u + 0x7fffu + ((u >> 16) & 1u)) >> 16; }
__device__ __forceinline__ unsigned pk2(float lo, float hi) { unsigned r; asm volatile("v_cvt_pk_bf16_f32 %0, %1, %2" : "=v"(r) : "v"(lo), "v"(hi)); return r; }
__device__ __forceinline__ unsigned pk4_fp8(float a, float b, float c, float d) { int w = 0; w = __builtin_amdgcn_cvt_pk_fp8_f32(a, b, w, false); w = __builtin_amdgcn_cvt_pk_fp8_f32(c, d, w, true); return (unsigned)w; }
template <int MASK> __device__ __forceinline__ float xchg_f(float x, int lane) {
    if constexpr (MASK == 1) return __int_as_float(__builtin_amdgcn_mov_dpp(__float_as_int(x), 0xB1, 0xF, 0xF, true));
    else if constexpr (MASK == 2) return __int_as_float(__builtin_amdgcn_mov_dpp(__float_as_int(x), 0x4E, 0xF, 0xF, true));
    else if constexpr (MASK == 32) { auto rr = __builtin_amdgcn_permlane32_swap(__float_as_uint(x), __float_as_uint(x), false, false); return __uint_as_float((lane >> 5) ? rr[0] : rr[1]); }
    else return __shfl_xor(x, MASK);
}
template <int MASK> __device__ __forceinline__ int xchg_i(int x, int lane) { return __float_as_int(xchg_f<MASK>(__int_as_float(x), lane)); }
__device__ __forceinline__ float wave_sum(float v) {
    const int lane = threadIdx.x & 63;
    v += xchg_f<1>(v, lane); v += xchg_f<2>(v, lane); v += xchg_f<4>(v, lane); v += xchg_f<8>(v, lane); v += xchg_f<16>(v, lane); v += xchg_f<32>(v, lane);
    return v;
}
__device__ __forceinline__ float wave_max(float v) {
#pragma unroll
    for (int o = 1; o < 64; o <<= 1) v = fmaxf(v, __shfl_xor(v, o));
    return v;
}
__device__ __forceinline__ float sigmoidf_(float x) { return __builtin_amdgcn_rcpf(1.0f + __builtin_amdgcn_exp2f(-1.4426950408889634f * x)); }
__device__ __forceinline__ float siluf_(float x) { return x * sigmoidf_(x); }
__device__ __forceinline__ float logsigmoidf_(float x) { return fminf(x, 0.f) - log1pf(__expf(-fabsf(x))); }
__device__ __forceinline__ int crow(int r, int hi) { return (r & 3) + 8 * (r >> 2) + 4 * hi; }

__device__ __constant__ unsigned char T5B[128] = {0, 1, 2, 3, 4, 5, 6, 7, 8, 9, 10, 11, 12, 13, 14, 15, 16, 16, 16, 17, 17, 18, 18, 18, 19, 19, 19, 20, 20, 20, 20, 21, 21, 21, 21, 22, 22, 22, 22, 22, 23, 23, 23, 23, 23, 23, 24, 24, 24, 24, 24, 24, 25, 25, 25, 25, 25, 25, 25, 26, 26, 26, 26, 26, 26, 26, 26, 27, 27, 27, 27, 27, 27, 27, 27, 27, 27, 28, 28, 28, 28, 28, 28, 28, 28, 28, 28, 29, 29, 29, 29, 29, 29, 29, 29, 29, 29, 29, 29, 30, 30, 30, 30, 30, 30, 30, 30, 30, 30, 30, 30, 30, 30, 31, 31, 31, 31, 31, 31, 31, 31, 31, 31, 31, 31, 31, 31, 31};

namespace pg8 {
typedef int v8i32 __attribute__((ext_vector_type(8)));
typedef int v4i32 __attribute__((ext_vector_type(4)));
constexpr int BM = 256, BK = 64, HALF = 128, HTB = HALF * BK * 2, STAGE_BYTES = 8 * HTB, NXCD = 8, WGM = 8;
__host__ __device__ __forceinline__ int lds_byte(int r, int c) { const int st = (r >> 4) * 2 + (c >> 5), rr = r & 15, cc = c & 31, ob = rr * 64 + cc * 2; return st * 1024 + (ob ^ (((ob >> 9) & 1) << 5)); }
__host__ __device__ __forceinline__ void stage_rc(int b, int& R, int& C) { const int st = b / 1024, sb = b % 1024, swz = sb ^ (((sb >> 9) & 1) << 5); R = (st >> 1) * 16 + swz / 64; C = (st & 1) * 32 + (swz % 64) / 2; }
__host__ __device__ __forceinline__ int perm32(int rho) { const int n = rho >> 4, i = rho & 15; return 8 * (i >> 2) + 4 * n + (i & 3); }

__device__ __forceinline__ void glds16_s(const char* sbase, unsigned voff, unsigned lds_dst) { unsigned keep;
    asm volatile("s_mov_b32 %0, m0\n\ts_mov_b32 m0, %3\n\ts_nop 0\n\tglobal_load_lds_dwordx4 %1, %2\n\ts_mov_b32 m0, %0" : "=&s"(keep) : "v"(voff), "s"(sbase), "s"(lds_dst) : "memory"); }
__device__ __forceinline__ const char* uniform_ptr(const char* p) { const unsigned long long v = (unsigned long long)p;
    return (const char*)(((unsigned long long)(unsigned)__builtin_amdgcn_readfirstlane((int)(v >> 32)) << 32) | (unsigned)__builtin_amdgcn_readfirstlane((int)v)); }
struct Unit { int pm, pn, e, ui; };

struct StaticSched {
    int nM, nN, nwg, G, c, K;
    __device__ void init(int M_, int N_, int K_, int G_, int c_) { nM = M_ / BM; nN = N_ / BM; nwg = nM * nN; G = G_; c = c_; K = K_; }
    __device__ __forceinline__ bool next(int i, Unit& u) const {
        const long L = (long)i * G + c; if (L >= nwg) return false;
        int wgid = (int)L; { const int q = nwg / NXCD, r = nwg % NXCD, xcd = wgid % NXCD, off = wgid / NXCD; wgid = (xcd < r ? xcd * (q + 1) : r * (q + 1) + (xcd - r) * q) + off; }
        const int nig = WGM * nN, gid = wgid / nig, fm = gid * WGM, gsz = (nM - fm) < WGM ? (nM - fm) : WGM;
        u.pm = fm + ((wgid % nig) % gsz); u.pn = (wgid % nig) / gsz; u.e = 0; u.ui = i; return true;
    }
    __device__ __forceinline__ unsigned arow(const Unit& u, int r) const { return (unsigned)(u.pm * BM + r); }
    __device__ __forceinline__ size_t boff(const Unit& u) const { return (size_t)u.pn * BM * K * 2; }
};

struct EpiBf16 {
    bf16* O; int ldc; const float* bias; int bstride;
    __device__ __forceinline__ void operator()(const f32x4 (&acc)[2][2][4][2], const Unit& u, int wr, int wc, int fr, int fq) const {
        const int row0 = u.pm * BM + wr * 64 + fr; const int col0 = u.pn * BM + wc * 32 + 8 * fq;
#pragma unroll
        for (int bj = 0; bj < 2; ++bj) {
            f32x4 bv0 = (f32x4){0.f, 0.f, 0.f, 0.f}, bv1 = bv0;
            if (bias) { bv0 = *(const f32x4*)(bias + (size_t)u.e * bstride + col0 + bj * HALF); bv1 = *(const f32x4*)(bias + (size_t)u.e * bstride + col0 + bj * HALF + 4); }
#pragma unroll
            for (int ai = 0; ai < 2; ++ai)
#pragma unroll
                for (int m = 0; m < 4; ++m) { bf16* rowp = O + (size_t)(row0 + ai * HALF + m * 16) * ldc + col0;
                    const f32x4 v0 = acc[ai][bj][m][0] + bv0, v1 = acc[ai][bj][m][1] + bv1;
                    u32x4 w; w.x = pk2(v0[0], v0[1]); w.y = pk2(v0[2], v0[3]); w.z = pk2(v1[0], v1[1]); w.w = pk2(v1[2], v1[3]);
                    *(u32x4*)(rowp + bj * HALF) = w; } }
    }
};
struct EpiSwiglu {
    unsigned char* O; const float* bup;
    __device__ __forceinline__ void operator()(const f32x4 (&acc)[2][2][4][2], const Unit& u, int wr, int wc, int fr, int fq) const {
        const int row0 = u.pm * BM + wr * 64 + fr; const int c0 = u.pn * HALF + wc * 32 + 8 * fq;
        const float* bg = bup + (size_t)u.e * 2048 + c0; const float* bl = bg + 1024;
        const f32x4 g0 = *(const f32x4*)bg, g1 = *(const f32x4*)(bg + 4), l0 = *(const f32x4*)bl, l1 = *(const f32x4*)(bl + 4);
#pragma unroll
        for (int ai = 0; ai < 2; ++ai)
#pragma unroll
            for (int m = 0; m < 4; ++m) { unsigned char* rowp = O + (size_t)(row0 + ai * HALF + m * 16) * 1024 + c0;
                float a[8];
#pragma unroll
                for (int n = 0; n < 2; ++n) { const f32x4 gv = acc[ai][0][m][n] + (n ? g1 : g0), lv = acc[ai][1][m][n] + (n ? l1 : l0);
#pragma unroll
                    for (int j2 = 0; j2 < 2; ++j2) {
                        f32x2 gl = {fminf(gv[2 * j2], 7.0f), fminf(gv[2 * j2 + 1], 7.0f)};
                        f32x2 li = {__builtin_amdgcn_fmed3f(lv[2 * j2], -7.0f, 7.0f), __builtin_amdgcn_fmed3f(lv[2 * j2 + 1], -7.0f, 7.0f)};
                        const f32x2 ea = gl * (-1.702f * 1.4426950408889634f);
                        f32x2 d = {__builtin_amdgcn_exp2f(ea.x), __builtin_amdgcn_exp2f(ea.y)}; d = d + 1.0f;
                        const f32x2 r = {__builtin_amdgcn_rcpf(d.x), __builtin_amdgcn_rcpf(d.y)};
                        const f32x2 t = gl * r, o = __builtin_elementwise_fma(t, li, t);
                        a[n * 4 + 2 * j2] = o.x; a[n * 4 + 2 * j2 + 1] = o.y; } }
                u32x2 w; w.x = pk4_fp8(a[0], a[1], a[2], a[3]); w.y = pk4_fp8(a[4], a[5], a[6], a[7]);
                *(u32x2*)rowp = w; }
    }
};

template <bool FP8, class Epi, class Sched>
__device__ __forceinline__ void gemm_phase(LAS unsigned char* lds, const bf16* Abase, const bf16* Bbase, const int K, const Sched& S, const Epi& E) {
    const int tid = threadIdx.x, wid = __builtin_amdgcn_readfirstlane(tid >> 6), lane = tid & 63, wr = wid >> 2, wc = wid & 3, fr = lane & 15, fq = lane >> 4;
    const int nt = K / BK;
    unsigned voffB[2];
#pragma unroll
    for (int i = 0; i < 2; ++i) { int R, C; stage_rc(tid * 16 + i * 8192, R, C); const int Rb = (R & ~31) + perm32(R & 31); voffB[i] = (unsigned)(Rb * K + C) * 2u; }
    const size_t kstep = (size_t)(BK * 2);
    const size_t hstepB = (size_t)HALF * K * 2;
    const unsigned rowB = (unsigned)K * 2u;
    const unsigned ldsb = (unsigned)__builtin_amdgcn_readfirstlane((int)((unsigned)(unsigned long long)lds + (unsigned)wid * 1024u));
    const int aoff = lds_byte(wr * 64 + fr, fq * 8), boff = lds_byte(wc * 32 + fr, fq * 8);
#define PG8_SA(b, h) (((b) * 2 + (h)) * HTB)
#define PG8_SB(b, h) ((4 + (b) * 2 + (h)) * HTB)
#define PG8_STAGE(bufoff, gbase, voff) do { _Pragma("unroll") for (int _i = 0; _i < 2; ++_i) glds16_s(gbase, (voff)[_i], ldsb + (unsigned)((bufoff) + _i * 8192)); } while (0)
#define PG8_LD16(off) (*(const LAS v4i32*)(lds + (off)))
#define PG8_LDA(dst, b, h) do { if constexpr (FP8) { _Pragma("unroll") for (int m = 0; m < 4; ++m) dst##8[m] = __builtin_shufflevector(PG8_LD16(PG8_SA(b, h) + aoff + m * 2048), PG8_LD16(PG8_SA(b, h) + aoff + m * 2048 + 1024), 0, 1, 2, 3, 4, 5, 6, 7); } \
        else { _Pragma("unroll") for (int m = 0; m < 4; ++m) _Pragma("unroll") for (int k = 0; k < 2; ++k) dst##4[m][k] = *(const LAS bf16x8*)(lds + PG8_SA(b, h) + aoff + m * 2048 + k * 1024); } } while (0)
#define PG8_LDB(dst, b, h) do { if constexpr (FP8) { _Pragma("unroll") for (int n = 0; n < 2; ++n) dst##8[n] = __builtin_shufflevector(PG8_LD16(PG8_SB(b, h) + boff + n * 2048), PG8_LD16(PG8_SB(b, h) + boff + n * 2048 + 1024), 0, 1, 2, 3, 4, 5, 6, 7); } \
        else { _Pragma("unroll") for (int n = 0; n < 2; ++n) _Pragma("unroll") for (int k = 0; k < 2; ++k) dst##4[n][k] = *(const LAS bf16x8*)(lds + PG8_SB(b, h) + boff + n * 2048 + k * 1024); } } while (0)
#define PG8_MMA(ai, bj, At, Bt) do { __builtin_amdgcn_s_setprio(1); _Pragma("unroll") for (int m = 0; m < 4; ++m) _Pragma("unroll") for (int n = 0; n < 2; ++n) { \
        if constexpr (FP8) { asm volatile("v_mfma_scale_f32_16x16x128_f8f6f4 %0, %1, %2, %0, %3, %4 op_sel_hi:[0,0,0]" : "+v"(acc[ai][bj][m][n]) : "v"(Bt##8[n]), "v"(At##8[m]), "v"(scl), "v"(scl)); } \
        else { _Pragma("unroll") for (int k = 0; k < 2; ++k) acc[ai][bj][m][n] = __builtin_amdgcn_mfma_f32_16x16x32_bf16(Bt##4[n][k], At##4[m][k], acc[ai][bj][m][n], 0, 0, 0); } } \
        __builtin_amdgcn_s_setprio(0); } while (0)
#define PG8_WAIT_V(n) asm volatile("s_waitcnt vmcnt(" #n ")" ::: "memory")
#define PG8_WAIT_L(n) asm volatile("s_waitcnt lgkmcnt(" #n ")" ::: "memory")
#define PG8_BAR __builtin_amdgcn_s_barrier()
#define PG8_SCHED __builtin_amdgcn_sched_barrier(0)
#define PG8_MKVA(dst, u) do { _Pragma("unroll") for (int _i = 0; _i < 2; ++_i) { int R_, C_; stage_rc(tid * 16 + _i * 8192, R_, C_); _Pragma("unroll") for (int _h = 0; _h < 2; ++_h) dst[_h][_i] = S.arow(u, _h * HALF + R_) * rowB + (unsigned)C_ * 2u; } } while (0)
    Unit cur, nxt; int ui = 0;
    if (!S.next(0, cur)) return;
    f32x4 acc[2][2][4][2];
#pragma unroll
    for (int a = 0; a < 2; ++a)
#pragma unroll
        for (int b = 0; b < 2; ++b)
#pragma unroll
            for (int m = 0; m < 4; ++m)
#pragma unroll
                for (int n = 0; n < 2; ++n) acc[a][b][m][n] = (f32x4){0.f, 0.f, 0.f, 0.f};
    v8i32 At8[4], B08[2], B18[2]; bf16x8 At4[4][2], B04[2][2], B14[2][2];
    const unsigned scl = 0x7c7c7c7cu;
    unsigned vc[2][2];
    PG8_MKVA(vc, cur);
    const char* cA = uniform_ptr((const char*)Abase);
    const char* cB = uniform_ptr((const char*)Bbase + S.boff(cur));
    PG8_STAGE(PG8_SB(0, 0), cB, voffB); PG8_STAGE(PG8_SB(0, 1), cB + hstepB, voffB); PG8_STAGE(PG8_SA(0, 0), cA, vc[0]); PG8_STAGE(PG8_SA(0, 1), cA, vc[1]);
    if (wr == 1) PG8_BAR;
    PG8_WAIT_V(2); PG8_BAR;
    PG8_STAGE(PG8_SB(1, 0), cB + kstep, voffB); PG8_STAGE(PG8_SA(1, 0), cA + kstep, vc[0]); PG8_STAGE(PG8_SB(1, 1), cB + hstepB + kstep, voffB);
    PG8_WAIT_V(6); PG8_BAR;
    for (;;) {
        const bool has_next = S.next(ui + 1, nxt);
        const char* nB = uniform_ptr(has_next ? (const char*)Bbase + S.boff(nxt) : cB);
#pragma unroll 1
        for (int t = 0; t < nt; t += 2) {
            const bool last = (t == nt - 2);
            const char* a1 = cA + (size_t)(t + 1) * kstep;
            const char* a2 = last ? cA : cA + (size_t)(t + 2) * kstep; const char* b2 = last ? nB : cB + (size_t)(t + 2) * kstep;
            const char* a3 = a2 + kstep; const char* b3 = b2 + kstep;
            unsigned v2a[2], v2b[2];
#pragma unroll
            for (int i = 0; i < 2; ++i) { v2a[i] = vc[0][i]; v2b[i] = vc[1][i]; }
            if (last && has_next) {
#pragma unroll
                for (int i = 0; i < 2; ++i) { int R_, C_; stage_rc(tid * 16 + i * 8192, R_, C_); v2a[i] = S.arow(nxt, R_) * rowB + (unsigned)C_ * 2u; v2b[i] = S.arow(nxt, HALF + R_) * rowB + (unsigned)C_ * 2u; } }
            PG8_LDB(B0, 0, 0); PG8_LDB(B1, 0, 1); PG8_SCHED; PG8_LDA(At, 0, 0); PG8_STAGE(PG8_SA(1, 1), a1, vc[1]);
            PG8_WAIT_V(8); PG8_WAIT_L(0); PG8_BAR; PG8_MMA(0, 0, At, B0); PG8_MMA(0, 1, At, B1); PG8_BAR; PG8_SCHED;
            PG8_LDA(At, 0, 1); PG8_STAGE(PG8_SB(0, 0), b2, voffB); PG8_STAGE(PG8_SB(0, 1), b2 + hstepB, voffB); PG8_STAGE(PG8_SA(0, 0), a2, v2a);
            PG8_WAIT_V(8); PG8_WAIT_L(0); PG8_BAR; PG8_MMA(1, 0, At, B0); PG8_MMA(1, 1, At, B1); PG8_BAR; PG8_SCHED;
            PG8_LDB(B0, 1, 0); PG8_LDB(B1, 1, 1); PG8_SCHED; PG8_LDA(At, 1, 0); PG8_STAGE(PG8_SA(0, 1), a2, v2b);
            PG8_WAIT_V(8); PG8_WAIT_L(0); PG8_BAR; PG8_MMA(0, 0, At, B0); PG8_MMA(0, 1, At, B1); PG8_BAR; PG8_SCHED;
            PG8_LDA(At, 1, 1); PG8_STAGE(PG8_SB(1, 0), b3, voffB); PG8_STAGE(PG8_SB(1, 1), b3 + hstepB, voffB); PG8_STAGE(PG8_SA(1, 0), a3, v2a);
            PG8_WAIT_V(8); PG8_WAIT_L(0); PG8_BAR; PG8_MMA(1, 0, At, B0); PG8_MMA(1, 1, At, B1); PG8_BAR; PG8_SCHED;
        }
        if (wr == 0) PG8_BAR;
        if constexpr (FP8) asm volatile("s_nop 15\n\ts_nop 15" ::: "memory");
        E(acc, cur, wr, wc, fr, fq);
        if (!has_next) break;
#pragma unroll
        for (int a = 0; a < 2; ++a)
#pragma unroll
            for (int b = 0; b < 2; ++b)
#pragma unroll
                for (int m = 0; m < 4; ++m)
#pragma unroll
                    for (int n = 0; n < 2; ++n) acc[a][b][m][n] = (f32x4){0.f, 0.f, 0.f, 0.f};
        cur = nxt; cB = nB; ++ui;
        PG8_MKVA(vc, cur);
        if (wr == 1) PG8_BAR;
    }
    PG8_WAIT_V(0);
    PG8_BAR;
#undef PG8_SA
#undef PG8_SB
#undef PG8_STAGE
#undef PG8_LDA
#undef PG8_LD16
#undef PG8_LDB
#undef PG8_MMA
#undef PG8_WAIT_V
#undef PG8_WAIT_L
#undef PG8_BAR
#undef PG8_SCHED
#undef PG8_MKVA
}
}

#define XB_TMO      128
#define XB_XCNT(j)  (256  + 64 * (j))
#define XB_XSUB(j)  (1280 + 64 * (j))
#define XB_XGEN(j)  (2304 + 64 * (j))
#define XB_TOP      3328
#define XB_TOPGEN   3392
#define XCD_BAR_WORDS 3456
#define XB_SPIN_CAP (1u << 18)

__device__ __forceinline__ unsigned xb_ld(unsigned* p)              { return __hip_atomic_load(p, __ATOMIC_RELAXED, __HIP_MEMORY_SCOPE_AGENT); }
__device__ __forceinline__ unsigned xb_add(unsigned* p, unsigned v) { return __hip_atomic_fetch_add(p, v, __ATOMIC_RELAXED, __HIP_MEMORY_SCOPE_AGENT); }
__device__ __forceinline__ unsigned xb_xcc_id() { return (unsigned)__builtin_amdgcn_s_getreg((3 << 11) | 20) & 0xFu; }
#define XB_SPIN(cond, bar) do { unsigned _sp = 0; while (cond) { __builtin_amdgcn_s_sleep(1); \
    if ((++_sp & 255u) == 0u) { if (xb_ld(&(bar)[XB_TMO])) break; if (_sp > XB_SPIN_CAP) { atomicAdd(&(bar)[XB_TMO], 1u); break; } } } } while (0)

struct XcdBarrier {
    unsigned* bar; unsigned x;
    volatile LAS unsigned* st;
};
__device__ __forceinline__ XcdBarrier xcd_barrier_post(unsigned* bar, volatile LAS unsigned* st) {
    XcdBarrier b; b.bar = bar; b.x = xb_xcc_id(); b.st = st;
    if (threadIdx.x == 0) (void)xb_add(&bar[XB_XCNT(b.x)], 1u);
    return b;
}
__device__ __forceinline__ void xcd_barrier_complete(unsigned* bar, unsigned x, unsigned& nloc, unsigned& nx) {
    const unsigned G = gridDim.x * gridDim.y * gridDim.z;
    unsigned sum, cnt, mine, sp = 0u;
    for (;;) {
        sum = 0u; cnt = 0u; mine = 0u;
#pragma unroll
        for (unsigned j = 0; j < 16; ++j) { const unsigned c = xb_ld(&bar[XB_XCNT(j)]); sum += c; cnt += (c > 0u) ? 1u : 0u; mine = (j == x) ? c : mine; }
        if (sum == G) break;
        __builtin_amdgcn_s_sleep(1);
        if ((++sp & 255u) == 0u) { if (xb_ld(&bar[XB_TMO])) break; if (sp > XB_SPIN_CAP) { atomicAdd(&bar[XB_TMO], 1u); break; } }
    }
    nloc = mine > 0u ? mine : 1u; nx = cnt > 0u ? cnt : 1u;
}
__device__ __forceinline__ void xcd_barrier(const XcdBarrier& b) {
    asm volatile("s_waitcnt vmcnt(0)" ::: "memory");
    __syncthreads();
    if (threadIdx.x == 0) {
        unsigned* bar = b.bar;
        __builtin_amdgcn_s_waitcnt(0);
        unsigned nloc = b.st[0], nx = b.st[1];
        if (nloc == 0u) { xcd_barrier_complete(bar, b.x, nloc, nx); b.st[0] = nloc; b.st[1] = nx; }
        const unsigned old = xb_add(&bar[XB_XSUB(b.x)], 1u);
        const unsigned gen = old / nloc;
        if (old + 1u == (gen + 1u) * nloc) {
            __builtin_amdgcn_fence(__ATOMIC_RELEASE, "agent");
            asm volatile("s_waitcnt vmcnt(0)" ::: "memory");
            const unsigned og = xb_add(&bar[XB_TOP], 1u);
            const unsigned tg = og / nx;
            if (og + 1u == (tg + 1u) * nx) xb_add(&bar[XB_TOPGEN], 1u);
            else XB_SPIN(xb_ld(&bar[XB_TOPGEN]) == tg, bar);
            __builtin_amdgcn_fence(__ATOMIC_ACQUIRE, "agent");
            xb_add(&bar[XB_XGEN(b.x)], 1u);
            asm volatile("s_waitcnt vmcnt(0)" ::: "memory");
        } else {
            XB_SPIN(xb_ld(&bar[XB_XGEN(b.x)]) == gen, bar);
            __builtin_amdgcn_fence(__ATOMIC_ACQUIRE, "agent");
            asm volatile("s_waitcnt vmcnt(0)" ::: "memory");
        }
    }
    __syncthreads();
}

struct Frame {
    LAS unsigned char* lds;
    unsigned* ctl;
    unsigned char* ws;
    int tid, lane, wave, vcu, G;
    const float* const __attribute__((address_space(4)))* in;
    float* out;
};
#define LDS_WAIT() asm volatile("s_waitcnt lgkmcnt(0)" ::: "memory")
#define VM_WAIT() asm volatile("s_waitcnt vmcnt(0)" ::: "memory")

__device__ __forceinline__ int map_n(int mode, int n) {
    if (mode == 1) return n < 2048 ? n : (n < 2056 ? 3328 + (n - 2048) : (n < 3336 ? n - 8 : n));
    if (mode == 2) return n < 1024 ? ((n >> 7) * 256 + (n & 127)) : (((n - 1024) >> 7) * 256 + 128 + ((n - 1024) & 127));
    return n;
}
template <bool FP8>
__device__ __forceinline__ void p0_transpose_item(const float* W, int K, int N, void* WTv, int mode, LAS float* scr, int item, int lane) {
    const int nblk = N / 32, kb = item / nblk, nb = item % nblk, k0 = 64 * kb, n0 = 32 * nb;
    float tv_[32];
#pragma unroll
    for (int i = 0; i < 32; ++i) { const int kk = 2 * i + (lane >> 5); tv_[i] = W[(size_t)(k0 + kk) * N + n0 + (lane & 31)]; }
#pragma unroll
    for (int i = 0; i < 32; ++i) { const int kk = 2 * i + (lane >> 5); scr[kk * 33 + (lane & 31)] = tv_[i]; }
    LDS_WAIT(); asm volatile("" ::: "memory");
    const int c = lane & 7;
#pragma unroll
    for (int j = 0; j < 4; ++j) { const int n = (lane >> 3) + 8 * j; const LAS float* s = scr + (8 * c) * 33 + n;
        if constexpr (FP8) { u32x2 o; o.x = pk4_fp8(64.f * s[0 * 33], 64.f * s[1 * 33], 64.f * s[2 * 33], 64.f * s[3 * 33]); o.y = pk4_fp8(64.f * s[4 * 33], 64.f * s[5 * 33], 64.f * s[6 * 33], 64.f * s[7 * 33]);
            *(u32x2*)((unsigned char*)WTv + (size_t)map_n(mode, n0 + n) * K + k0 + 8 * c) = o; }
        else { u32x4 o; o.x = pk2(s[0 * 33], s[1 * 33]); o.y = pk2(s[2 * 33], s[3 * 33]); o.z = pk2(s[4 * 33], s[5 * 33]); o.w = pk2(s[6 * 33], s[7 * 33]);
            *(u32x4*)((bf16*)WTv + (size_t)map_n(mode, n0 + n) * K + k0 + 8 * c) = o; } }
    LDS_WAIT(); asm volatile("" ::: "memory");
}
__device__ __forceinline__ void p0_prologue(Frame& F) {
    LAS float* scr = (LAS float*)(F.lds + F.wave * 16384);
    const int gw = F.vcu * NWAVES + F.wave, NGW = F.G * NWAVES, lane = F.lane;
    constexpr int I_ADA = 192, I_CMP = 128, I_WRT = 32, I_PAD = 224, I_WIN = 16 * 105, I_WOUT = 16 * 32, I_WUP = 32 * 16 * 64, I_WDN = 32 * 16 * 32;
    unsigned char* ws = F.ws;
    for (int r = F.vcu; r < I_ADA; r += F.G) {
        const int ks = r / 24, jb = r % 24, j0 = jb * 256 + 4 * lane;
        const float* wa = F.in[2]; const float* c = F.in[1];
        f32x4 acc[4], w4[16];
#pragma unroll
        for (int b = 0; b < 4; ++b) acc[b] = (f32x4){0.f, 0.f, 0.f, 0.f};
#pragma unroll
        for (int kk = 0; kk < 16; ++kk) w4[kk] = __builtin_nontemporal_load((const f32x4*)(wa + (size_t)(ks * 128 + F.wave * 16 + kk) * 6144 + j0));
#pragma unroll
        for (int kk = 0; kk < 16; ++kk) {
#pragma unroll
            for (int b = 0; b < 4; ++b) { const float sv = siluf_(c[b * 1024 + ks * 128 + F.wave * 16 + kk]); acc[b] += w4[kk] * sv; } }
        LAS f32x4* red = (LAS f32x4*)F.lds;
#pragma unroll
        for (int b = 0; b < 4; ++b) red[(F.wave * 4 + b) * 64 + lane] = acc[b];
        __syncthreads();
        if (F.tid < 256) { const int b = F.tid >> 6, ln = F.tid & 63; f32x4 sum = red[b * 64 + ln];
#pragma unroll
            for (int w = 1; w < 8; ++w) sum += red[(w * 4 + b) * 64 + ln];
            *(f32x4*)((float*)(ws + WS_MODP) + (size_t)(ks * 4 + b) * 6144 + jb * 256 + 4 * ln) = sum; }
        __syncthreads();
    }
    for (int it = gw; it < I_CMP + I_WRT + I_PAD; it += NGW) {
        int r = it;
        if (r < I_CMP) {
            const int kv = r >> 6, e = r & 63; const float* w = kv ? F.in[12] : F.in[11]; const float* pos = kv ? F.in[14] : F.in[13];
            bf16* wt = (bf16*)(ws + WS_WCMP) + (size_t)(kv * 64 + e) * 2048; float s = 0.f;
            for (int k = lane; k < 2048; k += 64) { const float v = w[(size_t)k * 64 + e]; wt[k] = (bf16)f2bf(v); s += pos[k] * v; }
            s = wave_sum(s); if (lane == 0) ((float*)(ws + WS_CMPB))[kv * 64 + e] = s;
            continue; }
        r -= I_CMP;
        if (r < I_WRT) { const float* wr_ = F.in[17]; float* wt = (float*)(ws + WS_WRT) + (size_t)r * 1024;
            for (int k = lane; k < 1024; k += 64) wt[k] = wr_[(size_t)k * 32 + r];
            continue; }
        r -= I_WRT;
        { u32x4* p = (u32x4*)((bf16*)(ws + WS_WIN) + (size_t)(D_IN + r) * 1024); p[lane] = (u32x4){0u, 0u, 0u, 0u}; p[lane + 64] = (u32x4){0u, 0u, 0u, 0u}; }
    }
    constexpr int NT_ITEMS = I_WIN + I_WOUT;
    struct TItem { const float* src; unsigned char* dst; int N, mode, fp8, k0, n0; };
#define P0_DECODE(d, rr) do { int r_ = (rr); int item_; \
        if (r_ < I_WIN) { d.src = F.in[8]; d.dst = ws + WS_WIN; d.N = D_IN; d.mode = 1; d.fp8 = 0; item_ = r_; } \
        else { r_ -= I_WIN; d.src = F.in[16]; d.dst = ws + WS_WOUT; d.N = 1024; d.mode = 0; d.fp8 = 0; item_ = r_; } \
        const int nblk_ = d.N / 32; d.k0 = 64 * (item_ / nblk_); d.n0 = 32 * (item_ % nblk_); } while (0)
#define P0_LOAD(d, tv) do { _Pragma("unroll") for (int i = 0; i < 32; ++i) tv[i] = d.src[(size_t)(d.k0 + 2 * i + (lane >> 5)) * d.N + d.n0 + (lane & 31)]; } while (0)
    int itx = gw;
    if (itx < NT_ITEMS) {
        TItem d0, d1; float ta[32], tb[32];
        P0_DECODE(d0, itx); P0_LOAD(d0, ta);
        for (;;) {
            const int nx = itx + NGW; const bool has = nx < NT_ITEMS;
            if (has) { P0_DECODE(d1, nx); P0_LOAD(d1, tb); }
#pragma unroll
            for (int i = 0; i < 32; ++i) scr[(2 * i + (lane >> 5)) * 33 + (lane & 31)] = ta[i];
            LDS_WAIT(); asm volatile("" ::: "memory");
            const int c = lane & 7;
#pragma unroll
            for (int j = 0; j < 4; ++j) { const int n = (lane >> 3) + 8 * j; const LAS float* sp = scr + (8 * c) * 33 + n; const size_t orow = (size_t)map_n(d0.mode, d0.n0 + n) * 1024 + d0.k0 + 8 * c;
                if (d0.fp8) { u32x2 o; o.x = pk4_fp8(64.f * sp[0 * 33], 64.f * sp[1 * 33], 64.f * sp[2 * 33], 64.f * sp[3 * 33]); o.y = pk4_fp8(64.f * sp[4 * 33], 64.f * sp[5 * 33], 64.f * sp[6 * 33], 64.f * sp[7 * 33]);
                    *(u32x2*)(d0.dst + orow) = o; }
                else { u32x4 o; o.x = pk2(sp[0 * 33], sp[1 * 33]); o.y = pk2(sp[2 * 33], sp[3 * 33]); o.z = pk2(sp[4 * 33], sp[5 * 33]); o.w = pk2(sp[6 * 33], sp[7 * 33]);
                    *(u32x4*)(d0.dst + orow * 2) = o; } }
            LDS_WAIT(); asm volatile("" ::: "memory");
            if (!has) break;
            itx = nx; d0 = d1;
#pragma unroll
            for (int i = 0; i < 32; ++i) ta[i] = tb[i];
        }
    }
#undef P0_DECODE
#undef P0_LOAD
    {
        constexpr int NH = 2 * (32 * 8 * 32 + 32 * 8 * 16);
        LAS unsigned char* scr8 = (LAS unsigned char*)scr;
        struct HItem { const float* src; unsigned char* dst; int N, mode, k0, n0, half; };
#define P8_DECODE(d, hh) do { int it_ = (hh) >> 1; d.half = (hh) & 1; \
            if (it_ < 32 * 256) { const int e_ = it_ >> 8, q_ = it_ & 255; d.src = F.in[19] + (size_t)e_ * 1024 * 2048; d.dst = ws + WS_WUP + (size_t)e_ * 2048 * 1024; d.N = 2048; d.mode = 2; d.k0 = 128 * (q_ >> 5); d.n0 = 64 * (q_ & 31); } \
            else { it_ -= 32 * 256; const int e_ = it_ >> 7, q_ = it_ & 127; d.src = F.in[21] + (size_t)e_ * 1024 * 1024; d.dst = ws + WS_WDN + (size_t)e_ * 1024 * 1024; d.N = 1024; d.mode = 0; d.k0 = 128 * (q_ >> 4); d.n0 = 64 * (q_ & 15); } } while (0)
#define P8_LOAD(d, tv) do { _Pragma("unroll") for (int i = 0; i < 16; ++i) tv[i] = __builtin_nontemporal_load((const f32x4*)(d.src + (size_t)(d.k0 + 64 * d.half + 16 * (i >> 2) + 4 * (lane >> 4) + (i & 3)) * d.N + d.n0 + 4 * (lane & 15))); } while (0)
        int item = gw;
        if (item < NH / 2) {
            HItem d0, d1; f32x4 ta[16], tb[16];
            int hcur = 2 * item; P8_DECODE(d0, hcur); P8_LOAD(d0, ta);
            for (;;) {
                const bool has = (hcur & 1) == 0 || (item + NGW) < NH / 2;
                const int hn = (hcur & 1) == 0 ? hcur + 1 : 2 * (item + NGW);
                if (has) { P8_DECODE(d1, hn); P8_LOAD(d1, tb); }
#pragma unroll
                for (int g = 0; g < 4; ++g) {
                    const unsigned r0 = pk4_fp8(64.f * ta[4 * g][0], 64.f * ta[4 * g][1], 64.f * ta[4 * g][2], 64.f * ta[4 * g][3]);
                    const unsigned r1 = pk4_fp8(64.f * ta[4 * g + 1][0], 64.f * ta[4 * g + 1][1], 64.f * ta[4 * g + 1][2], 64.f * ta[4 * g + 1][3]);
                    const unsigned r2 = pk4_fp8(64.f * ta[4 * g + 2][0], 64.f * ta[4 * g + 2][1], 64.f * ta[4 * g + 2][2], 64.f * ta[4 * g + 2][3]);
                    const unsigned r3 = pk4_fp8(64.f * ta[4 * g + 3][0], 64.f * ta[4 * g + 3][1], 64.f * ta[4 * g + 3][2], 64.f * ta[4 * g + 3][3]);
                    const unsigned t01l = __builtin_amdgcn_perm(r1, r0, 0x05010400u), t01h = __builtin_amdgcn_perm(r1, r0, 0x07030602u), t23l = __builtin_amdgcn_perm(r3, r2, 0x05010400u), t23h = __builtin_amdgcn_perm(r3, r2, 0x07030602u);
                    const unsigned o0 = __builtin_amdgcn_perm(t23l, t01l, 0x05040100u), o1 = __builtin_amdgcn_perm(t23l, t01l, 0x07060302u), o2 = __builtin_amdgcn_perm(t23h, t01h, 0x05040100u), o3 = __builtin_amdgcn_perm(t23h, t01h, 0x07060302u);
                    LAS unsigned char* wp = scr8 + (4 * (lane & 15)) * 132 + 64 * d0.half + 16 * g + 4 * (lane >> 4);
                    *(LAS unsigned*)(wp) = o0; *(LAS unsigned*)(wp + 132) = o1; *(LAS unsigned*)(wp + 264) = o2; *(LAS unsigned*)(wp + 396) = o3; }
                if (d0.half == 1) {
                    LDS_WAIT(); asm volatile("" ::: "memory");
#pragma unroll
                    for (int i = 0; i < 8; ++i) { const int n = (lane >> 3) + 8 * i, ch = lane & 7; const LAS unsigned* rp = (const LAS unsigned*)(scr8 + n * 132 + ch * 16);
                        u32x4 o; o.x = rp[0]; o.y = rp[1]; o.z = rp[2]; o.w = rp[3];
                        __builtin_nontemporal_store(o, (u32x4*)(d0.dst + (size_t)map_n(d0.mode, d0.n0 + n) * 1024 + d0.k0 + ch * 16)); }
                    LDS_WAIT(); asm volatile("" ::: "memory");
                }
                if (!has) break;
                if (hcur & 1) item += NGW;
                hcur = hn; d0 = d1;
#pragma unroll
                for (int i = 0; i < 16; ++i) ta[i] = tb[i];
            }
        }
#undef P8_DECODE
#undef P8_LOAD
    }
}

__device__ __forceinline__ float mod_val(const Frame& F, int b, int j) {
    const float* mp = (const float*)(F.ws + WS_MODP); float s = F.in[3][j];
#pragma unroll
    for (int ks = 0; ks < 8; ++ks) s += mp[(size_t)(ks * 4 + b) * 6144 + j];
    return s;
}
__device__ __forceinline__ void p1_rows(Frame& F) {
    LAS float* A1 = (LAS float*)F.lds; LAS float* B1 = A1 + 1024;
    bf16* H = (bf16*)(F.ws + WS_H);
    for (int rb = F.vcu; rb < M / 64; rb += F.G) {
        const int b = (rb * 64) / SEQ;
        f32x4 v[8][4];
#pragma unroll
        for (int i = 0; i < 8; ++i) { const f32x4* xr = (const f32x4*)(F.in[0] + (size_t)(rb * 64 + F.wave * 8 + i) * 1024) + F.lane;
#pragma unroll
            for (int j = 0; j < 4; ++j) v[i][j] = __builtin_nontemporal_load(xr + 64 * j); }
        for (int col = F.tid; col < 1024; col += NTHR) { A1[col] = F.in[4][col] * (1.0f + mod_val(F, b, 1024 + col)); B1[col] = mod_val(F, b, col); }
        if (rb < 96 && F.tid < 256) { const int idx = rb * 256 + F.tid; ((float*)(F.ws + WS_MODF))[idx] = mod_val(F, idx / 6144, idx % 6144); }
        __syncthreads();
#pragma unroll
        for (int i = 0; i < 8; ++i) {
            const int row = rb * 64 + F.wave * 8 + i;
            float ss = 0.f;
#pragma unroll
            for (int j = 0; j < 4; ++j) ss += (v[i][j].x * v[i][j].x + v[i][j].y * v[i][j].y) + (v[i][j].z * v[i][j].z + v[i][j].w * v[i][j].w);
            const float rs = rsqrtf(wave_sum(ss) * (1.0f / 1024.0f) + EPS);
            u32x2* o8 = (u32x2*)(H + (size_t)row * 1024) + F.lane;
#pragma unroll
            for (int j = 0; j < 4; ++j) { const int c0 = 4 * F.lane + 256 * j;
                const f32x4 a = *(const LAS f32x4*)(A1 + c0), bb = *(const LAS f32x4*)(B1 + c0);
                const f32x4 y = v[i][j] * rs * a + bb; u32x2 w; w.x = pk2(y.x, y.y); w.y = pk2(y.z, y.w); o8[64 * j] = w; }
        }
        __syncthreads();
    }
}

__device__ __forceinline__ void p3_compress_item(Frame& F, int wi) {
    const int lane = F.lane, r32 = lane & 31, hi = lane >> 5;
    const int nt = wi & 1, kv = (wi >> 1) & 1, it = (wi >> 2) & 7, g = (wi >> 5) & 1, b = wi >> 6;
    const bf16* Z = (const bf16*)(F.ws + WS_Z);
    const int i = it * 32 + r32; const bool ok = i < 255; const int ic = ok ? i : 0;
    const bf16* zrow0 = Z + (size_t)(b * SEQ + 16 * ic) * ZP + (kv ? ZC_VC : ZC_KC) + g * 64 + hi * 8;
    const bf16* wrow = (const bf16*)(F.ws + WS_WCMP) + (size_t)(kv * 64 + nt * 32 + r32) * 2048 + hi * 8;
    f32x16 acc = {};
    bf16x8 av[16], bv[16];
#pragma unroll
    for (int k = 0; k < 16; ++k) { const int ks = F.wave * 16 + k, l = ks >> 2, dq = ks & 3; av[k] = *(const bf16x8*)(zrow0 + (size_t)l * ZP + dq * 16); bv[k] = *(const bf16x8*)(wrow + ks * 16); }
#pragma unroll
    for (int k = 0; k < 16; ++k) { bf16x8 a = av[k]; if (!ok) a = (bf16x8){0, 0, 0, 0, 0, 0, 0, 0}; acc = __builtin_amdgcn_mfma_f32_32x32x16_bf16(a, bv[k], acc, 0, 0, 0); }
    LAS float* part = (LAS float*)F.lds;
#pragma unroll
    for (int r = 0; r < 16; ++r) part[(F.wave * 16 + r) * 64 + lane] = acc[r];
    __syncthreads();
    bf16* dst = (bf16*)(F.ws + (kv ? WS_VC : WS_KC)) + (size_t)((b * 2 + g) * 256) * 64;
#pragma unroll
    for (int k = 0; k < 2; ++k) { const int o = F.tid + NTHR * k, r = o >> 6, ln = o & 63; float v = 0.f;
#pragma unroll
        for (int w = 0; w < 8; ++w) v += part[(w * 16 + r) * 64 + ln];
        const int irow = it * 32 + crow(r, ln >> 5), e = nt * 32 + (ln & 31);
        dst[(size_t)irow * 64 + e] = (bf16)f2bf(irow < 255 ? v + ((const float*)(F.ws + WS_CMPB))[kv * 64 + e] : 0.f); }
    __syncthreads();
}
__device__ __forceinline__ void chunk_gates(const Frame& F, int b, int h, int c, float& ig, float& g) {
    const bf16* Z = (const bf16*)(F.ws + WS_Z); const size_t row = (size_t)(b * SEQ + c * 64 + F.lane) * ZP;
    ig = bf2f(Z[row + ZC_IG + h]) + F.in[9][h];
    const float fp = bf2f(Z[row + ZC_FG + h]) + F.in[9][4 + h];
    float v = logsigmoidf_(fp);
#pragma unroll
    for (int o = 1; o < 64; o <<= 1) { const float t = __shfl_up(v, o); if (F.lane >= o) v += t; }
    g = v;
}
__device__ __forceinline__ void conv8(const Frame& F, int b, int t, int zc, int cc, float (&o)[8]) {
    const bf16* Z = (const bf16*)(F.ws + WS_Z); const float* cw = F.in[10];
#pragma unroll
    for (int j = 0; j < 8; ++j) o[j] = 0.f;
#pragma unroll
    for (int jj = 0; jj < 4; ++jj) { const int tt = t - 3 + jj;
        if (tt >= 0) { const bf16x8 v = *(const bf16x8*)(Z + (size_t)(b * SEQ + tt) * ZP + zc);
            const f32x4 w0 = *(const f32x4*)(cw + jj * 1024 + cc), w1 = *(const f32x4*)(cw + jj * 1024 + cc + 4);
#pragma unroll
            for (int j = 0; j < 4; ++j) { o[j] += w0[j] * bf2f((unsigned short)v[j]); o[4 + j] += w1[j] * bf2f((unsigned short)v[4 + j]); } } }
#pragma unroll
    for (int j = 0; j < 8; ++j) o[j] = siluf_(o[j]);
}
struct ConvRaw { bf16x8 v[4]; };
__device__ __forceinline__ void conv8_load(const Frame& F, int b, int t, int zc, ConvRaw& r) {
    const bf16* Z = (const bf16*)(F.ws + WS_Z);
#pragma unroll
    for (int jj = 0; jj < 4; ++jj) { const int tt = t - 3 + jj; r.v[jj] = (bf16x8){0, 0, 0, 0, 0, 0, 0, 0}; if (tt >= 0) r.v[jj] = *(const bf16x8*)(Z + (size_t)(b * SEQ + tt) * ZP + zc); }
}
__device__ __forceinline__ void conv8_calc(const Frame& F, const ConvRaw& r, int cc, float (&o)[8]) {
    const float* cw = F.in[10];
#pragma unroll
    for (int j = 0; j < 8; ++j) o[j] = 0.f;
#pragma unroll
    for (int jj = 0; jj < 4; ++jj) { const f32x4 w0 = *(const f32x4*)(cw + jj * 1024 + cc), w1 = *(const f32x4*)(cw + jj * 1024 + cc + 4);
#pragma unroll
        for (int j = 0; j < 4; ++j) { o[j] += w0[j] * bf2f((unsigned short)r.v[jj][j]); o[4 + j] += w1[j] * bf2f((unsigned short)r.v[jj][4 + j]); } }
#pragma unroll
    for (int j = 0; j < 8; ++j) o[j] = siluf_(o[j]);
}
constexpr int KT_STRIDE = 72, QS_STRIDE = 136;
__device__ __forceinline__ void p3_mlstm_a_item(Frame& F, int item) {
    const int b = item >> 8, h = (item >> 6) & 3, c = item & 63, tid = F.tid, lane = F.lane, r32 = lane & 31, hi = lane >> 5;
    LAS bf16* kT = (LAS bf16*)F.lds; LAS bf16* vwT = kT + 128 * KT_STRIDE; LAS float* wex = (LAS float*)(F.lds + 2 * 128 * KT_STRIDE * 2);
    const bf16* Z = (const bf16*)(F.ws + WS_Z);
    float* SCG = (float*)(F.ws + WS_SC); float* SCM = SCG + 1024;
    ConvRaw rk[2]; bf16x8 rvv[2];
#pragma unroll
    for (int rep = 0; rep < 2; ++rep) { const int task = tid + NTHR * rep, l = task >> 4, ch = task & 15, t = c * 64 + l;
        conv8_load(F, b, t, ZC_KM + h * 128 + ch * 8, rk[rep]); rvv[rep] = *(const bf16x8*)(Z + (size_t)(b * SEQ + t) * ZP + ZC_VM + h * 128 + ch * 8); }
    if (F.wave == 0) {
        float ig, g; chunk_gates(F, b, h, c, ig, g);
        const float G = __shfl(g, 63), wl = G - g + ig, ml = wave_max(wl);
        wex[lane] = __expf(wl - ml);
        if (lane == 0) { SCG[item] = G; SCM[item] = ml; }
    }
    __syncthreads();
#pragma unroll
    for (int rep = 0; rep < 2; ++rep) { const int task = tid + NTHR * rep, l = task >> 4, ch = task & 15;
        float kk[8]; conv8_calc(F, rk[rep], 512 + h * 128 + ch * 8, kk);
        const bf16x8 vv = rvv[rep]; const float we = wex[l];
#pragma unroll
        for (int j = 0; j < 8; ++j) { kT[(ch * 8 + j) * KT_STRIDE + l] = (bf16)f2bf(kk[j] * 0.08838834764831845f); vwT[(ch * 8 + j) * KT_STRIDE + l] = (bf16)f2bf(bf2f((unsigned short)vv[j]) * we); } }
    __syncthreads();
    {
        const int et = F.wave >> 1; bf16* DC = (bf16*)(F.ws + WS_DC) + (size_t)item * 16384;
#pragma unroll
        for (int dt2 = 0; dt2 < 2; ++dt2) { const int dt = 2 * (F.wave & 1) + dt2; f32x16 acc = {};
#pragma unroll
            for (int ks = 0; ks < 4; ++ks) { const bf16x8 a = *(const LAS bf16x8*)(vwT + (et * 32 + r32) * KT_STRIDE + ks * 16 + hi * 8), bq = *(const LAS bf16x8*)(kT + (dt * 32 + r32) * KT_STRIDE + ks * 16 + hi * 8);
                acc = __builtin_amdgcn_mfma_f32_32x32x16_bf16(a, bq, acc, 0, 0, 0); }
#pragma unroll
            for (int r = 0; r < 16; ++r) DC[(size_t)(et * 32 + crow(r, hi)) * 128 + dt * 32 + r32] = (bf16)f2bf(acc[r]); }
        { const int d = tid >> 2, part = tid & 3; float s = 0.f;
#pragma unroll
            for (int l = 0; l < 16; ++l) s += wex[part * 16 + l] * bf2f(kT[d * KT_STRIDE + part * 16 + l]);
            s += __shfl_xor(s, 1); s += __shfl_xor(s, 2);
            if (part == 0) ((float*)(F.ws + WS_DN))[(size_t)item * 128 + d] = s; }
    }
    __syncthreads();
}

__device__ __forceinline__ void p4_scan(Frame& F) {
    const float* SCG = (const float*)(F.ws + WS_SC); const float* SCM = SCG + 1024; float* MP = (float*)(F.ws + WS_SC) + 2048;
    for (int it = F.vcu; it < 256; it += F.G) {
        const int bh = it >> 4, idx = (it & 15) * 512 + F.tid; const bool wmp = ((it & 15) == 0) && F.tid == 0;
        const unsigned* __restrict__ src = (const unsigned*)(F.ws + WS_DC) + idx; unsigned* __restrict__ dst = (unsigned*)(F.ws + WS_CP) + idx;
        float m = -INFINITY, s0 = 0.f, s1 = 0.f;
        for (int cb = 0; cb < 4; ++cb) {
            unsigned v[16];
#pragma unroll
            for (int i = 0; i < 16; ++i) v[i] = __builtin_nontemporal_load(src + (size_t)(bh * 64 + cb * 16 + i) * 8192);
#pragma unroll
            for (int i = 0; i < 16; ++i) { const int ci = bh * 64 + cb * 16 + i; const float G = SCG[ci], ml = SCM[ci];
                const float mn = fmaxf(G + m, ml), a = __expf(G + m - mn), bc = __expf(ml - mn);
                dst[(size_t)ci * 8192] = pk2(s0, s1); if (wmp) MP[ci] = m;
                s0 = a * s0 + bc * bf2f(v[i] & 0xffffu); s1 = a * s1 + bc * bf2f(v[i] >> 16); m = mn; }
        }
        if (F.tid < 8) { const int flat = it * 8 + F.tid, bhn = flat >> 7, d = flat & 127;
            const float* __restrict__ sn = (const float*)(F.ws + WS_DN) + d; float* __restrict__ dn = (float*)(F.ws + WS_NP) + d;
            float mN = -INFINITY, st = 0.f;
            for (int cb = 0; cb < 4; ++cb) { float v[16];
#pragma unroll
                for (int i = 0; i < 16; ++i) v[i] = sn[(size_t)(bhn * 64 + cb * 16 + i) * 128];
#pragma unroll
                for (int i = 0; i < 16; ++i) { const int ci = bhn * 64 + cb * 16 + i; const float G = SCG[ci], ml = SCM[ci];
                    const float mn = fmaxf(G + mN, ml), a = __expf(G + mN - mn), bc = __expf(ml - mn);
                    dn[(size_t)ci * 128] = st; st = a * st + bc * v[i]; mN = mn; } } }
    }
}

namespace nsa {
constexpr int KOFF = 0, VOFF = 32768, TBOFF = 65536, WSFOFF = 71680, MSKOFF = 73728, UNIOFF = 74240, JLOFF = 74304, OACCOFF = 74752, QOFF0 = 123904;
constexpr float LOG2E = 1.4426950408889634f, C2 = 0.125f * LOG2E;
typedef short v4i16_t __attribute__((ext_vector_type(4)));
#define NSA_WAITV(n) asm volatile("s_waitcnt vmcnt(" #n ")" ::: "memory")
#define NSA_BAR() do { asm volatile("s_waitcnt lgkmcnt(0)" ::: "memory"); __builtin_amdgcn_s_barrier(); asm volatile("" ::: "memory"); } while (0)

__device__ __forceinline__ void dma_k(LAS unsigned char* L, int buf, int wid, int lane, const bf16* Kt, size_t P) {
    __builtin_amdgcn_global_load_lds((const unsigned*)(Kt + (size_t)lane * P + wid * 8), (LAS unsigned*)(L + KOFF + buf * 8192 + wid * 1024), 16, 0, 0);
}
__device__ __forceinline__ void dma_v(LAS unsigned char* L, int buf, int wid, int lane, const bf16* Vt, size_t P) {
    __builtin_amdgcn_global_load_lds((const unsigned*)(Vt + (size_t)(16 * (wid & 3) + (lane >> 2)) * P + (wid >> 2) * 32 + (lane & 3) * 8), (LAS unsigned*)(L + VOFF + buf * 8192 + wid * 1024), 16, 0, 0);
}
__device__ __forceinline__ void qkt(f32x16& p0, f32x16& p1, const LAS unsigned char* L, int buf, const LAS bf16x8* qr, int r32, int hi) {
    const LAS unsigned char* kb = L + KOFF + buf * 8192 + hi * 1024 + r32 * 16;
    p0 = (f32x16){}; p1 = (f32x16){};
#pragma unroll
    for (int d0 = 0; d0 < 4; ++d0) {
        const bf16x8 b0 = *(const LAS bf16x8*)(kb + d0 * 2048), b1 = *(const LAS bf16x8*)(kb + d0 * 2048 + 512), q = qr[d0 * 64];
        p0 = __builtin_amdgcn_mfma_f32_32x32x16_bf16(b0, q, p0, 0, 0, 0);
        p1 = __builtin_amdgcn_mfma_f32_32x32x16_bf16(b1, q, p1, 0, 0, 0); }
}
__device__ __forceinline__ s16x4 vtr(const LAS unsigned char* p) { return __builtin_bit_cast(s16x4, __builtin_amdgcn_ds_read_tr16_b64_v4i16((LAS v4i16_t*)p)); }
__device__ __forceinline__ void pv(f32x16 (&o)[2], const LAS unsigned char* L, int buf, const u32x4 (&pw)[4], int lane, int hi) {
    const LAS unsigned char* vp = L + VOFF + buf * 8192 + ((lane >> 4) & 1) * 32 + (lane & 3) * 8 + (4 * hi + ((lane & 15) >> 2)) * 64;
#pragma unroll
    for (int dh = 0; dh < 2; ++dh)
#pragma unroll
        for (int ks = 0; ks < 4; ++ks) {
            const s16x4 lo = vtr(vp + dh * 4096 + ks * 1024), hh = vtr(vp + dh * 4096 + ks * 1024 + 512);
            const bf16x8 vf = (bf16x8){lo[0], lo[1], lo[2], lo[3], hh[0], hh[1], hh[2], hh[3]};
            o[dh] = __builtin_amdgcn_mfma_f32_32x32x16_bf16(__builtin_bit_cast(bf16x8, pw[ks]), vf, o[dh], 0, 0, 0); }
}
__device__ __forceinline__ float xhalf(float x, int hi) {
    auto rr = __builtin_amdgcn_permlane32_swap(__float_as_uint(x), __float_as_uint(x), false, false); return __uint_as_float(hi ? rr[0] : rr[1]); }
__device__ __forceinline__ float dpp_xor1(float x) { return __int_as_float(__builtin_amdgcn_mov_dpp(__float_as_int(x), 0xB1, 0xF, 0xF, true)); }
__device__ __forceinline__ float dpp_xor2(float x) { return __int_as_float(__builtin_amdgcn_mov_dpp(__float_as_int(x), 0x4E, 0xF, 0xF, true)); }
__device__ __forceinline__ void score_tile(f32x16& p0, f32x16& p1, int dist0, int step, int dmax, bool laneok, bool usebias, const LAS float* tbh, int hi) {
    const int dbase = dist0 + step * 4 * hi;
#pragma unroll
    for (int r = 0; r < 16; ++r) {
        const int kk = (r & 3) + 8 * (r >> 2); const int da = dbase + step * kk, db = da + step * 32;
        float sa = p0[r] * C2, sb = p1[r] * C2;
        if (usebias) { sa += tbh[min(max(da, 0), 127)]; sb += tbh[min(max(db, 0), 127)]; }
        p0[r] = (laneok && da >= 0 && da < dmax) ? sa : -INFINITY;
        p1[r] = (laneok && db >= 0 && db < dmax) ? sb : -INFINITY; }
}
template <bool DIAG>
__device__ __forceinline__ void near_scores(f32x16& p0, f32x16& p1, const LAS float* tbD, int D0) {
#pragma unroll
    for (int r = 0; r < 16; ++r) { const int kk = (r & 3) + 8 * (r >> 2);
        float sa = __builtin_fmaf(p0[r], C2, tbD[-kk]), sb = __builtin_fmaf(p1[r], C2, tbD[-kk - 32]);
        if (DIAG) { sa = (kk <= D0) ? sa : -INFINITY; sb = (kk + 32 <= D0) ? sb : -INFINITY; }
        p0[r] = sa; p1[r] = sb; }
}
__device__ __forceinline__ void wedge_mask(f32x16& p0, f32x16& p1, int D) {
#pragma unroll
    for (int r = 0; r < 16; ++r) { const int kk = (r & 3) + 8 * (r >> 2); p0[r] = (kk > D) ? p0[r] : -INFINITY; p1[r] = (kk + 32 > D) ? p1[r] : -INFINITY; }
}
__device__ __forceinline__ float rowmax32(const f32x16& p0, const f32x16& p1) {
    float a = fmaxf(p0[0], p1[0]);
#pragma unroll
    for (int r = 1; r < 16; ++r) a = fmaxf(a, fmaxf(p0[r], p1[r]));
    return fmaxf(a, xchg_f<32>(a, threadIdx.x & 63));
}
template <bool HAS_O>
__device__ __forceinline__ void softmax_step(f32x16& p0, f32x16& p1, float& m, float& l, f32x16 (&o)[2], u32x4 (&pw)[4], LAS float* wsf, int r32, int hi, bool sel = true) {
    const float rm = sel ? rowmax32(p0, p1) : -INFINITY, mn = fmaxf(m, rm);
    if (__any(mn > m + 8.0f)) {
        const float alpha = __builtin_amdgcn_exp2f(m - mn); l *= alpha; m = mn;
        if (HAS_O) { if (hi == 0) wsf[r32] = alpha; LDS_WAIT();
#pragma unroll
            for (int r = 0; r < 16; ++r) { const float f = wsf[crow(r, hi)]; o[0][r] *= f; o[1][r] *= f; }
            LDS_WAIT(); }
    }
    const float off = sel ? -m : -INFINITY;
    float s0 = 0.f, s1 = 0.f;
#pragma unroll
    for (int r = 0; r < 16; ++r) { p0[r] = __builtin_amdgcn_exp2f(p0[r] + off); p1[r] = __builtin_amdgcn_exp2f(p1[r] + off); s0 += p0[r]; s1 += p1[r]; }
    l += s0 + s1;
#pragma unroll
    for (int k = 0; k < 2; ++k) { pw[k] = (u32x4){pk2(p0[8 * k], p0[8 * k + 1]), pk2(p0[8 * k + 2], p0[8 * k + 3]), pk2(p0[8 * k + 4], p0[8 * k + 5]), pk2(p0[8 * k + 6], p0[8 * k + 7])};
        pw[2 + k] = (u32x4){pk2(p1[8 * k], p1[8 * k + 1]), pk2(p1[8 * k + 2], p1[8 * k + 3]), pk2(p1[8 * k + 4], p1[8 * k + 5]), pk2(p1[8 * k + 6], p1[8 * k + 7])}; }
}
template <bool HAS_O = true>
__device__ __forceinline__ void softmax_fast(f32x16& p0, f32x16& p1, float& m, float& l, f32x16 (&o)[2], u32x4 (&pw)[4], LAS float* wsf, int r32, int hi, bool sel) {
    float a = fmaxf(fmaxf(p0[0], p0[1]), p1[0]), bq = fmaxf(fmaxf(p0[2], p0[3]), p1[1]); a = fmaxf(fmaxf(a, p1[2]), p1[3]);
#pragma unroll
    for (int r = 4; r < 16; r += 4) { a = fmaxf(fmaxf(a, p0[r]), p0[r + 1]); bq = fmaxf(fmaxf(bq, p0[r + 2]), p0[r + 3]); a = fmaxf(fmaxf(a, p1[r]), p1[r + 1]); bq = fmaxf(fmaxf(bq, p1[r + 2]), p1[r + 3]); }
    a = fmaxf(a, bq); a = fmaxf(a, xchg_f<32>(a, threadIdx.x & 63));
    const float rm = sel ? a * C2 : -INFINITY, mn = fmaxf(m, rm);
    if (__any(mn > m + 8.0f)) {
        const float alpha = __builtin_amdgcn_exp2f(m - mn); l *= alpha; m = mn;
        if (HAS_O) { if (hi == 0) wsf[r32] = alpha; LDS_WAIT();
#pragma unroll
            for (int r = 0; r < 16; ++r) { const float f = wsf[crow(r, hi)]; o[0][r] *= f; o[1][r] *= f; }
            LDS_WAIT(); }
    }
    const float off = sel ? -m : -INFINITY;
    float s0 = 0.f, s1 = 0.f;
#pragma unroll
    for (int r = 0; r < 16; ++r) { p0[r] = __builtin_amdgcn_exp2f(__builtin_fmaf(p0[r], C2, off)); p1[r] = __builtin_amdgcn_exp2f(__builtin_fmaf(p1[r], C2, off)); s0 += p0[r]; s1 += p1[r]; }
    l += s0 + s1;
#pragma unroll
    for (int k = 0; k < 2; ++k) { pw[k] = (u32x4){pk2(p0[8 * k], p0[8 * k + 1]), pk2(p0[8 * k + 2], p0[8 * k + 3]), pk2(p0[8 * k + 4], p0[8 * k + 5]), pk2(p0[8 * k + 6], p0[8 * k + 7])};
        pw[2 + k] = (u32x4){pk2(p1[8 * k], p1[8 * k + 1]), pk2(p1[8 * k + 2], p1[8 * k + 3]), pk2(p1[8 * k + 4], p1[8 * k + 5]), pk2(p1[8 * k + 6], p1[8 * k + 7])}; }
}
template <bool FIRST>
__device__ __forceinline__ void branch_merge(LAS bf16* oa, const f32x16 (&o)[2], float l, float gate, LAS float* wsf, int r32, int hi, int lane) {
    const float lt = l + xchg_f<32>(l, lane); const float f = lt > 0.f ? gate / lt : 0.f;
    LDS_WAIT(); if (hi == 0) wsf[r32] = f; LDS_WAIT();
#pragma unroll
    for (int r = 0; r < 16; ++r) { const float ff = wsf[crow(r, hi)];
        float a0 = o[0][r] * ff, a1 = o[1][r] * ff;
        if (!FIRST) { a0 += bf2f(oa[(2 * r) * 64 + lane]); a1 += bf2f(oa[(2 * r + 1) * 64 + lane]); }
        oa[(2 * r) * 64 + lane] = (bf16)f2bf(a0); oa[(2 * r + 1) * 64 + lane] = (bf16)f2bf(a1); }
    LDS_WAIT();
}

#define NSA_LOOP(NTILES, NDMA, ISSUE, COMPUTE) do { const int n_ = (NTILES); \
        ISSUE(0, 0); if (n_ > 1) { ISSUE(1, 1); } \
        for (int idx = 0; idx < n_; ++idx) { \
            if (idx + 1 < n_) { if (NDMA == 2) NSA_WAITV(2); else NSA_WAITV(1); } else { NSA_WAITV(0); } \
            NSA_BAR(); \
            if (idx + 2 < n_) { ISSUE(idx + 2, (idx + 2) & 3); } \
            COMPUTE(idx, idx & 3); } \
        NSA_BAR(); } while (0)

template <int VAR>
__device__ __forceinline__ void attn_unit(const Frame& F, int b, int g, int cur, bf16* Y, bool FILL_TB) {
    LAS unsigned char* L = F.lds;
    const int lane = F.lane, wid = F.wave, r32 = lane & 31, hi = lane >> 5, tid = F.tid;
    const bf16* Z = (const bf16*)(F.ws + WS_Z);
    const int qi = r32 >> 2, hp = r32 & 3, head = g * 4 + hp;
    const int tq = cur * 64 + wid * 8 + qi;
    const size_t zrow = (size_t)(b * SEQ + tq) * ZP;
    LAS float* tb = (LAS float*)(L + TBOFF);
    if (FILL_TB) for (int i = tid; i < 4 * 384; i += NTHR) { const int hpp = i / 384, dd = i % 384 - 64; tb[i] = (dd >= 0 && dd < 128) ? (F.in[15][T5B[dd & 127] * 8 + g * 4 + hpp] - F.in[15][31 * 8 + g * 4 + hpp]) * LOG2E : 0.f; }
    const LAS float* tbh = tb + hp * 384 + 64;
    LAS bf16x8* qr = (LAS bf16x8*)(L + (wid == 0 ? QOFF0 : TAB_OFF + (wid - 1) * 4096)) + lane;
#pragma unroll
    for (int d0 = 0; d0 < 4; ++d0) qr[d0 * 64] = *(const bf16x8*)(Z + zrow + ZC_QA + head * 64 + d0 * 16 + hi * 8);
#define NSA_GATE(br) sigmoidf_(bf2f(Z[zrow + ZC_GA + head * 3 + (br)]))
    LAS float* wsf = (LAS float*)(L + WSFOFF) + wid * 64;
    LAS unsigned long long* msk = (LAS unsigned long long*)(L + MSKOFF);
    LAS unsigned long long* uni = (LAS unsigned long long*)(L + UNIOFF);
    LAS int* jl = (LAS int*)(L + JLOFF);
    LAS bf16* oa = (LAS bf16*)(L + OACCOFF) + wid * 2048;
    LAS float* sc = (LAS float*)oa;
    f32x16 p0, p1, o[2]; u32x4 pw[4];
    NSA_BAR();

    {
        const bf16* KCb = (const bf16*)(F.ws + WS_KC) + (size_t)((b * 2 + g) * 256) * 64;
        const bf16* VCb = (const bf16*)(F.ws + WS_VC) + (size_t)((b * 2 + g) * 256) * 64;
        const int nT = (4 * cur + 2) / 64 + 1;
        float m = -1e30f, l = 0.f;
#define B1_COMP1(T, s) do { qkt(p0, p1, L, s, qr, r32, hi); \
            if (cur >= 16 * (T) + 19) softmax_fast<false>(p0, p1, m, l, o, pw, wsf, r32, hi, true); \
            else { score_tile(p0, p1, tq - 31 - 16 * 64 * (T), -16, 1 << 30, true, true, tbh, hi); softmax_step<false>(p0, p1, m, l, o, pw, wsf, r32, hi); } } while (0)
        for (int T = 0; T < nT; ++T) { dma_k(L, T, wid, lane, KCb + (size_t)T * 64 * 64, 64); dma_v(L, T, wid, lane, VCb + (size_t)T * 64 * 64, 64); }
        NSA_WAITV(0); NSA_BAR();
        for (int T = 0; T < nT; ++T) B1_COMP1(T, T);
        const float lt = l + xchg_f<32>(l, lane); const float inv_l = lt > 0.f ? 1.0f / lt : 0.f;
        o[0] = (f32x16){}; o[1] = (f32x16){};
        float carry = 0.f;
#define B1_COMP2(T, s) do { qkt(p0, p1, L, s, qr, r32, hi); \
            if (cur >= 16 * (T) + 19) { _Pragma("unroll") for (int r = 0; r < 16; ++r) { p0[r] *= C2; p1[r] *= C2; } } \
            else score_tile(p0, p1, tq - 31 - 16 * 64 * (T), -16, 1 << 30, true, true, tbh, hi); \
            float ps8[9]; \
            _Pragma("unroll") for (int i = 0; i < 9; ++i) ps8[i] = 0.f; \
            ps8[0] = (hi == 0) ? carry : 0.f; \
            _Pragma("unroll") for (int r = 0; r < 16; ++r) { p0[r] = __builtin_amdgcn_exp2f(p0[r] - m) * inv_l; p1[r] = __builtin_amdgcn_exp2f(p1[r] - m) * inv_l; } \
            _Pragma("unroll") for (int sub = 0; sub < 2; ++sub) _Pragma("unroll") for (int n = 0; n < 4; ++n) { \
                const float q0 = sub ? p1[4 * n] : p0[4 * n], q1 = sub ? p1[4 * n + 1] : p0[4 * n + 1], q2 = sub ? p1[4 * n + 2] : p0[4 * n + 2], q3 = sub ? p1[4 * n + 3] : p0[4 * n + 3]; \
                const float a = (q0 + q1) + (q2 + 0.5f * q3), bq = 0.5f * q3, bsw = xhalf(bq, hi); \
                if (hi == 1) ps8[sub * 4 + n] += a + bsw; else { ps8[sub * 4 + n] += a; ps8[sub * 4 + n + 1] += bsw; } } \
            carry = ps8[8]; \
            _Pragma("unroll") for (int i = 0; i < 8; ++i) { float v = ps8[i]; v += dpp_xor1(v); v += dpp_xor2(v); if (hp == 0) sc[qi * 64 + 16 * (T) + 2 * i + hi] = v; } \
            _Pragma("unroll") for (int k = 0; k < 2; ++k) { pw[k] = (u32x4){pk2(p0[8 * k], p0[8 * k + 1]), pk2(p0[8 * k + 2], p0[8 * k + 3]), pk2(p0[8 * k + 4], p0[8 * k + 5]), pk2(p0[8 * k + 6], p0[8 * k + 7])}; \
                pw[2 + k] = (u32x4){pk2(p1[8 * k], p1[8 * k + 1]), pk2(p1[8 * k + 2], p1[8 * k + 3]), pk2(p1[8 * k + 4], p1[8 * k + 5]), pk2(p1[8 * k + 6], p1[8 * k + 7])}; } \
            pv(o, L, s, pw, lane, hi); } while (0)
        for (int T = 0; T < nT; ++T) B1_COMP2(T, T);
        NSA_BAR();
    }
    unsigned long long mymask; int nsel;
    {
        LDS_WAIT();
        if (cur >= 16) {
            for (int q = 0; q < 8; ++q) {
                const bool valid = lane <= cur; const bool forced = (lane == 0) || (lane == cur) || (lane == cur - 1);
                const float v = valid ? sc[q * 64 + lane] + (forced ? 1000.f : 0.f) : -1.0f;
                const unsigned bits = valid ? __float_as_uint(v) : 0u; const unsigned long long vm = __ballot(valid);
                unsigned T = 0u;
#pragma unroll
                for (int bt = 30; bt >= 0; --bt) { const unsigned cand = T | (1u << bt); const unsigned long long ge = __ballot(bits >= cand) & vm; if (__builtin_popcountll(ge) >= 16) T = cand; }
                const unsigned long long gt = __ballot(bits > T) & vm, eq = __ballot(bits == T) & vm;
                const int need = 16 - __builtin_popcountll(gt);
                const bool pick_eq = ((eq >> lane) & 1ull) && (__builtin_popcountll(eq & ((1ull << lane) - 1ull)) < need);
                const unsigned long long mk = gt | __ballot(pick_eq);
                if (lane == 0) msk[wid * 8 + q] = mk;
            }
        } else {
            if (lane < 8) msk[wid * 8 + lane] = (2ull << cur) - 1ull;
        }
        LDS_WAIT();
        mymask = msk[wid * 8 + qi];
        unsigned long long u = mymask;
#pragma unroll
        for (int o_ = 4; o_ < 32; o_ <<= 1) { const unsigned lo = __shfl_xor((unsigned)u, o_), hh = __shfl_xor((unsigned)(u >> 32), o_); u |= ((unsigned long long)hh << 32) | lo; }
        if (lane == 0) uni[wid] = u;
        branch_merge<true>(oa, o, 0.5f, NSA_GATE(0), wsf, r32, hi, lane);
        NSA_BAR();
        unsigned long long umask = 0ull;
#pragma unroll
        for (int w = 0; w < 8; ++w) umask |= uni[w];
        umask = ((unsigned long long)__builtin_amdgcn_readfirstlane((unsigned)(umask >> 32)) << 32) | (unsigned)__builtin_amdgcn_readfirstlane((unsigned)umask);
        nsel = __builtin_popcountll(umask);
        if (wid == 0 && ((umask >> lane) & 1ull)) jl[__builtin_popcountll(umask & ((1ull << lane) - 1ull))] = lane;
        NSA_BAR();
    }
    {
        const bf16* Kb = Z + (size_t)(b * SEQ) * ZP + ZC_KS + g * 64; const bf16* Vb = Z + (size_t)(b * SEQ) * ZP + ZC_VS + g * 64;
        float m = -1e30f, l = 0.f; o[0] = (f32x16){}; o[1] = (f32x16){};
#define B2_ISSUE(i_, s) do { const int jj_ = __builtin_amdgcn_readfirstlane(jl[i_]); dma_k(L, s, wid, lane, Kb + (size_t)(64 * jj_) * ZP, ZP); dma_v(L, s, wid, lane, Vb + (size_t)(64 * jj_) * ZP, ZP); } while (0)
#define B2_COMP(i_, s) do { const int j = __builtin_amdgcn_readfirstlane(jl[i_]); const bool sel = (mymask >> j) & 1ull; \
            if (VAR != 1 && __any(sel)) { qkt(p0, p1, L, s, qr, r32, hi); \
                if (VAR == 2) { asm volatile("" :: "v"(p0), "v"(p1)); } else \
                if ((cur - j) < 3) { const int D0 = tq - 64 * j - 4 * hi; if (j == cur) near_scores<true>(p0, p1, tbh + D0, D0); else near_scores<false>(p0, p1, tbh + D0, D0); \
                    softmax_step<true>(p0, p1, m, l, o, pw, wsf, r32, hi, sel); } \
                else softmax_fast(p0, p1, m, l, o, pw, wsf, r32, hi, sel); \
                if (VAR == 0) pv(o, L, s, pw, lane, hi); else if (VAR == 3) { asm volatile("" :: "v"(pw[0]), "v"(pw[1]), "v"(pw[2]), "v"(pw[3])); } } } while (0)
        NSA_LOOP(nsel, 2, B2_ISSUE, B2_COMP);
        branch_merge<false>(oa, o, l, NSA_GATE(1), wsf, r32, hi, lane);
    }
    {
        const bf16* Kb = Z + (size_t)(b * SEQ) * ZP + ZC_KW + g * 64; const bf16* Vb = Z + (size_t)(b * SEQ) * ZP + ZC_VW + g * 64;
        float m = -1e30f, l = 0.f; o[0] = (f32x16){}; o[1] = (f32x16){};
        const int j0 = cur >= 8 ? cur - 8 : 0, nT = cur - j0 + 1;
#define B3_ISSUE(T, s) do { dma_k(L, s, wid, lane, Kb + (size_t)(64 * (j0 + (T))) * ZP, ZP); dma_v(L, s, wid, lane, Vb + (size_t)(64 * (j0 + (T))) * ZP, ZP); } while (0)
#define B3_COMP(T, s) do { const int j = j0 + (T); if (VAR != 1) { qkt(p0, p1, L, s, qr, r32, hi); \
            if (VAR == 2) { asm volatile("" :: "v"(p0), "v"(p1)); } else \
            if ((cur - j) < 3) { const int D0 = tq - 64 * j - 4 * hi; if (j == cur) near_scores<true>(p0, p1, tbh + D0, D0); else near_scores<false>(p0, p1, tbh + D0, D0); \
                softmax_step<true>(p0, p1, m, l, o, pw, wsf, r32, hi); } \
            else { if ((cur - j) >= 8) wedge_mask(p0, p1, tq - 64 * cur - 4 * hi); softmax_fast(p0, p1, m, l, o, pw, wsf, r32, hi, true); } \
            if (VAR == 0) pv(o, L, s, pw, lane, hi); else if (VAR == 3) { asm volatile("" :: "v"(pw[0]), "v"(pw[1]), "v"(pw[2]), "v"(pw[3])); } } } while (0)
        NSA_LOOP(nT, 2, B3_ISSUE, B3_COMP);
        branch_merge<false>(oa, o, l, NSA_GATE(2), wsf, r32, hi, lane);
    }
#pragma unroll
    for (int r = 0; r < 16; ++r) { const int row = crow(r, hi), q_ = row >> 2, hp_ = row & 3;
        bf16* dst = Y + (size_t)(b * SEQ + cur * 64 + wid * 8 + q_) * 1024 + 512 + (g * 4 + hp_) * 64 + r32;
        dst[0] = oa[(2 * r) * 64 + lane]; dst[32] = oa[(2 * r + 1) * 64 + lane]; }
#undef B1_COMP1
#undef B1_COMP2
#undef B2_ISSUE
#undef B2_COMP
#undef B3_ISSUE
#undef B3_COMP
#undef NSA_GATE
}
template <int VAR>
__device__ __forceinline__ void p4_attention(Frame& F, bf16* Y) {
    for (int v = F.vcu; v < 256; v += F.G) {
        const int bg = v >> 5, s = v & 31;
#pragma unroll 1
        for (int u2 = 0; u2 < 2; ++u2) attn_unit<VAR>(F, bg >> 1, bg & 1, u2 ? s : 63 - s, Y, u2 == 0);
    }
}
}

__device__ __forceinline__ f32x16 mma32_lds(const LAS bf16* A, int sa, const LAS bf16* Bt, int sb, int ksteps, int r32, int hi, f32x16 acc) {
#pragma unroll
    for (int ks = 0; ks < 8; ++ks) if (ks < ksteps) {
        const bf16x8 a = *(const LAS bf16x8*)(A + r32 * sa + ks * 16 + hi * 8), bq = *(const LAS bf16x8*)(Bt + r32 * sb + ks * 16 + hi * 8);
        acc = __builtin_amdgcn_mfma_f32_32x32x16_bf16(a, bq, acc, 0, 0, 0); }
    return acc;
}
__device__ __forceinline__ void p5_mlstm_c_items(Frame& F) {
    const int tid = F.tid, lane = F.lane, r32 = lane & 31, hi = lane >> 5, wid = F.wave;
    LAS bf16* Qs = (LAS bf16*)F.lds;
    LAS bf16* Qp = Qs + 64 * QS_STRIDE;
    LAS bf16* Ks = Qp + 64 * QS_STRIDE;
    LAS bf16* VT = Ks + 64 * QS_STRIDE;
    LAS bf16* CT = VT + 128 * KT_STRIDE;
    LAS bf16* Wm = CT + 128 * QS_STRIDE;
    LAS float* fu = (LAS float*)(Wm + 64 * KT_STRIDE);
    LAS float* fmm = fu + 64; LAS float* fiw = fu + 128; LAS float* ffl = fu + 192; LAS float* frd = fu + 256; LAS float* fnp = fu + 320;
    const bf16* Z = (const bf16*)(F.ws + WS_Z);
    ConvRaw rq[2], rk[2]; bf16x8 rvv[2]; u32x4 cpv[4]; unsigned short ogn[16]; unsigned short gi_raw = 0, gf_raw = 0; float mp_n = 0.f, np_n = 0.f;
#define P5_LOAD(item_) do { const int b_ = (item_) >> 8, h_ = ((item_) >> 6) & 3, c_ = (item_) & 63; \
    _Pragma("unroll") for (int rep = 0; rep < 2; ++rep) { const int task = tid + NTHR * rep, l = task >> 4, ch = task & 15, t = c_ * 64 + l; \
        conv8_load(F, b_, t, ZC_QM + h_ * 128 + ch * 8, rq[rep]); conv8_load(F, b_, t, ZC_KM + h_ * 128 + ch * 8, rk[rep]); \
        rvv[rep] = *(const bf16x8*)(Z + (size_t)(b_ * SEQ + t) * ZP + ZC_VM + h_ * 128 + ch * 8); } \
    { const bf16* cp = (const bf16*)(F.ws + WS_CP) + (size_t)(item_) * 16384; \
      _Pragma("unroll") for (int i = 0; i < 4; ++i) { const int q = tid + NTHR * i; cpv[i] = *(const u32x4*)(cp + q * 8); } } \
    { const int lt = wid & 1, et = wid >> 1; \
      _Pragma("unroll") for (int r = 0; r < 16; ++r) ogn[r] = Z[(size_t)(b_ * SEQ + c_ * 64 + lt * 32 + crow(r, hi)) * ZP + ZC_OM + h_ * 128 + et * 32 + r32]; } \
    if (wid == 0) { const size_t zr_ = (size_t)(b_ * SEQ + c_ * 64 + lane) * ZP; gi_raw = Z[zr_ + ZC_IG + h_]; gf_raw = Z[zr_ + ZC_FG + h_]; mp_n = ((const float*)(F.ws + WS_SC))[2048 + (item_)]; } \
    if (tid >= 64 && tid < 192) np_n = ((const float*)(F.ws + WS_NP))[(size_t)(item_) * 128 + tid - 64]; } while (0)
    int item = F.vcu;
    if (item >= 1024) return;
    P5_LOAD(item);
    for (;;) {
    const int b = item >> 8, h = (item >> 6) & 3, c = item & 63;
    if (wid == 0) {
        const float ig = bf2f(gi_raw) + F.in[9][h]; float g = logsigmoidf_(bf2f(gf_raw) + F.in[9][4 + h]);
#pragma unroll
        for (int o = 1; o < 64; o <<= 1) { const float t = __shfl_up(g, o); if (lane >= o) g += t; }
        const float u = ig - g; float pm = u;
#pragma unroll
        for (int o = 1; o < 64; o <<= 1) { const float t = __shfl_up(pm, o); if (lane >= o) pm = fmaxf(pm, t); }
        const float Mp = mp_n;
        const float mm = fmaxf(Mp, pm);
        fu[lane] = u; fmm[lane] = mm; fiw[lane] = __expf(Mp - mm); ffl[lane] = __expf(-(g + mm));
    }
    if (tid >= 64 && tid < 192) fnp[tid - 64] = np_n;
    __syncthreads();
#pragma unroll
    for (int rep = 0; rep < 2; ++rep) { const int task = tid + NTHR * rep, l = task >> 4, ch = task & 15;
        float qq[8], kk[8];
        conv8_calc(F, rq[rep], h * 128 + ch * 8, qq);
        conv8_calc(F, rk[rep], 512 + h * 128 + ch * 8, kk);
        const float iw = fiw[l];
        u32x4 wq, wp, wk;
        wq.x = pk2(qq[0], qq[1]); wq.y = pk2(qq[2], qq[3]); wq.z = pk2(qq[4], qq[5]); wq.w = pk2(qq[6], qq[7]);
        wp.x = pk2(qq[0] * iw, qq[1] * iw); wp.y = pk2(qq[2] * iw, qq[3] * iw); wp.z = pk2(qq[4] * iw, qq[5] * iw); wp.w = pk2(qq[6] * iw, qq[7] * iw);
        const float sk = 0.08838834764831845f;
        wk.x = pk2(kk[0] * sk, kk[1] * sk); wk.y = pk2(kk[2] * sk, kk[3] * sk); wk.z = pk2(kk[4] * sk, kk[5] * sk); wk.w = pk2(kk[6] * sk, kk[7] * sk);
        *(LAS u32x4*)(Qs + l * QS_STRIDE + ch * 8) = wq; *(LAS u32x4*)(Qp + l * QS_STRIDE + ch * 8) = wp; *(LAS u32x4*)(Ks + l * QS_STRIDE + ch * 8) = wk;
        const bf16x8 vv = rvv[rep];
#pragma unroll
        for (int j = 0; j < 8; ++j) VT[(ch * 8 + j) * KT_STRIDE + l] = (bf16)vv[j]; }
    {
#pragma unroll
        for (int i = 0; i < 4; ++i) { const int q = tid + NTHR * i, e = q >> 4, d8 = (q & 15) * 8; *(LAS u32x4*)(CT + e * QS_STRIDE + d8) = cpv[i]; } }
    unsigned short og[16];
#pragma unroll
    for (int r = 0; r < 16; ++r) og[r] = ogn[r];
    const int nitem = item + F.G;
    if (nitem < 1024) P5_LOAD(nitem);
    __syncthreads();
    if (wid < 4) {
        const int lt = wid >> 1, st = wid & 1;
        f32x16 acc = {}; acc = mma32_lds(Qs + lt * 32 * QS_STRIDE, QS_STRIDE, Ks + st * 32 * QS_STRIDE, QS_STRIDE, 8, r32, hi, acc);
        const int s = st * 32 + r32; const float us = fu[s];
#pragma unroll
        for (int r = 0; r < 16; ++r) { const int l = lt * 32 + crow(r, hi); const float w = (s <= l) ? __expf(us - fmm[l]) * acc[r] : 0.f; Wm[l * KT_STRIDE + s] = (bf16)f2bf(w); }
    }
    __syncthreads();
    {
        const int l = tid >> 3, part = tid & 7; float dsum = 0.f;
#pragma unroll
        for (int s = 0; s < 8; ++s) dsum += bf2f(Wm[l * KT_STRIDE + part * 8 + s]);
#pragma unroll
        for (int d = 0; d < 16; ++d) dsum += bf2f(Qp[l * QS_STRIDE + part * 16 + d]) * fnp[part * 16 + d];
        dsum += __shfl_xor(dsum, 1); dsum += __shfl_xor(dsum, 2); dsum += __shfl_xor(dsum, 4);
        if (part == 0) frd[l] = 1.0f / fmaxf(fabsf(dsum), ffl[l]);
    }
    f32x16 acc = {};
    {
        const int lt = wid & 1, et = wid >> 1;
        acc = mma32_lds(Wm + lt * 32 * KT_STRIDE, KT_STRIDE, VT + et * 32 * KT_STRIDE, KT_STRIDE, 4, r32, hi, acc);
        acc = mma32_lds(Qp + lt * 32 * QS_STRIDE, QS_STRIDE, CT + et * 32 * QS_STRIDE, QS_STRIDE, 8, r32, hi, acc);
        __syncthreads();
        bf16* Y = (bf16*)(F.ws + WS_YMIX);
        const int e = et * 32 + r32;
#pragma unroll
        for (int r = 0; r < 16; ++r) { const int l = lt * 32 + crow(r, hi); const size_t row = (size_t)(b * SEQ + c * 64 + l);
            Y[row * 1024 + h * 128 + e] = (bf16)f2bf(acc[r] * frd[l] * sigmoidf_(bf2f(og[r]))); }
    }
    __syncthreads();
    if (nitem >= 1024) break;
    item = nitem;
    }
#undef P5_LOAD
}

template <int L> __device__ __forceinline__ float rtree(const LAS float* WR, const f32x4 (&h2)[4], int base, int lane) {
    if constexpr (L == 0) { float s = 0.f;
#pragma unroll
        for (int j = 0; j < 4; ++j) { const f32x4 w = *(const LAS f32x4*)(WR + base * 1024 + 4 * lane + 256 * j); s += (h2[j].x * w.x + h2[j].y * w.y) + (h2[j].z * w.z + h2[j].w * w.w); }
        return s;
    } else {
        const float lo = rtree<L - 1>(WR, h2, base, lane), hh = rtree<L - 1>(WR, h2, base + (1 << (L - 1)), lane);
        const bool up = (lane & (1 << L)) != 0;
        return (up ? hh : lo) + __shfl_xor(up ? lo : hh, 1 << L);
    }
}
__device__ __forceinline__ void wave_sum2(float (&v)[2]) {
    const int lane = threadIdx.x & 63;
#define WS2_STEP(M) do { const float a = xchg_f<M>(v[0], lane), b = xchg_f<M>(v[1], lane); v[0] += a; v[1] += b; } while (0)
    WS2_STEP(1); WS2_STEP(2); WS2_STEP(4); WS2_STEP(8); WS2_STEP(16); WS2_STEP(32);
#undef WS2_STEP
}
#define RT_MASK(L) ((L) == 1 ? 1 : (L) == 2 ? 2 : (L) == 3 ? 32 : (L) == 4 ? 4 : 8)
__device__ __forceinline__ int router_expert(int lane) { return (lane & 3) | (((lane >> 5) & 1) << 2) | (((lane >> 2) & 3) << 3); }
template <int L> __device__ __forceinline__ f32x2 rtree2(const LAS float* WR, const f32x4 (&h2)[2][4], int base, int lane) {
    if constexpr (L == 0) { f32x2 a0 = {0.f, 0.f}, a1 = {0.f, 0.f};
#pragma unroll
        for (int j = 0; j < 4; ++j) { const f32x4 w = *(const LAS f32x4*)(WR + base * 1024 + 4 * lane + 256 * j);
            const f32x2 wl = {w.x, w.y}, wh = {w.z, w.w};
            a0 = __builtin_elementwise_fma((f32x2){h2[0][j].x, h2[0][j].y}, wl, a0); a0 = __builtin_elementwise_fma((f32x2){h2[0][j].z, h2[0][j].w}, wh, a0);
            a1 = __builtin_elementwise_fma((f32x2){h2[1][j].x, h2[1][j].y}, wl, a1); a1 = __builtin_elementwise_fma((f32x2){h2[1][j].z, h2[1][j].w}, wh, a1); }
        f32x2 s; s.x = a0.x + a0.y; s.y = a1.x + a1.y;
        return s;
    } else {
        const f32x2 lo = rtree2<L - 1>(WR, h2, base, lane), hh = rtree2<L - 1>(WR, h2, base + (1 << (L - 1)), lane);
        const bool up = (lane & RT_MASK(L)) != 0;
        f32x2 r; r.x = (up ? hh.x : lo.x) + xchg_f<RT_MASK(L)>(up ? lo.x : hh.x, lane); r.y = (up ? hh.y : lo.y) + xchg_f<RT_MASK(L)>(up ? lo.y : hh.y, lane);
        return r;
    }
}
__device__ __forceinline__ void p7_rows(Frame& F) {
    LAS float* WR = (LAS float*)F.lds;
    LAS int* lcnt = (LAS int*)(F.lds + TAB_OFF);
    LAS int* gbase = lcnt + 32;
    LAS int* rinfo = gbase + 32;
    const float* MODF = (const float*)(F.ws + WS_MODF);
    const int lane = F.lane, tid = F.tid;
    for (int i = tid; i < 32 * 1024 / 4; i += NTHR) ((LAS f32x4*)WR)[i] = ((const f32x4*)(F.ws + WS_WRT))[i];
    for (int rb = F.vcu; rb < M / 64; rb += F.G) {
        const int b = (rb * 64) / SEQ;
        if (tid < 32) lcnt[tid] = 0;
        __syncthreads();
        LAS float* A7 = (LAS float*)(F.lds + TAB_OFF + 4096); LAS float* G2 = A7 + 1024; LAS float* S2 = G2 + 1024;
        for (int c0 = tid; c0 < 1024; c0 += NTHR) { A7[c0] = F.in[5][c0] * MODF[b * 6144 + 2048 + c0]; G2[c0] = F.in[6][c0] * (MODF[b * 6144 + 4096 + c0] + 1.0f); S2[c0] = MODF[b * 6144 + 3072 + c0]; }
        __syncthreads();
        u32x2 yw[2][2][4]; f32x4 xw[2][2][4];
        const int row0 = rb * 64 + F.wave * 8;
#pragma unroll
        for (int r = 0; r < 2; ++r) { const u32x2* yr = (const u32x2*)((const bf16*)(F.ws + WS_Y) + (size_t)(row0 + r) * 1024) + lane; const f32x4* xr = (const f32x4*)(F.in[0] + (size_t)(row0 + r) * 1024) + lane;
#pragma unroll
            for (int j = 0; j < 4; ++j) { yw[0][r][j] = yr[64 * j]; xw[0][r][j] = xr[64 * j]; } }
        const float brt = F.in[18][router_expert(lane)];
#pragma unroll
        for (int ip = 0; ip < 4; ++ip) {
            const int rl0 = F.wave * 8 + 2 * ip, rowp = rb * 64 + rl0;
            if (ip < 3) {
#pragma unroll
                for (int r = 0; r < 2; ++r) { const u32x2* yr = (const u32x2*)((const bf16*)(F.ws + WS_Y) + (size_t)(rowp + 2 + r) * 1024) + lane; const f32x4* xr = (const f32x4*)(F.in[0] + (size_t)(rowp + 2 + r) * 1024) + lane;
#pragma unroll
                    for (int j = 0; j < 4; ++j) { yw[(ip + 1) & 1][r][j] = yr[64 * j]; xw[(ip + 1) & 1][r][j] = xr[64 * j]; } } }
            f32x4 y[2][4], x1[2][4], h2[2][4]; float ss[2] = {0.f, 0.f};
#pragma unroll
            for (int r = 0; r < 2; ++r)
#pragma unroll
                for (int j = 0; j < 4; ++j) { const u32x2 w = yw[ip & 1][r][j]; y[r][j] = (f32x4){bf2f(w.x & 0xffffu), bf2f(w.x >> 16), bf2f(w.y & 0xffffu), bf2f(w.y >> 16)};
                    ss[r] += (y[r][j].x * y[r][j].x + y[r][j].y * y[r][j].y) + (y[r][j].z * y[r][j].z + y[r][j].w * y[r][j].w); }
            wave_sum2(ss);
            float s1[2] = {0.f, 0.f};
#pragma unroll
            for (int r = 0; r < 2; ++r) { const float rs = rsqrtf(ss[r] * (1.0f / 1024.0f) + EPS);
#pragma unroll
                for (int j = 0; j < 4; ++j) { x1[r][j] = xw[ip & 1][r][j] + *(const LAS f32x4*)(A7 + 4 * lane + 256 * j) * (y[r][j] * rs); s1[r] += (x1[r][j].x * x1[r][j].x + x1[r][j].y * x1[r][j].y) + (x1[r][j].z * x1[r][j].z + x1[r][j].w * x1[r][j].w);
                    ((f32x4*)(F.out + (size_t)(rowp + r) * 1024))[lane + 64 * j] = x1[r][j]; } }
            wave_sum2(s1);
#pragma unroll
            for (int r = 0; r < 2; ++r) { const float rs1 = rsqrtf(s1[r] * (1.0f / 1024.0f) + EPS);
                unsigned* ho = (unsigned*)(F.ws + WS_H + (size_t)(rowp + r) * 1024) + lane;
#pragma unroll
                for (int j = 0; j < 4; ++j) { h2[r][j] = x1[r][j] * rs1 * *(const LAS f32x4*)(G2 + 4 * lane + 256 * j) + *(const LAS f32x4*)(S2 + 4 * lane + 256 * j); ho[64 * j] = pk4_fp8(h2[r][j].x, h2[r][j].y, h2[r][j].z, h2[r][j].w); } }
            f32x2 lg = rtree2<5>(WR, h2, 0, lane);
            lg.x += __shfl_xor(lg.x, 16); lg.y += __shfl_xor(lg.y, 16);
            lg.x += brt; lg.y += brt;
            const int e = router_expert(lane);
            float tvv[2][4]; int tee[2][4]; float cand0 = lg.x, cand1 = lg.y;
#define TOPK_STEP(MASK) do { const float ov0 = xchg_f<MASK>(v0, lane), ov1 = xchg_f<MASK>(v1, lane); const int oi0 = xchg_i<MASK>(i0, lane), oi1 = xchg_i<MASK>(i1, lane); \
                    if (ov0 > v0 || (ov0 == v0 && oi0 < i0)) { v0 = ov0; i0 = oi0; } if (ov1 > v1 || (ov1 == v1 && oi1 < i1)) { v1 = ov1; i1 = oi1; } } while (0)
#pragma unroll
            for (int k = 0; k < 4; ++k) { float v0 = cand0, v1 = cand1; int i0 = e, i1 = e;
                TOPK_STEP(1); TOPK_STEP(2); TOPK_STEP(32); TOPK_STEP(4); TOPK_STEP(8);
                tvv[0][k] = v0; tee[0][k] = i0; tvv[1][k] = v1; tee[1][k] = i1; if (e == i0) cand0 = -INFINITY; if (e == i1) cand1 = -INFINITY; }
#undef TOPK_STEP
#pragma unroll
            for (int r = 0; r < 2; ++r) { int te[4]; float tv[4];
#pragma unroll
                for (int k = 0; k < 4; ++k) { te[k] = tee[r][k]; tv[k] = tvv[r][k]; }
                const float e1 = __expf(tv[1] - tv[0]), e2 = __expf(tv[2] - tv[0]), e3 = __expf(tv[3] - tv[0]); const float inv = 1.0f / (1.0f + e1 + e2 + e3);
                if (lane < 4) { const int ek = lane == 0 ? te[0] : lane == 1 ? te[1] : lane == 2 ? te[2] : te[3]; const float gk = (lane == 0 ? 1.0f : lane == 1 ? e1 : lane == 2 ? e2 : e3) * inv;
                    const int lr = __hip_atomic_fetch_add(&lcnt[ek], 1, __ATOMIC_RELAXED, __HIP_MEMORY_SCOPE_WORKGROUP); const int rl = rl0 + r;
                    rinfo[(rl * 4 + lane) * 3 + 0] = ek; rinfo[(rl * 4 + lane) * 3 + 1] = lr; rinfo[(rl * 4 + lane) * 3 + 2] = __float_as_int(gk); } }
        }
        __syncthreads();
        if (tid < 32) gbase[tid] = (int)__hip_atomic_fetch_add(F.ctl + CW_CNT + 64 * tid, (unsigned)lcnt[tid], RLX_AGENT);
        __syncthreads();
        if (tid < 256) { const int rl = tid >> 2, k = tid & 3, row = rb * 64 + rl; const int ek = rinfo[tid * 3], rank = gbase[ek] + rinfo[tid * 3 + 1];
            ((int*)(F.ws + WS_TOKE))[row * 4 + k] = ek; ((int*)(F.ws + WS_TOKR))[row * 4 + k] = rank; ((int*)(F.ws + WS_TOKG))[row * 4 + k] = rinfo[tid * 3 + 2];
            ((int*)(F.ws + WS_ROWTOK))[(size_t)ek * ECAP + rank] = row; }
        __syncthreads();
    }
}

struct MoeTabs { LAS int* cnt; LAS int* tbase; LAS int* tile_e; LAS int* tile_r0; LAS int* idx; };
__device__ __forceinline__ MoeTabs moe_tabs(const Frame& F) { MoeTabs t; t.cnt = (LAS int*)(F.lds + TAB_OFF); t.tbase = t.cnt + 32; t.tile_e = t.tbase + 40; t.tile_r0 = t.tile_e + MAXT; t.idx = t.tile_r0 + MAXT; return t; }
__device__ __forceinline__ int moe_build_tabs(const Frame& F, const MoeTabs& T) {
    if (F.tid < 32) T.cnt[F.tid] = (int)__hip_atomic_load(F.ctl + CW_CNT + 64 * F.tid, RLX_AGENT);
    __syncthreads();
    if (F.tid < 32) { int s0 = 0, tot = 0;
#pragma unroll
        for (int e = 0; e < 32; ++e) { const int n = (T.cnt[e] + 255) >> 8; s0 += (e < F.tid) ? n : 0; tot += n; }
        T.tbase[F.tid] = s0; if (F.tid == 0) T.tbase[32] = tot;
        const int n = (T.cnt[F.tid] + 255) >> 8; for (int t = 0; t < n; ++t) { T.tile_e[s0 + t] = F.tid; T.tile_r0[s0 + t] = t * 256; } }
    __syncthreads();
    return T.tbase[32];
}
constexpr int MAXU = 12;
struct MoeUpSched {
    int NT, G, c; LAS const int* tile_e; LAS const int* idx;
    __device__ __forceinline__ bool next(int i, pg8::Unit& u) const { const int L = i * G + c; if (L >= NT * 8 || i >= MAXU) return false; u.pm = L >> 3; u.pn = L & 7; u.e = tile_e[u.pm]; u.ui = i; return true; }
    __device__ __forceinline__ unsigned arow(const pg8::Unit& u, int r) const { return (unsigned)idx[u.ui * 256 + r]; }
    __device__ __forceinline__ size_t boff(const pg8::Unit& u) const { return ((size_t)u.e * 2048 + (size_t)u.pn * 256) * 1024; }
};
struct MoeDownSched {
    int NT, G, c; LAS const int* tile_e;
    __device__ __forceinline__ bool next(int i, pg8::Unit& u) const { const int L = i * G + c; if (L >= NT * 4) return false; u.pm = L >> 2; u.pn = L & 3; u.e = tile_e[u.pm]; u.ui = i; return true; }
    __device__ __forceinline__ unsigned arow(const pg8::Unit& u, int r) const { return (unsigned)(u.pm * 256 + r); }
    __device__ __forceinline__ size_t boff(const pg8::Unit& u) const { return ((size_t)u.e * 1024 + (size_t)u.pn * 256) * 1024; }
};

__device__ __forceinline__ void p11_final(Frame& F, float* dstp) {
    const MoeTabs T = moe_tabs(F); (void)moe_build_tabs(F, T);
    const float* MODF = (const float*)(F.ws + WS_MODF); const int lane = F.lane;
    const bf16* YB = (const bf16*)(F.ws + WS_YB);
    for (int rb = F.vcu; rb < M / 64; rb += F.G) {
        const int b = (rb * 64) / SEQ;
        LAS float* A9 = (LAS float*)(F.lds + TAB_OFF + 16384);
        __syncthreads();
        for (int c0 = F.tid; c0 < 1024; c0 += NTHR) A9[c0] = F.in[7][c0] * MODF[b * 6144 + 5120 + c0];
        __syncthreads();
        const int row0 = rb * 64 + F.wave * 8;
        typedef int i32x4 __attribute__((ext_vector_type(4)));
        const i32x4* TE = (const i32x4*)(F.ws + WS_TOKE); const i32x4* TR = (const i32x4*)(F.ws + WS_TOKR); const f32x4* TG = (const f32x4*)(F.ws + WS_TOKG);
        i32x4 ie1 = TE[row0 + 1], ir1 = TR[row0 + 1]; f32x4 ig0 = TG[row0], ig1 = TG[row0 + 1];
        u32x4 ywc[4][2], ywn[4][2]; f32x4 xwc[4], xwn[4];
        { const i32x4 ie0 = TE[row0], ir0 = TR[row0];
#pragma unroll
          for (int k = 0; k < 4; ++k) { const u32x4* yr = (const u32x4*)(YB + ((size_t)T.tbase[ie0[k]] * 256 + ir0[k]) * 1024) + lane;
#pragma unroll
              for (int jj = 0; jj < 2; ++jj) ywc[k][jj] = yr[64 * jj]; } }
#pragma unroll
        for (int jj = 0; jj < 2; ++jj) { const f32x4* xr = (const f32x4*)(F.out + (size_t)row0 * 1024) + 2 * lane + 128 * jj; xwc[2 * jj] = xr[0]; xwc[2 * jj + 1] = xr[1]; }
#pragma unroll 1
        for (int i = 0; i < 8; ++i) {
            const int row = row0 + i;
            i32x4 ie2 = ie1, ir2 = ir1; f32x4 ig2 = ig1;
            if (i + 2 < 8) { ie2 = TE[row + 2]; ir2 = TR[row + 2]; ig2 = TG[row + 2]; }
            if (i + 1 < 8) {
#pragma unroll
                for (int k = 0; k < 4; ++k) { const u32x4* yr = (const u32x4*)(YB + ((size_t)T.tbase[ie1[k]] * 256 + ir1[k]) * 1024) + lane;
#pragma unroll
                    for (int jj = 0; jj < 2; ++jj) ywn[k][jj] = yr[64 * jj]; }
#pragma unroll
                for (int jj = 0; jj < 2; ++jj) { const f32x4* xr = (const f32x4*)(F.out + (size_t)(row + 1) * 1024) + 2 * lane + 128 * jj; xwn[2 * jj] = xr[0]; xwn[2 * jj + 1] = xr[1]; } }
            f32x4 y[4];
#pragma unroll
            for (int j = 0; j < 4; ++j) y[j] = (f32x4){0.f, 0.f, 0.f, 0.f};
#pragma unroll
            for (int k = 0; k < 4; ++k)
#pragma unroll
                for (int jj = 0; jj < 2; ++jj) { const u32x4 w = ywc[k][jj];
                    y[2 * jj] += (f32x4){bf2f(w.x & 0xffffu), bf2f(w.x >> 16), bf2f(w.y & 0xffffu), bf2f(w.y >> 16)} * ig0[k];
                    y[2 * jj + 1] += (f32x4){bf2f(w.z & 0xffffu), bf2f(w.z >> 16), bf2f(w.w & 0xffffu), bf2f(w.w >> 16)} * ig0[k]; }
            float ss = 0.f;
#pragma unroll
            for (int j = 0; j < 4; ++j) ss += (y[j].x * y[j].x + y[j].y * y[j].y) + (y[j].z * y[j].z + y[j].w * y[j].w);
            const float rs = rsqrtf(wave_sum(ss) * (1.0f / 1024.0f) + EPS);
#pragma unroll
            for (int jj = 0; jj < 2; ++jj) { f32x4* orow = (f32x4*)(dstp + (size_t)row * 1024) + 2 * lane + 128 * jj; const LAS f32x4* a9 = (const LAS f32x4*)(A9 + 8 * lane + 512 * jj);
                orow[0] = xwc[2 * jj] + a9[0] * (y[2 * jj] * rs); orow[1] = xwc[2 * jj + 1] + a9[1] * (y[2 * jj + 1] * rs); }
            ig0 = ig1; ie1 = ie2; ir1 = ir2; ig1 = ig2;
#pragma unroll
            for (int k = 0; k < 4; ++k)
#pragma unroll
                for (int jj = 0; jj < 2; ++jj) ywc[k][jj] = ywn[k][jj];
#pragma unroll
            for (int j = 0; j < 4; ++j) xwc[j] = xwn[j];
        }
    }
}

#ifndef MLSTM_FUSED
#define MLSTM_FUSED 0
#endif
__device__ __forceinline__ void mlstm_fused(Frame& F, int b, int h, int eh) {
    const int tid = F.tid, lane = F.lane, r32 = lane & 31, hi = lane >> 5, wid = F.wave;
    LAS bf16* Qs = (LAS bf16*)F.lds;
    LAS bf16* Qp = Qs + 64 * QS_STRIDE;
    LAS bf16* Ks = Qp + 64 * QS_STRIDE;
    LAS bf16* KT = Ks + 64 * QS_STRIDE;
    LAS bf16* VT = KT + 128 * KT_STRIDE;
    LAS bf16* VwT = VT + 64 * KT_STRIDE;
    LAS bf16* CT = VwT + 64 * KT_STRIDE;
    LAS bf16* Wm = CT + 64 * QS_STRIDE;
    LAS float* fu = (LAS float*)(Wm + 64 * KT_STRIDE);
    LAS float* fmm = fu + 64; LAS float* fiw = fu + 128; LAS float* ffl = fu + 192; LAS float* frd = fu + 256; LAS float* fwx = fu + 320; LAS float* fnp = fu + 384; LAS float* ms = fu + 512;
    const bf16* Z = (const bf16*)(F.ws + WS_Z);
    bf16* Y = (bf16*)(F.ws + WS_YMIX);
    const int e0 = eh * 64;
    for (int i = tid; i < 64 * QS_STRIDE; i += NTHR) CT[i] = 0;
    if (tid < 128) fnp[tid] = 0.f;
    if (tid == 0) ms[0] = -INFINITY;
    f32x16 st = {};
    ConvRaw rq[2], rk[2]; bf16x8 rv; unsigned short og[16]; unsigned short gi_raw = 0, gf_raw = 0;
#define MF_PREFETCH(c_) do { \
        _Pragma("unroll") for (int rep = 0; rep < 2; ++rep) { const int task = tid + NTHR * rep, l = task >> 4, ch = task & 15, t = (c_) * 64 + l; \
            conv8_load(F, b, t, ZC_QM + h * 128 + ch * 8, rq[rep]); conv8_load(F, b, t, ZC_KM + h * 128 + ch * 8, rk[rep]); } \
        { const int l = tid >> 3, chv = tid & 7; rv = *(const bf16x8*)(Z + (size_t)(b * SEQ + (c_) * 64 + l) * ZP + ZC_VM + h * 128 + e0 + chv * 8); } \
        if (wid < 4) { _Pragma("unroll") for (int r = 0; r < 16; ++r) { const int l = (wid & 1) * 32 + crow(r, hi); og[r] = Z[(size_t)(b * SEQ + (c_) * 64 + l) * ZP + ZC_OM + h * 128 + e0 + (wid >> 1) * 32 + r32]; } } \
        if (wid == 0) { const size_t zr_ = (size_t)(b * SEQ + (c_) * 64 + lane) * ZP; gi_raw = Z[zr_ + ZC_IG + h]; gf_raw = Z[zr_ + ZC_FG + h]; } } while (0)
    MF_PREFETCH(0);
    __syncthreads();
    for (int c = 0; c < 64; ++c) {
        if (wid == 0) {
            const float ig = bf2f(gi_raw) + F.in[9][h]; float g = logsigmoidf_(bf2f(gf_raw) + F.in[9][4 + h]);
#pragma unroll
            for (int o = 1; o < 64; o <<= 1) { const float t = __shfl_up(g, o); if (lane >= o) g += t; }
            const float u = ig - g; float pm = u;
#pragma unroll
            for (int o = 1; o < 64; o <<= 1) { const float t = __shfl_up(pm, o); if (lane >= o) pm = fmaxf(pm, t); }
            const float G = __shfl(g, 63), wl = G - g + ig, ml = wave_max(wl);
            const float m_old = ms[0], mm = fmaxf(m_old, pm), m_new = fmaxf(G + m_old, ml);
            fu[lane] = u; fmm[lane] = mm; fiw[lane] = __expf(m_old - mm); ffl[lane] = __expf(-(g + mm)); fwx[lane] = __expf(wl - m_new);
            if (lane == 0) { ms[1] = __expf(G + m_old - m_new); ms[2] = m_new; }
        }
        __syncthreads();
#pragma unroll
        for (int rep = 0; rep < 2; ++rep) { const int task = tid + NTHR * rep, l = task >> 4, ch = task & 15;
            float qq[8], kk[8];
            conv8_calc(F, rq[rep], h * 128 + ch * 8, qq); conv8_calc(F, rk[rep], 512 + h * 128 + ch * 8, kk);
            const float iw = fiw[l], sk = 0.08838834764831845f;
            u32x4 wq, wp, wk;
            wq.x = pk2(qq[0], qq[1]); wq.y = pk2(qq[2], qq[3]); wq.z = pk2(qq[4], qq[5]); wq.w = pk2(qq[6], qq[7]);
            wp.x = pk2(qq[0] * iw, qq[1] * iw); wp.y = pk2(qq[2] * iw, qq[3] * iw); wp.z = pk2(qq[4] * iw, qq[5] * iw); wp.w = pk2(qq[6] * iw, qq[7] * iw);
            wk.x = pk2(kk[0] * sk, kk[1] * sk); wk.y = pk2(kk[2] * sk, kk[3] * sk); wk.z = pk2(kk[4] * sk, kk[5] * sk); wk.w = pk2(kk[6] * sk, kk[7] * sk);
            *(LAS u32x4*)(Qs + l * QS_STRIDE + ch * 8) = wq; *(LAS u32x4*)(Qp + l * QS_STRIDE + ch * 8) = wp; *(LAS u32x4*)(Ks + l * QS_STRIDE + ch * 8) = wk;
#pragma unroll
            for (int j = 0; j < 8; ++j) KT[(ch * 8 + j) * KT_STRIDE + l] = (bf16)f2bf(kk[j] * sk); }
        { const int l = tid >> 3, chv = tid & 7; const float we = fwx[l];
#pragma unroll
            for (int j = 0; j < 8; ++j) { VT[(chv * 8 + j) * KT_STRIDE + l] = (bf16)rv[j]; VwT[(chv * 8 + j) * KT_STRIDE + l] = (bf16)f2bf(bf2f((unsigned short)rv[j]) * we); } }
        unsigned short ogc[16];
#pragma unroll
        for (int r = 0; r < 16; ++r) ogc[r] = og[r];
        if (c + 1 < 64) MF_PREFETCH(c + 1);
        __syncthreads();
        if (wid < 4) {
            const int lt = wid >> 1, stl = wid & 1;
            f32x16 acc = {}; acc = mma32_lds(Qs + lt * 32 * QS_STRIDE, QS_STRIDE, Ks + stl * 32 * QS_STRIDE, QS_STRIDE, 8, r32, hi, acc);
            const int s_ = stl * 32 + r32; const float us = fu[s_];
#pragma unroll
            for (int r = 0; r < 16; ++r) { const int l = lt * 32 + crow(r, hi); const float w = (s_ <= l) ? __expf(us - fmm[l]) * acc[r] : 0.f; Wm[l * KT_STRIDE + s_] = (bf16)f2bf(w); }
        }
        __syncthreads();
        if (tid < 64) { float dsum = 0.f;
#pragma unroll 8
            for (int s_ = 0; s_ < 64; ++s_) dsum += bf2f(Wm[tid * KT_STRIDE + s_]);
#pragma unroll 8
            for (int d = 0; d < 128; ++d) dsum += bf2f(Qp[tid * QS_STRIDE + d]) * fnp[d];
            frd[tid] = 1.0f / fmaxf(fabsf(dsum), ffl[tid]); }
        f32x16 num = {};
        if (wid < 4) { const int lt = wid & 1, et = wid >> 1;
            num = mma32_lds(Wm + lt * 32 * KT_STRIDE, KT_STRIDE, VT + et * 32 * KT_STRIDE, KT_STRIDE, 4, r32, hi, num);
            num = mma32_lds(Qp + lt * 32 * QS_STRIDE, QS_STRIDE, CT + et * 32 * QS_STRIDE, QS_STRIDE, 8, r32, hi, num); }
        { const float a = ms[1];
#pragma unroll
            for (int r = 0; r < 16; ++r) st[r] *= a;
            st = mma32_lds(VwT + (wid & 1) * 32 * KT_STRIDE, KT_STRIDE, KT + (wid >> 1) * 32 * KT_STRIDE, KT_STRIDE, 4, r32, hi, st); }
        __syncthreads();
        if (wid < 4) { const int lt = wid & 1, et = wid >> 1, e = e0 + et * 32 + r32;
#pragma unroll
            for (int r = 0; r < 16; ++r) { const int l = lt * 32 + crow(r, hi); const size_t row = (size_t)(b * SEQ + c * 64 + l);
                Y[row * 1024 + h * 128 + e] = (bf16)f2bf(num[r] * frd[l] * sigmoidf_(bf2f(ogc[r]))); } }
#pragma unroll
        for (int r = 0; r < 16; ++r) CT[((wid & 1) * 32 + crow(r, hi)) * QS_STRIDE + (wid >> 1) * 32 + r32] = (bf16)f2bf(st[r]);
        if (tid >= 256 && tid < 384) { const int d = tid - 256; float s_ = 0.f;
#pragma unroll 8
            for (int l = 0; l < 64; ++l) s_ += fwx[l] * bf2f(KT[d * KT_STRIDE + l]);
            fnp[d] = ms[1] * fnp[d] + s_; }
        __syncthreads();
        if (tid == 0) ms[0] = ms[2];
    }
    __syncthreads();
#undef MF_PREFETCH
}

__device__ __forceinline__ void ph2_zgemm(Frame& F) {
    unsigned char* ws = F.ws;
    pg8::StaticSched S; S.init(M, ZP, 1024, F.G, (int)blockIdx.x);
    pg8::EpiBf16 E{(bf16*)(ws + WS_Z), ZP, nullptr, 0};
    pg8::gemm_phase<false>(F.lds, (const bf16*)(ws + WS_H), (const bf16*)(ws + WS_WIN), 1024, S, E);
}
__device__ __forceinline__ void ph3_local(Frame& F) {
    for (int wi = F.vcu; wi < 256; wi += F.G) p3_compress_item(F, wi);
#if !MLSTM_FUSED
    for (int it = F.vcu; it < 1024; it += F.G) p3_mlstm_a_item(F, it);
#endif
}
#ifndef ATT_PROBE
#define ATT_PROBE -1
#endif
constexpr int CW_AQ = 20480;
__device__ __forceinline__ void ph4_scan_attn(Frame& F) {
#if MLSTM_FUSED
    if (F.vcu < 32) mlstm_fused(F, F.vcu >> 3, (F.vcu >> 1) & 3, F.vcu & 1);
    volatile LAS unsigned* qslot = (volatile LAS unsigned*)(F.lds + LDSCTL_OFF + 512);
    for (;;) {
        __syncthreads();
        if (F.tid == 0) qslot[0] = __hip_atomic_fetch_add(F.ctl + CW_AQ, 1u, RLX_AGENT);
        __syncthreads();
        const int q = (int)qslot[0];
        if (q >= 512) break;
        const int cur = 63 - (q >> 3), bg = q & 7;
        nsa::attn_unit<0>(F, bg >> 1, bg & 1, cur, (bf16*)(F.ws + WS_YMIX), true);
    }
#else
    p4_scan(F); __syncthreads();
    if (ATT_PROBE >= 0) { nsa::p4_attention<(ATT_PROBE < 0 ? 0 : ATT_PROBE)>(F, (bf16*)(F.ws + WS_ACT)); __syncthreads(); }
    nsa::p4_attention<0>(F, (bf16*)(F.ws + WS_YMIX));
#endif
}
__device__ __forceinline__ void ph5_mlstm_out(Frame& F) {
#if !MLSTM_FUSED
    p5_mlstm_c_items(F);
#endif
}
__device__ __forceinline__ void ph6_wout(Frame& F) {
    unsigned char* ws = F.ws;
    pg8::StaticSched S; S.init(M, 1024, 1024, F.G, (int)blockIdx.x);
    pg8::EpiBf16 E{(bf16*)(ws + WS_Y), 1024, nullptr, 0};
    pg8::gemm_phase<false>(F.lds, (const bf16*)(ws + WS_YMIX), (const bf16*)(ws + WS_WOUT), 1024, S, E);
}
__device__ __forceinline__ void ph8_up(Frame& F) {
    unsigned char* ws = F.ws;
    const MoeTabs T = moe_tabs(F); const int NT = moe_build_tabs(F, T);
    const int* rowtok = (const int*)(ws + WS_ROWTOK);
    for (int i = 0; i < MAXU; ++i) { const int L = i * F.G + F.vcu; if (L >= NT * 8) break; const int t = L >> 3, e = T.tile_e[t], r0 = T.tile_r0[t];
        for (int r = F.tid; r < 256; r += NTHR) { const int gi = r0 + r; T.idx[i * 256 + r] = gi < T.cnt[e] ? rowtok[(size_t)e * ECAP + gi] : 0; } }
    __syncthreads();
    MoeUpSched S{NT, F.G, F.vcu, T.tile_e, T.idx};
    pg8::EpiSwiglu E{(unsigned char*)(ws + WS_ACT), F.in[20]};
    pg8::gemm_phase<true>(F.lds, (const bf16*)(ws + WS_H), (const bf16*)(ws + WS_WUP), 512, S, E);
}
__device__ __forceinline__ void ph9_down(Frame& F) {
    unsigned char* ws = F.ws;
    const MoeTabs T = moe_tabs(F); const int NT = moe_build_tabs(F, T);
    MoeDownSched S{NT, F.G, F.vcu, T.tile_e};
    pg8::EpiBf16 E{(bf16*)(ws + WS_YB), 1024, F.in[22], 1024};
    pg8::gemm_phase<true>(F.lds, (const bf16*)(ws + WS_ACT), (const bf16*)(ws + WS_WDN), 512, S, E);
}

constexpr int N_PHASES = 11;
struct Args { const float* in[23]; float* out; unsigned char* ws; int ph_lo, ph_hi; };
__global__ void __launch_bounds__(NTHR, 2) hybrid_fwd(Args args) {
    extern __shared__ __attribute__((aligned(16))) unsigned char lds_raw[];
    Frame F;
    F.lds = (LAS unsigned char*)lds_raw;
    F.tid = threadIdx.x; F.lane = F.tid & 63; F.wave = __builtin_amdgcn_readfirstlane(F.tid >> 6);
    F.G = gridDim.x; { const int bx = blockIdx.x; F.vcu = (F.G % 8 == 0) ? (bx % 8) * (F.G / 8) + bx / 8 : bx; }
    F.ws = args.ws; F.ctl = (unsigned*)(args.ws + WS_CTL); F.out = args.out;
    F.in = (const float* const __attribute__((address_space(4)))*)__builtin_amdgcn_kernarg_segment_ptr();
    for (int u = F.tid; u < (LDS_BYTES - LDSCTL_OFF) / 4; u += NTHR) ((LAS unsigned*)(F.lds + LDSCTL_OFF))[u] = 0u;
    __syncthreads();
    volatile LAS unsigned* MISC = (volatile LAS unsigned*)(F.lds + MISC_OFF);
    XcdBarrier bar; bar.bar = F.ctl + CW_BAR; bar.x = 0; bar.st = nullptr;
    if (!MK_PER_PHASE) bar = xcd_barrier_post(F.ctl + CW_BAR, MISC + 8);
    const int lo = args.ph_lo, hi = args.ph_hi;
#ifndef PH_MASK
#define PH_MASK 0x7ff
#endif
#define IN(k) (((PH_MASK >> (k)) & 1) && lo <= (k) && (k) < hi)
#define SEAM(k) do { if (IN(k) && IN((k) + 1)) xcd_barrier(bar); } while (0)
#ifndef PH_TWICE
#define PH_TWICE 0
#endif
#define RUNPH(k, call) do { if (IN(k)) { call; if ((PH_TWICE >> (k)) & 1) { xcd_barrier(bar); call; } } } while (0)
    RUNPH(0, p0_prologue(F)); SEAM(0);
    RUNPH(1, p1_rows(F)); SEAM(1);
    RUNPH(2, ph2_zgemm(F)); SEAM(2);
    RUNPH(3, ph3_local(F)); SEAM(3);
    RUNPH(4, ph4_scan_attn(F));
#if !MLSTM_FUSED
    SEAM(4);
#endif
    RUNPH(5, ph5_mlstm_out(F)); SEAM(5);
    RUNPH(6, ph6_wout(F)); SEAM(6);
    RUNPH(7, p7_rows(F)); SEAM(7);
    RUNPH(8, ph8_up(F)); SEAM(8);
    RUNPH(9, ph9_down(F)); SEAM(9);
#ifdef P10_TWICE
    if (IN(10)) { p11_final(F, (float*)(F.ws + WS_DC)); xcd_barrier(bar); }
#endif
    RUNPH(10, p11_final(F, F.out));
#ifdef EXTRA_BARS
#pragma unroll 1
    for (int eb = 0; eb < EXTRA_BARS; ++eb) xcd_barrier(bar);
#endif
#undef RUNPH
#undef IN
#undef SEAM
}

extern "C" void kernel_launch(void* const* d_in, const int* in_sizes, int n_in, void* d_out, int out_size, void* d_ws, size_t ws_size, hipStream_t stream) {
    static int grid = 0;
    if (grid == 0) {
        if (n_in != 23 || out_size != M * D || ws_size < WS_END) { fprintf(stderr, "kernel_launch: unexpected shapes (n_in %d out %d ws %zu)\n", n_in, out_size, ws_size); grid = -1; return; }
        int dev = 0, cus = 0;
        if (hipGetDevice(&dev) != hipSuccess || hipDeviceGetAttribute(&cus, hipDeviceAttributeMultiprocessorCount, dev) != hipSuccess) { grid = -1; return; }
        if (hipFuncSetAttribute((const void*)hybrid_fwd, hipFuncAttributeMaxDynamicSharedMemorySize, LDS_BYTES) != hipSuccess) { fprintf(stderr, "kernel_launch: hipFuncSetAttribute failed\n"); grid = -1; return; }
        int per_cu = 0;
        if (hipOccupancyMaxActiveBlocksPerMultiprocessor(&per_cu, (const void*)hybrid_fwd, NTHR, LDS_BYTES) != hipSuccess || per_cu < 1) fprintf(stderr, "kernel_launch: occupancy query reports %d\n", per_cu);
        (void)hipGetLastError();
        grid = cus > 256 ? 256 : cus;
    }
    if (grid < 0) return;
    (void)hipMemsetAsync((char*)d_ws + WS_CTL, 0, CTL_ZERO_BYTES, stream);
    Args a{};
    for (int i = 0; i < 23; ++i) a.in[i] = (const float*)d_in[i];
    a.out = (float*)d_out; a.ws = (unsigned char*)d_ws;
#if MK_PER_PHASE
    for (int p = 0; p < N_PHASES; ++p) { a.ph_lo = p; a.ph_hi = p + 1; hipLaunchKernelGGL(hybrid_fwd, dim3(grid), dim3(NTHR), LDS_BYTES, stream, a); }
#else
    a.ph_lo = 0; a.ph_hi = N_PHASES;
    hipLaunchKernelGGL(hybrid_fwd, dim3(grid), dim3(NTHR), LDS_BYTES, stream, a);
#endif
}
```

```cpp
#include <hip/hip_runtime.h>
#include <cstdio>
#include <cstdint>
#include <cmath>

#define GAS __attribute__((address_space(1)))
#define LAS __attribute__((address_space(3)))
typedef unsigned short bf16;
typedef short bf16x8 __attribute__((ext_vector_type(8)));
typedef short s16x4 __attribute__((ext_vector_type(4)));
typedef float f32x4 __attribute__((ext_vector_type(4)));
typedef float f32x2 __attribute__((ext_vector_type(2)));
typedef float f32x16 __attribute__((ext_vector_type(16)));
typedef unsigned u32x4 __attribute__((ext_vector_type(4)));
typedef unsigned u32x2 __attribute__((ext_vector_type(2)));

#ifndef MK_PER_PHASE
#define MK_PER_PHASE 0
#endif

constexpr int BATCH = 4, SEQ = 4096, D = 1024, M = BATCH * SEQ;
constexpr int D_IN = 3360, ZP = 3584;
constexpr int ZC_QM = 0, ZC_KM = 512, ZC_VM = 1024, ZC_OM = 1536, ZC_QA = 2048, ZC_KC = 2560, ZC_VC = 2688, ZC_KS = 2816, ZC_VS = 2944,
              ZC_KW = 3072, ZC_VW = 3200, ZC_IG = 3328, ZC_FG = 3332, ZC_GA = 3336;
constexpr int NEXP = 32, TOPK = 4, ECAP = 16384, MAXT = 288;
constexpr float EPS = 1e-6f;
constexpr int NWAVES = 8, NTHR = 512;

constexpr size_t MiB = 1u << 20;
constexpr size_t WS_CTL = 0, CTL_ZERO_BYTES = 1 * MiB;
constexpr size_t WS_MODP = 1 * MiB;
constexpr size_t WS_MODF = 2 * MiB;
constexpr size_t WS_CMPB = 2 * MiB + 128 * 1024;
constexpr size_t WS_WCMP = 3 * MiB;
constexpr size_t WS_WIN = 4 * MiB;
constexpr size_t WS_WOUT = 12 * MiB;
constexpr size_t WS_WRT = 14 * MiB;
constexpr size_t WS_WUP = 16 * MiB;
constexpr size_t WS_WDN = 144 * MiB;
constexpr size_t WS_H = 208 * MiB;
constexpr size_t WS_Z = 240 * MiB;
constexpr size_t WS_YMIX = 352 * MiB;
constexpr size_t WS_Y = 384 * MiB;
constexpr size_t WS_DC = 416 * MiB;
constexpr size_t WS_DN = 480 * MiB;
constexpr size_t WS_SC = 481 * MiB;
constexpr size_t WS_KC = 482 * MiB;
constexpr size_t WS_VC = 483 * MiB;
constexpr size_t WS_ACT = 484 * MiB;
constexpr size_t WS_YB = 628 * MiB;
constexpr size_t WS_TOKE = 772 * MiB;
constexpr size_t WS_TOKR = 772 * MiB + 256 * 1024;
constexpr size_t WS_TOKG = 772 * MiB + 512 * 1024;
constexpr size_t WS_ROWTOK = 774 * MiB;
constexpr size_t WS_CP = 776 * MiB;
constexpr size_t WS_NP = 840 * MiB;
constexpr size_t WS_END = 841 * MiB;
constexpr int CW_TMO = 0, CW_BAR = 4096, CW_CNT = 16384;

constexpr int RING_BYTES = 131072;
constexpr int LDSCTL_OFF = RING_BYTES, MISC_OFF = LDSCTL_OFF + 320;
constexpr int TAB_OFF = LDSCTL_OFF + 1024;
constexpr int LDS_BYTES = 163840;

#define RLX_AGENT __ATOMIC_RELAXED, __HIP_MEMORY_SCOPE_AGENT
__device__ __forceinline__ float bf2f(unsigned v) { return __uint_as_float(v << 16); }
__device__ __forceinline__ unsigned f2bf(float f) { unsigned u = __float_as_uint(f); return (u + 0x7fffu + ((u >> 16) & 1u)) >> 16; }
__device__ __forceinline__ unsigned pk2(float lo, float hi) { unsigned r; asm volatile("v_cvt_pk_bf16_f32 %0, %1, %2" : "=v"(r) : "v"(lo), "v"(hi)); return r; }
__device__ __forceinline__ unsigned pk4_fp8(float a, float b, float c, float d) { int w = 0; w = __builtin_amdgcn_cvt_pk_fp8_f32(a, b, w, false); w = __builtin_amdgcn_cvt_pk_fp8_f32(c, d, w, true); return (unsigned)w; }
template <int MASK> __device__ __forceinline__ float xchg_f(float x, int lane) {
    if constexpr (MASK == 1) return __int_as_float(__builtin_amdgcn_mov_dpp(__float_as_int(x), 0xB1, 0xF, 0xF, true));
    else if constexpr (MASK == 2) return __int_as_float(__builtin_amdgcn_mov_dpp(__float_as_int(x), 0x4E, 0xF, 0xF, true));
    else if constexpr (MASK == 32) { auto rr = __builtin_amdgcn_permlane32_swap(__float_as_uint(x), __float_as_uint(x), false, false); return __uint_as_float((lane >> 5) ? rr[0] : rr[1]); }
    else return __shfl_xor(x, MASK);
}
template <int MASK> __device__ __forceinline__ int xchg_i(int x, int lane) { return __float_as_int(xchg_f<MASK>(__int_as_float(x), lane)); }
__device__ __forceinline__ float wave_sum(float v) {
    const int lane = threadIdx.x & 63;
    v += xchg_f<1>(v, lane); v += xchg_f<2>(v, lane); v += xchg_f<4>(v, lane); v += xchg_f<8>(v, lane); v += xchg_f<16>(v, lane); v += xchg_f<32>(v, lane);
    return v;
}
__device__ __forceinline__ float wave_max(float v) {
#pragma unroll
    for (int o = 1; o < 64; o <<= 1) v = fmaxf(v, __shfl_xor(v, o));
    return v;
}
__device__ __forceinline__ float sigmoidf_(float x) { return __builtin_amdgcn_rcpf(1.0f + __builtin_amdgcn_exp2f(-1.4426950408889634f * x)); }
__device__ __forceinline__ float siluf_(float x) { return x * sigmoidf_(x); }
__device__ __forceinline__ float logsigmoidf_(float x) { return fminf(x, 0.f) - log1pf(__expf(-fabsf(x))); }
__device__ __forceinline__ int crow(int r, int hi) { return (r & 3) + 8 * (r >> 2) + 4 * hi; }

__device__ __constant__ unsigned char T5B[128] = {0, 1, 2, 3, 4, 5, 6, 7, 8, 9, 10, 11, 12, 13, 14, 15, 16, 16, 16, 17, 17, 18, 18, 18, 19, 19, 19, 20, 20, 20, 20, 21, 21, 21, 21, 22, 22, 22, 22, 22, 23, 23, 23, 23, 23, 23, 24, 24, 24, 24, 24, 24, 25, 25, 25, 25, 25, 25, 25, 26, 26, 26, 26, 26, 26, 26, 26, 27, 27, 27, 27, 27, 27, 27, 27, 27, 27, 28, 28, 28, 28, 28, 28, 28, 28, 28, 28, 29, 29, 29, 29, 29, 29, 29, 29, 29, 29, 29, 29, 30, 30, 30, 30, 30, 30, 30, 30, 30, 30, 30, 30, 30, 30, 31, 31, 31, 31, 31, 31, 31, 31, 31, 31, 31, 31, 31, 31, 31};

namespace pg8 {
typedef int v8i32 __attribute__((ext_vector_type(8)));
typedef int v4i32 __attribute__((ext_vector_type(4)));
constexpr int BM = 256, BK = 64, HALF = 128, HTB = HALF * BK * 2, STAGE_BYTES = 8 * HTB, NXCD = 8, WGM = 8;
__host__ __device__ __forceinline__ int lds_byte(int r, int c) { const int st = (r >> 4) * 2 + (c >> 5), rr = r & 15, cc = c & 31, ob = rr * 64 + cc * 2; return st * 1024 + (ob ^ (((ob >> 9) & 1) << 5)); }
__host__ __device__ __forceinline__ void stage_rc(int b, int& R, int& C) { const int st = b / 1024, sb = b % 1024, swz = sb ^ (((sb >> 9) & 1) << 5); R = (st >> 1) * 16 + swz / 64; C = (st & 1) * 32 + (swz % 64) / 2; }
__host__ __device__ __forceinline__ int perm32(int rho) { const int n = rho >> 4, i = rho & 15; return 8 * (i >> 2) + 4 * n + (i & 3); }

__device__ __forceinline__ void glds16_s(const char* sbase, unsigned voff, unsigned lds_dst) { unsigned keep;
    asm volatile("s_mov_b32 %0, m0\n\ts_mov_b32 m0, %3\n\ts_nop 0\n\tglobal_load_lds_dwordx4 %1, %2\n\ts_mov_b32 m0, %0" : "=&s"(keep) : "v"(voff), "s"(sbase), "s"(lds_dst) : "memory"); }
__device__ __forceinline__ const char* uniform_ptr(const char* p) { const unsigned long long v = (unsigned long long)p;
    return (const char*)(((unsigned long long)(unsigned)__builtin_amdgcn_readfirstlane((int)(v >> 32)) << 32) | (unsigned)__builtin_amdgcn_readfirstlane((int)v)); }
struct Unit { int pm, pn, e, ui; };

struct StaticSched {
    int nM, nN, nwg, G, c, K;
    __device__ void init(int M_, int N_, int K_, int G_, int c_) { nM = M_ / BM; nN = N_ / BM; nwg = nM * nN; G = G_; c = c_; K = K_; }
    __device__ __forceinline__ bool next(int i, Unit& u) const {
        const long L = (long)i * G + c; if (L >= nwg) return false;
        int wgid = (int)L; { const int q = nwg / NXCD, r = nwg % NXCD, xcd = wgid % NXCD, off = wgid / NXCD; wgid = (xcd < r ? xcd * (q + 1) : r * (q + 1) + (xcd - r) * q) + off; }
        const int nig = WGM * nN, gid = wgid / nig, fm = gid * WGM, gsz = (nM - fm) < WGM ? (nM - fm) : WGM;
        u.pm = fm + ((wgid % nig) % gsz); u.pn = (wgid % nig) / gsz; u.e = 0; u.ui = i; return true;
    }
    __device__ __forceinline__ unsigned arow(const Unit& u, int r) const { return (unsigned)(u.pm * BM + r); }
    __device__ __forceinline__ size_t boff(const Unit& u) const { return (size_t)u.pn * BM * K * 2; }
};

struct EpiBf16 {
    bf16* O; int ldc; const float* bias; int bstride;
    __device__ __forceinline__ void operator()(const f32x4 (&acc)[2][2][4][2], const Unit& u, int wr, int wc, int fr, int fq) const {
        const int row0 = u.pm * BM + wr * 64 + fr; const int col0 = u.pn * BM + wc * 32 + 8 * fq;
#pragma unroll
        for (int bj = 0; bj < 2; ++bj) {
            f32x4 bv0 = (f32x4){0.f, 0.f, 0.f, 0.f}, bv1 = bv0;
            if (bias) { bv0 = *(const f32x4*)(bias + (size_t)u.e * bstride + col0 + bj * HALF); bv1 = *(const f32x4*)(bias + (size_t)u.e * bstride + col0 + bj * HALF + 4); }
#pragma unroll
            for (int ai = 0; ai < 2; ++ai)
#pragma unroll
                for (int m = 0; m < 4; ++m) { bf16* rowp = O + (size_t)(row0 + ai * HALF + m * 16) * ldc + col0;
                    const f32x4 v0 = acc[ai][bj][m][0] + bv0, v1 = acc[ai][bj][m][1] + bv1;
                    u32x4 w; w.x = pk2(v0[0], v0[1]); w.y = pk2(v0[2], v0[3]); w.z = pk2(v1[0], v1[1]); w.w = pk2(v1[2], v1[3]);
                    *(u32x4*)(rowp + bj * HALF) = w; } }
    }
};
struct EpiSwiglu {
    unsigned char* O; const float* bup;
    __device__ __forceinline__ void operator()(const f32x4 (&acc)[2][2][4][2], const Unit& u, int wr, int wc, int fr, int fq) const {
        const int row0 = u.pm * BM + wr * 64 + fr; const int c0 = u.pn * HALF + wc * 32 + 8 * fq;
        const float* bg = bup + (size_t)u.e * 2048 + c0; const float* bl = bg + 1024;
        const f32x4 g0 = *(const f32x4*)bg, g1 = *(const f32x4*)(bg + 4), l0 = *(const f32x4*)bl, l1 = *(const f32x4*)(bl + 4);
#pragma unroll
        for (int ai = 0; ai < 2; ++ai)
#pragma unroll
            for (int m = 0; m < 4; ++m) { unsigned char* rowp = O + (size_t)(row0 + ai * HALF + m * 16) * 1024 + c0;
                float a[8];
#pragma unroll
                for (int n = 0; n < 2; ++n) { const f32x4 gv = acc[ai][0][m][n] + (n ? g1 : g0), lv = acc[ai][1][m][n] + (n ? l1 : l0);
#pragma unroll
                    for (int j2 = 0; j2 < 2; ++j2) {
                        f32x2 gl = {fminf(gv[2 * j2], 7.0f), fminf(gv[2 * j2 + 1], 7.0f)};
                        f32x2 li = {__builtin_amdgcn_fmed3f(lv[2 * j2], -7.0f, 7.0f), __builtin_amdgcn_fmed3f(lv[2 * j2 + 1], -7.0f, 7.0f)};
                        const f32x2 ea = gl * (-1.702f * 1.4426950408889634f);
                        f32x2 d = {__builtin_amdgcn_exp2f(ea.x), __builtin_amdgcn_exp2f(ea.y)}; d = d + 1.0f;
                        const f32x2 r = {__builtin_amdgcn_rcpf(d.x), __builtin_amdgcn_rcpf(d.y)};
                        const f32x2 t = gl * r, o = __builtin_elementwise_fma(t, li, t);
                        a[n * 4 + 2 * j2] = o.x; a[n * 4 + 2 * j2 + 1] = o.y; } }
                u32x2 w; w.x = pk4_fp8(a[0], a[1], a[2], a[3]); w.y = pk4_fp8(a[4], a[5], a[6], a[7]);
                *(u32x2*)rowp = w; }
    }
};

template <bool FP8, class Epi, class Sched>
__device__ __forceinline__ void gemm_phase(LAS unsigned char* lds, const bf16* Abase, const bf16* Bbase, const int K, const Sched& S, const Epi& E) {
    const int tid = threadIdx.x, wid = __builtin_amdgcn_readfirstlane(tid >> 6), lane = tid & 63, wr = wid >> 2, wc = wid & 3, fr = lane & 15, fq = lane >> 4;
    const int nt = K / BK;
    unsigned voffB[2];
#pragma unroll
    for (int i = 0; i < 2; ++i) { int R, C; stage_rc(tid * 16 + i * 8192, R, C); const int Rb = (R & ~31) + perm32(R & 31); voffB[i] = (unsigned)(Rb * K + C) * 2u; }
    const size_t kstep = (size_t)(BK * 2);
    const size_t hstepB = (size_t)HALF * K * 2;
    const unsigned rowB = (unsigned)K * 2u;
    const unsigned ldsb = (unsigned)__builtin_amdgcn_readfirstlane((int)((unsigned)(unsigned long long)lds + (unsigned)wid * 1024u));
    const int aoff = lds_byte(wr * 64 + fr, fq * 8), boff = lds_byte(wc * 32 + fr, fq * 8);
#define PG8_SA(b, h) (((b) * 2 + (h)) * HTB)
#define PG8_SB(b, h) ((4 + (b) * 2 + (h)) * HTB)
#define PG8_STAGE(bufoff, gbase, voff) do { _Pragma("unroll") for (int _i = 0; _i < 2; ++_i) glds16_s(gbase, (voff)[_i], ldsb + (unsigned)((bufoff) + _i * 8192)); } while (0)
#define PG8_LD16(off) (*(const LAS v4i32*)(lds + (off)))
#define PG8_LDA(dst, b, h) do { if constexpr (FP8) { _Pragma("unroll") for (int m = 0; m < 4; ++m) dst##8[m] = __builtin_shufflevector(PG8_LD16(PG8_SA(b, h) + aoff + m * 2048), PG8_LD16(PG8_SA(b, h) + aoff + m * 2048 + 1024), 0, 1, 2, 3, 4, 5, 6, 7); } \
        else { _Pragma("unroll") for (int m = 0; m < 4; ++m) _Pragma("unroll") for (int k = 0; k < 2; ++k) dst##4[m][k] = *(const LAS bf16x8*)(lds + PG8_SA(b, h) + aoff + m * 2048 + k * 1024); } } while (0)
#define PG8_LDB(dst, b, h) do { if constexpr (FP8) { _Pragma("unroll") for (int n = 0; n < 2; ++n) dst##8[n] = __builtin_shufflevector(PG8_LD16(PG8_SB(b, h) + boff + n * 2048), PG8_LD16(PG8_SB(b, h) + boff + n * 2048 + 1024), 0, 1, 2, 3, 4, 5, 6, 7); } \
        else { _Pragma("unroll") for (int n = 0; n < 2; ++n) _Pragma("unroll") for (int k = 0; k < 2; ++k) dst##4[n][k] = *(const LAS bf16x8*)(lds + PG8_SB(b, h) + boff + n * 2048 + k * 1024); } } while (0)
#define PG8_MMA(ai, bj, At, Bt) do { __builtin_amdgcn_s_setprio(1); _Pragma("unroll") for (int m = 0; m < 4; ++m) _Pragma("unroll") for (int n = 0; n < 2; ++n) { \
        if constexpr (FP8) { asm volatile("v_mfma_scale_f32_16x16x128_f8f6f4 %0, %1, %2, %0, %3, %4 op_sel_hi:[0,0,0]" : "+v"(acc[ai][bj][m][n]) : "v"(Bt##8[n]), "v"(At##8[m]), "v"(scl), "v"(scl)); } \
        else { _Pragma("unroll") for (int k = 0; k < 2; ++k) acc[ai][bj][m][n] = __builtin_amdgcn_mfma_f32_16x16x32_bf16(Bt##4[n][k], At##4[m][k], acc[ai][bj][m][n], 0, 0, 0); } } \
        __builtin_amdgcn_s_setprio(0); } while (0)
#define PG8_WAIT_V(n) asm volatile("s_waitcnt vmcnt(" #n ")" ::: "memory")
#define PG8_WAIT_L(n) asm volatile("s_waitcnt lgkmcnt(" #n ")" ::: "memory")
#define PG8_BAR __builtin_amdgcn_s_barrier()
#define PG8_SCHED __builtin_amdgcn_sched_barrier(0)
#define PG8_MKVA(dst, u) do { _Pragma("unroll") for (int _i = 0; _i < 2; ++_i) { int R_, C_; stage_rc(tid * 16 + _i * 8192, R_, C_); _Pragma("unroll") for (int _h = 0; _h < 2; ++_h) dst[_h][_i] = S.arow(u, _h * HALF + R_) * rowB + (unsigned)C_ * 2u; } } while (0)
    Unit cur, nxt; int ui = 0;
    if (!S.next(0, cur)) return;
    f32x4 acc[2][2][4][2];
#pragma unroll
    for (int a = 0; a < 2; ++a)
#pragma unroll
        for (int b = 0; b < 2; ++b)
#pragma unroll
            for (int m = 0; m < 4; ++m)
#pragma unroll
                for (int n = 0; n < 2; ++n) acc[a][b][m][n] = (f32x4){0.f, 0.f, 0.f, 0.f};
    v8i32 At8[4], B08[2], B18[2]; bf16x8 At4[4][2], B04[2][2], B14[2][2];
    const unsigned scl = 0x7c7c7c7cu;
    unsigned vc[2][2];
    PG8_MKVA(vc, cur);
    const char* cA = uniform_ptr((const char*)Abase);
    const char* cB = uniform_ptr((const char*)Bbase + S.boff(cur));
    PG8_STAGE(PG8_SB(0, 0), cB, voffB); PG8_STAGE(PG8_SB(0, 1), cB + hstepB, voffB); PG8_STAGE(PG8_SA(0, 0), cA, vc[0]); PG8_STAGE(PG8_SA(0, 1), cA, vc[1]);
    if (wr == 1) PG8_BAR;
    PG8_WAIT_V(2); PG8_BAR;
    PG8_STAGE(PG8_SB(1, 0), cB + kstep, voffB); PG8_STAGE(PG8_SA(1, 0), cA + kstep, vc[0]); PG8_STAGE(PG8_SB(1, 1), cB + hstepB + kstep, voffB);
    PG8_WAIT_V(6); PG8_BAR;
    for (;;) {
        const bool has_next = S.next(ui + 1, nxt);
        const char* nB = uniform_ptr(has_next ? (const char*)Bbase + S.boff(nxt) : cB);
#pragma unroll 1
        for (int t = 0; t < nt; t += 2) {
            const bool last = (t == nt - 2);
            const char* a1 = cA + (size_t)(t + 1) * kstep;
            const char* a2 = last ? cA : cA + (size_t)(t + 2) * kstep; const char* b2 = last ? nB : cB + (size_t)(t + 2) * kstep;
            const char* a3 = a2 + kstep; const char* b3 = b2 + kstep;
            unsigned v2a[2], v2b[2];
#pragma unroll
            for (int i = 0; i < 2; ++i) { v2a[i] = vc[0][i]; v2b[i] = vc[1][i]; }
            if (last && has_next) {
#pragma unroll
                for (int i = 0; i < 2; ++i) { int R_, C_; stage_rc(tid * 16 + i * 8192, R_, C_); v2a[i] = S.arow(nxt, R_) * rowB + (unsigned)C_ * 2u; v2b[i] = S.arow(nxt, HALF + R_) * rowB + (unsigned)C_ * 2u; } }
            PG8_LDB(B0, 0, 0); PG8_LDB(B1, 0, 1); PG8_SCHED; PG8_LDA(At, 0, 0); PG8_STAGE(PG8_SA(1, 1), a1, vc[1]);
            PG8_WAIT_V(8); PG8_WAIT_L(0); PG8_BAR; PG8_MMA(0, 0, At, B0); PG8_MMA(0, 1, At, B1); PG8_BAR; PG8_SCHED;
            PG8_LDA(At, 0, 1); PG8_STAGE(PG8_SB(0, 0), b2, voffB); PG8_STAGE(PG8_SB(0, 1), b2 + hstepB, voffB); PG8_STAGE(PG8_SA(0, 0), a2, v2a);
            PG8_WAIT_V(8); PG8_WAIT_L(0); PG8_BAR; PG8_MMA(1, 0, At, B0); PG8_MMA(1, 1, At, B1); PG8_BAR; PG8_SCHED;
            PG8_LDB(B0, 1, 0); PG8_LDB(B1, 1, 1); PG8_SCHED; PG8_LDA(At, 1, 0); PG8_STAGE(PG8_SA(0, 1), a2, v2b);
            PG8_WAIT_V(8); PG8_WAIT_L(0); PG8_BAR; PG8_MMA(0, 0, At, B0); PG8_MMA(0, 1, At, B1); PG8_BAR; PG8_SCHED;
            PG8_LDA(At, 1, 1); PG8_STAGE(PG8_SB(1, 0), b3, voffB); PG8_STAGE(PG8_SB(1, 1), b3 + hstepB, voffB); PG8_STAGE(PG8_SA(1, 0), a3, v2a);
            PG8_WAIT_V(8); PG8_WAIT_L(0); PG8_BAR; PG8_MMA(1, 0, At, B0); PG8_MMA(1, 1, At, B1); PG8_BAR; PG8_SCHED;
        }
        if (wr == 0) PG8_BAR;
        if constexpr (FP8) asm volatile("s_nop 15\n\ts_nop 15" ::: "memory");
        E(acc, cur, wr, wc, fr, fq);
        if (!has_next) break;
#pragma unroll
        for (int a = 0; a < 2; ++a)
#pragma unroll
            for (int b = 0; b < 2; ++b)
#pragma unroll
                for (int m = 0; m < 4; ++m)
#pragma unroll
                    for (int n = 0; n < 2; ++n) acc[a][b][m][n] = (f32x4){0.f, 0.f, 0.f, 0.f};
        cur = nxt; cB = nB; ++ui;
        PG8_MKVA(vc, cur);
        if (wr == 1) PG8_BAR;
    }
    PG8_WAIT_V(0);
    PG8_BAR;
#undef PG8_SA
#undef PG8_SB
#undef PG8_STAGE
#undef PG8_LDA
#undef PG8_LD16
#undef PG8_LDB
#undef PG8_MMA
#undef PG8_WAIT_V
#undef PG8_WAIT_L
#undef PG8_BAR
#undef PG8_SCHED
#undef PG8_MKVA
}
}

#define XB_TMO      128
#define XB_XCNT(j)  (256  + 64 * (j))
#define XB_XSUB(j)  (1280 + 64 * (j))
#define XB_XGEN(j)  (2304 + 64 * (j))
#define XB_TOP      3328
#define XB_TOPGEN   3392
#define XCD_BAR_WORDS 3456
#define XB_SPIN_CAP (1u << 18)

__device__ __forceinline__ unsigned xb_ld(unsigned* p)              { return __hip_atomic_load(p, __ATOMIC_RELAXED, __HIP_MEMORY_SCOPE_AGENT); }
__device__ __forceinline__ unsigned xb_add(unsigned* p, unsigned v) { return __hip_atomic_fetch_add(p, v, __ATOMIC_RELAXED, __HIP_MEMORY_SCOPE_AGENT); }
__device__ __forceinline__ unsigned xb_xcc_id() { return (unsigned)__builtin_amdgcn_s_getreg((3 << 11) | 20) & 0xFu; }
#define XB_SPIN(cond, bar) do { unsigned _sp = 0; while (cond) { __builtin_amdgcn_s_sleep(1); \
    if ((++_sp & 255u) == 0u) { if (xb_ld(&(bar)[XB_TMO])) break; if (_sp > XB_SPIN_CAP) { atomicAdd(&(bar)[XB_TMO], 1u); break; } } } } while (0)

struct XcdBarrier {
    unsigned* bar; unsigned x;
    volatile LAS unsigned* st;
};
__device__ __forceinline__ XcdBarrier xcd_barrier_post(unsigned* bar, volatile LAS unsigned* st) {
    XcdBarrier b; b.bar = bar; b.x = xb_xcc_id(); b.st = st;
    if (threadIdx.x == 0) (void)xb_add(&bar[XB_XCNT(b.x)], 1u);
    return b;
}
__device__ __forceinline__ void xcd_barrier_complete(unsigned* bar, unsigned x, unsigned& nloc, unsigned& nx) {
    const unsigned G = gridDim.x * gridDim.y * gridDim.z;
    unsigned sum, cnt, mine, sp = 0u;
    for (;;) {
        sum = 0u; cnt = 0u; mine = 0u;
#pragma unroll
        for (unsigned j = 0; j < 16; ++j) { const unsigned c = xb_ld(&bar[XB_XCNT(j)]); sum += c; cnt += (c > 0u) ? 1u : 0u; mine = (j == x) ? c : mine; }
        if (sum == G) break;
        __builtin_amdgcn_s_sleep(1);
        if ((++sp & 255u) == 0u) { if (xb_ld(&bar[XB_TMO])) break; if (sp > XB_SPIN_CAP) { atomicAdd(&bar[XB_TMO], 1u); break; } }
    }
    nloc = mine > 0u ? mine : 1u; nx = cnt > 0u ? cnt : 1u;
}
__device__ __forceinline__ void xcd_barrier(const XcdBarrier& b) {
    asm volatile("s_waitcnt vmcnt(0)" ::: "memory");
    __syncthreads();
    if (threadIdx.x == 0) {
        unsigned* bar = b.bar;
        __builtin_amdgcn_s_waitcnt(0);
        unsigned nloc = b.st[0], nx = b.st[1];
        if (nloc == 0u) { xcd_barrier_complete(bar, b.x, nloc, nx); b.st[0] = nloc; b.st[1] = nx; }
        const unsigned old = xb_add(&bar[XB_XSUB(b.x)], 1u);
        const unsigned gen = old / nloc;
        if (old + 1u == (gen + 1u) * nloc) {
            __builtin_amdgcn_fence(__ATOMIC_RELEASE, "agent");
            asm volatile("s_waitcnt vmcnt(0)" ::: "memory");
            const unsigned og = xb_add(&bar[XB_TOP], 1u);
            const unsigned tg = og / nx;
            if (og + 1u == (tg + 1u) * nx) xb_add(&bar[XB_TOPGEN], 1u);
            else XB_SPIN(xb_ld(&bar[XB_TOPGEN]) == tg, bar);
            __builtin_amdgcn_fence(__ATOMIC_ACQUIRE, "agent");
            xb_add(&bar[XB_XGEN(b.x)], 1u);
            asm volatile("s_waitcnt vmcnt(0)" ::: "memory");
        } else {
            XB_SPIN(xb_ld(&bar[XB_XGEN(b.x)]) == gen, bar);
            __builtin_amdgcn_fence(__ATOMIC_ACQUIRE, "agent");
            asm volatile("s_waitcnt vmcnt(0)" ::: "memory");
        }
    }
    __syncthreads();
}

struct Frame {
    LAS unsigned char* lds;
    unsigned* ctl;
    unsigned char* ws;
    int tid, lane, wave, vcu, G;
    const float* const __attribute__((address_space(4)))* in;
    float* out;
};
#define LDS_WAIT() asm volatile("s_waitcnt lgkmcnt(0)" ::: "memory")
#define VM_WAIT() asm volatile("s_waitcnt vmcnt(0)" ::: "memory")

__device__ __forceinline__ int map_n(int mode, int n) {
    if (mode == 1) return n < 2048 ? n : (n < 2056 ? 3328 + (n - 2048) : (n < 3336 ? n - 8 : n));
    if (mode == 2) return n < 1024 ? ((n >> 7) * 256 + (n & 127)) : (((n - 1024) >> 7) * 256 + 128 + ((n - 1024) & 127));
    return n;
}
template <bool FP8>
__device__ __forceinline__ void p0_transpose_item(const float* W, int K, int N, void* WTv, int mode, LAS float* scr, int item, int lane) {
    const int nblk = N / 32, kb = item / nblk, nb = item % nblk, k0 = 64 * kb, n0 = 32 * nb;
    float tv_[32];
#pragma unroll
    for (int i = 0; i < 32; ++i) { const int kk = 2 * i + (lane >> 5); tv_[i] = W[(size_t)(k0 + kk) * N + n0 + (lane & 31)]; }
#pragma unroll
    for (int i = 0; i < 32; ++i) { const int kk = 2 * i + (lane >> 5); scr[kk * 33 + (lane & 31)] = tv_[i]; }
    LDS_WAIT(); asm volatile("" ::: "memory");
    const int c = lane & 7;
#pragma unroll
    for (int j = 0; j < 4; ++j) { const int n = (lane >> 3) + 8 * j; const LAS float* s = scr + (8 * c) * 33 + n;
        if constexpr (FP8) { u32x2 o; o.x = pk4_fp8(64.f * s[0 * 33], 64.f * s[1 * 33], 64.f * s[2 * 33], 64.f * s[3 * 33]); o.y = pk4_fp8(64.f * s[4 * 33], 64.f * s[5 * 33], 64.f * s[6 * 33], 64.f * s[7 * 33]);
            *(u32x2*)((unsigned char*)WTv + (size_t)map_n(mode, n0 + n) * K + k0 + 8 * c) = o; }
        else { u32x4 o; o.x = pk2(s[0 * 33], s[1 * 33]); o.y = pk2(s[2 * 33], s[3 * 33]); o.z = pk2(s[4 * 33], s[5 * 33]); o.w = pk2(s[6 * 33], s[7 * 33]);
            *(u32x4*)((bf16*)WTv + (size_t)map_n(mode, n0 + n) * K + k0 + 8 * c) = o; } }
    LDS_WAIT(); asm volatile("" ::: "memory");
}
__device__ __forceinline__ void p0_prologue(Frame& F) {
    LAS float* scr = (LAS float*)(F.lds + F.wave * 16384);
    const int gw = F.vcu * NWAVES + F.wave, NGW = F.G * NWAVES, lane = F.lane;
    constexpr int I_ADA = 192, I_CMP = 128, I_WRT = 32, I_PAD = 224, I_WIN = 16 * 105, I_WOUT = 16 * 32, I_WUP = 32 * 16 * 64, I_WDN = 32 * 16 * 32;
    unsigned char* ws = F.ws;
    for (int r = F.vcu; r < I_ADA; r += F.G) {
        const int ks = r / 24, jb = r % 24, j0 = jb * 256 + 4 * lane;
        const float* wa = F.in[2]; const float* c = F.in[1];
        f32x4 acc[4], w4[16];
#pragma unroll
        for (int b = 0; b < 4; ++b) acc[b] = (f32x4){0.f, 0.f, 0.f, 0.f};
#pragma unroll
        for (int kk = 0; kk < 16; ++kk) w4[kk] = __builtin_nontemporal_load((const f32x4*)(wa + (size_t)(ks * 128 + F.wave * 16 + kk) * 6144 + j0));
#pragma unroll
        for (int kk = 0; kk < 16; ++kk) {
#pragma unroll
            for (int b = 0; b < 4; ++b) { const float sv = siluf_(c[b * 1024 + ks * 128 + F.wave * 16 + kk]); acc[b] += w4[kk] * sv; } }
        LAS f32x4* red = (LAS f32x4*)F.lds;
#pragma unroll
        for (int b = 0; b < 4; ++b) red[(F.wave * 4 + b) * 64 + lane] = acc[b];
        __syncthreads();
        if (F.tid < 256) { const int b = F.tid >> 6, ln = F.tid & 63; f32x4 sum = red[b * 64 + ln];
#pragma unroll
            for (int w = 1; w < 8; ++w) sum += red[(w * 4 + b) * 64 + ln];
            *(f32x4*)((float*)(ws + WS_MODP) + (size_t)(ks * 4 + b) * 6144 + jb * 256 + 4 * ln) = sum; }
        __syncthreads();
    }
    for (int it = gw; it < I_CMP + I_WRT + I_PAD; it += NGW) {
        int r = it;
        if (r < I_CMP) {
            const int kv = r >> 6, e = r & 63; const float* w = kv ? F.in[12] : F.in[11]; const float* pos = kv ? F.in[14] : F.in[13];
            bf16* wt = (bf16*)(ws + WS_WCMP) + (size_t)(kv * 64 + e) * 2048; float s = 0.f;
            for (int k = lane; k < 2048; k += 64) { const float v = w[(size_t)k * 64 + e]; wt[k] = (bf16)f2bf(v); s += pos[k] * v; }
            s = wave_sum(s); if (lane == 0) ((float*)(ws + WS_CMPB))[kv * 64 + e] = s;
            continue; }
        r -= I_CMP;
        if (r < I_WRT) { const float* wr_ = F.in[17]; float* wt = (float*)(ws + WS_WRT) + (size_t)r * 1024;
            for (int k = lane; k < 1024; k += 64) wt[k] = wr_[(size_t)k * 32 + r];
            continue; }
        r -= I_WRT;
        { u32x4* p = (u32x4*)((bf16*)(ws + WS_WIN) + (size_t)(D_IN + r) * 1024); p[lane] = (u32x4){0u, 0u, 0u, 0u}; p[lane + 64] = (u32x4){0u, 0u, 0u, 0u}; }
    }
    constexpr int NT_ITEMS = I_WIN + I_WOUT;
    struct TItem { const float* src; unsigned char* dst; int N, mode, fp8, k0, n0; };
#define P0_DECODE(d, rr) do { int r_ = (rr); int item_; \
        if (r_ < I_WIN) { d.src = F.in[8]; d.dst = ws + WS_WIN; d.N = D_IN; d.mode = 1; d.fp8 = 0; item_ = r_; } \
        else { r_ -= I_WIN; d.src = F.in[16]; d.dst = ws + WS_WOUT; d.N = 1024; d.mode = 0; d.fp8 = 0; item_ = r_; } \
        const int nblk_ = d.N / 32; d.k0 = 64 * (item_ / nblk_); d.n0 = 32 * (item_ % nblk_); } while (0)
#define P0_LOAD(d, tv) do { _Pragma("unroll") for (int i = 0; i < 32; ++i) tv[i] = d.src[(size_t)(d.k0 + 2 * i + (lane >> 5)) * d.N + d.n0 + (lane & 31)]; } while (0)
    int itx = gw;
    if (itx < NT_ITEMS) {
        TItem d0, d1; float ta[32], tb[32];
        P0_DECODE(d0, itx); P0_LOAD(d0, ta);
        for (;;) {
            const int nx = itx + NGW; const bool has = nx < NT_ITEMS;
            if (has) { P0_DECODE(d1, nx); P0_LOAD(d1, tb); }
#pragma unroll
            for (int i = 0; i < 32; ++i) scr[(2 * i + (lane >> 5)) * 33 + (lane & 31)] = ta[i];
            LDS_WAIT(); asm volatile("" ::: "memory");
            const int c = lane & 7;
#pragma unroll
            for (int j = 0; j < 4; ++j) { const int n = (lane >> 3) + 8 * j; const LAS float* sp = scr + (8 * c) * 33 + n; const size_t orow = (size_t)map_n(d0.mode, d0.n0 + n) * 1024 + d0.k0 + 8 * c;
                if (d0.fp8) { u32x2 o; o.x = pk4_fp8(64.f * sp[0 * 33], 64.f * sp[1 * 33], 64.f * sp[2 * 33], 64.f * sp[3 * 33]); o.y = pk4_fp8(64.f * sp[4 * 33], 64.f * sp[5 * 33], 64.f * sp[6 * 33], 64.f * sp[7 * 33]);
                    *(u32x2*)(d0.dst + orow) = o; }
                else { u32x4 o; o.x = pk2(sp[0 * 33], sp[1 * 33]); o.y = pk2(sp[2 * 33], sp[3 * 33]); o.z = pk2(sp[4 * 33], sp[5 * 33]); o.w = pk2(sp[6 * 33], sp[7 * 33]);
                    *(u32x4*)(d0.dst + orow * 2) = o; } }
            LDS_WAIT(); asm volatile("" ::: "memory");
            if (!has) break;
            itx = nx; d0 = d1;
#pragma unroll
            for (int i = 0; i < 32; ++i) ta[i] = tb[i];
        }
    }
#undef P0_DECODE
#undef P0_LOAD
    {
        constexpr int NH = 2 * (32 * 8 * 32 + 32 * 8 * 16);
        LAS unsigned char* scr8 = (LAS unsigned char*)scr;
        struct HItem { const float* src; unsigned char* dst; int N, mode, k0, n0, half; };
#define P8_DECODE(d, hh) do { int it_ = (hh) >> 1; d.half = (hh) & 1; \
            if (it_ < 32 * 256) { const int e_ = it_ >> 8, q_ = it_ & 255; d.src = F.in[19] + (size_t)e_ * 1024 * 2048; d.dst = ws + WS_WUP + (size_t)e_ * 2048 * 1024; d.N = 2048; d.mode = 2; d.k0 = 128 * (q_ >> 5); d.n0 = 64 * (q_ & 31); } \
            else { it_ -= 32 * 256; const int e_ = it_ >> 7, q_ = it_ & 127; d.src = F.in[21] + (size_t)e_ * 1024 * 1024; d.dst = ws + WS_WDN + (size_t)e_ * 1024 * 1024; d.N = 1024; d.mode = 0; d.k0 = 128 * (q_ >> 4); d.n0 = 64 * (q_ & 15); } } while (0)
#define P8_LOAD(d, tv) do { _Pragma("unroll") for (int i = 0; i < 16; ++i) tv[i] = __builtin_nontemporal_load((const f32x4*)(d.src + (size_t)(d.k0 + 64 * d.half + 16 * (i >> 2) + 4 * (lane >> 4) + (i & 3)) * d.N + d.n0 + 4 * (lane & 15))); } while (0)
        int item = gw;
        if (item < NH / 2) {
            HItem d0, d1; f32x4 ta[16], tb[16];
            int hcur = 2 * item; P8_DECODE(d0, hcur); P8_LOAD(d0, ta);
            for (;;) {
                const bool has = (hcur & 1) == 0 || (item + NGW) < NH / 2;
                const int hn = (hcur & 1) == 0 ? hcur + 1 : 2 * (item + NGW);
                if (has) { P8_DECODE(d1, hn); P8_LOAD(d1, tb); }
#pragma unroll
                for (int g = 0; g < 4; ++g) {
                    const unsigned r0 = pk4_fp8(64.f * ta[4 * g][0], 64.f * ta[4 * g][1], 64.f * ta[4 * g][2], 64.f * ta[4 * g][3]);
                    const unsigned r1 = pk4_fp8(64.f * ta[4 * g + 1][0], 64.f * ta[4 * g + 1][1], 64.f * ta[4 * g + 1][2], 64.f * ta[4 * g + 1][3]);
                    const unsigned r2 = pk4_fp8(64.f * ta[4 * g + 2][0], 64.f * ta[4 * g + 2][1], 64.f * ta[4 * g + 2][2], 64.f * ta[4 * g + 2][3]);
                    const unsigned r3 = pk4_fp8(64.f * ta[4 * g + 3][0], 64.f * ta[4 * g + 3][1], 64.f * ta[4 * g + 3][2], 64.f * ta[4 * g + 3][3]);
                    const unsigned t01l = __builtin_amdgcn_perm(r1, r0, 0x05010400u), t01h = __builtin_amdgcn_perm(r1, r0, 0x07030602u), t23l = __builtin_amdgcn_perm(r3, r2, 0x05010400u), t23h = __builtin_amdgcn_perm(r3, r2, 0x07030602u);
                    const unsigned o0 = __builtin_amdgcn_perm(t23l, t01l, 0x05040100u), o1 = __builtin_amdgcn_perm(t23l, t01l, 0x07060302u), o2 = __builtin_amdgcn_perm(t23h, t01h, 0x05040100u), o3 = __builtin_amdgcn_perm(t23h, t01h, 0x07060302u);
                    LAS unsigned char* wp = scr8 + (4 * (lane & 15)) * 132 + 64 * d0.half + 16 * g + 4 * (lane >> 4);
                    *(LAS unsigned*)(wp) = o0; *(LAS unsigned*)(wp + 132) = o1; *(LAS unsigned*)(wp + 264) = o2; *(LAS unsigned*)(wp + 396) = o3; }
                if (d0.half == 1) {
                    LDS_WAIT(); asm volatile("" ::: "memory");
#pragma unroll
                    for (int i = 0; i < 8; ++i) { const int n = (lane >> 3) + 8 * i, ch = lane & 7; const LAS unsigned* rp = (const LAS unsigned*)(scr8 + n * 132 + ch * 16);
                        u32x4 o; o.x = rp[0]; o.y = rp[1]; o.z = rp[2]; o.w = rp[3];
                        __builtin_nontemporal_store(o, (u32x4*)(d0.dst + (size_t)map_n(d0.mode, d0.n0 + n) * 1024 + d0.k0 + ch * 16)); }
                    LDS_WAIT(); asm volatile("" ::: "memory");
                }
                if (!has) break;
                if (hcur & 1) item += NGW;
                hcur = hn; d0 = d1;
#pragma unroll
                for (int i = 0; i < 16; ++i) ta[i] = tb[i];
            }
        }
#undef P8_DECODE
#undef P8_LOAD
    }
}

__device__ __forceinline__ float mod_val(const Frame& F, int b, int j) {
    const float* mp = (const float*)(F.ws + WS_MODP); float s = F.in[3][j];
#pragma unroll
    for (int ks = 0; ks < 8; ++ks) s += mp[(size_t)(ks * 4 + b) * 6144 + j];
    return s;
}
__device__ __forceinline__ void p1_rows(Frame& F) {
    LAS float* A1 = (LAS float*)F.lds; LAS float* B1 = A1 + 1024;
    bf16* H = (bf16*)(F.ws + WS_H);
    for (int rb = F.vcu; rb < M / 64; rb += F.G) {
        const int b = (rb * 64) / SEQ;
        f32x4 v[8][4];
#pragma unroll
        for (int i = 0; i < 8; ++i) { const f32x4* xr = (const f32x4*)(F.in[0] + (size_t)(rb * 64 + F.wave * 8 + i) * 1024) + F.lane;
#pragma unroll
            for (int j = 0; j < 4; ++j) v[i][j] = __builtin_nontemporal_load(xr + 64 * j); }
        for (int col = F.tid; col < 1024; col += NTHR) { A1[col] = F.in[4][col] * (1.0f + mod_val(F, b, 1024 + col)); B1[col] = mod_val(F, b, col); }
        if (rb < 96 && F.tid < 256) { const int idx = rb * 256 + F.tid; ((float*)(F.ws + WS_MODF))[idx] = mod_val(F, idx / 6144, idx % 6144); }
        __syncthreads();
#pragma unroll
        for (int i = 0; i < 8; ++i) {
            const int row = rb * 64 + F.wave * 8 + i;
            float ss = 0.f;
#pragma unroll
            for (int j = 0; j < 4; ++j) ss += (v[i][j].x * v[i][j].x + v[i][j].y * v[i][j].y) + (v[i][j].z * v[i][j].z + v[i][j].w * v[i][j].w);
            const float rs = rsqrtf(wave_sum(ss) * (1.0f / 1024.0f) + EPS);
            u32x2* o8 = (u32x2*)(H + (size_t)row * 1024) + F.lane;
#pragma unroll
            for (int j = 0; j < 4; ++j) { const int c0 = 4 * F.lane + 256 * j;
                const f32x4 a = *(const LAS f32x4*)(A1 + c0), bb = *(const LAS f32x4*)(B1 + c0);
                const f32x4 y = v[i][j] * rs * a + bb; u32x2 w; w.x = pk2(y.x, y.y); w.y = pk2(y.z, y.w); o8[64 * j] = w; }
        }
        __syncthreads();
    }
}

__device__ __forceinline__ void p3_compress_item(Frame& F, int wi) {
    const int lane = F.lane, r32 = lane & 31, hi = lane >> 5;
    const int nt = wi & 1, kv = (wi >> 1) & 1, it = (wi >> 2) & 7, g = (wi >> 5) & 1, b = wi >> 6;
    const bf16* Z = (const bf16*)(F.ws + WS_Z);
    const int i = it * 32 + r32; const bool ok = i < 255; const int ic = ok ? i : 0;
    const bf16* zrow0 = Z + (size_t)(b * SEQ + 16 * ic) * ZP + (kv ? ZC_VC : ZC_KC) + g * 64 + hi * 8;
    const bf16* wrow = (const bf16*)(F.ws + WS_WCMP) + (size_t)(kv * 64 + nt * 32 + r32) * 2048 + hi * 8;
    f32x16 acc = {};
    bf16x8 av[16], bv[16];
#pragma unroll
    for (int k = 0; k < 16; ++k) { const int ks = F.wave * 16 + k, l = ks >> 2, dq = ks & 3; av[k] = *(const bf16x8*)(zrow0 + (size_t)l * ZP + dq * 16); bv[k] = *(const bf16x8*)(wrow + ks * 16); }
#pragma unroll
    for (int k = 0; k < 16; ++k) { bf16x8 a = av[k]; if (!ok) a = (bf16x8){0, 0, 0, 0, 0, 0, 0, 0}; acc = __builtin_amdgcn_mfma_f32_32x32x16_bf16(a, bv[k], acc, 0, 0, 0); }
    LAS float* part = (LAS float*)F.lds;
#pragma unroll
    for (int r = 0; r < 16; ++r) part[(F.wave * 16 + r) * 64 + lane] = acc[r];
    __syncthreads();
    bf16* dst = (bf16*)(F.ws + (kv ? WS_VC : WS_KC)) + (size_t)((b * 2 + g) * 256) * 64;
#pragma unroll
    for (int k = 0; k < 2; ++k) { const int o = F.tid + NTHR * k, r = o >> 6, ln = o & 63; float v = 0.f;
#pragma unroll
        for (int w = 0; w < 8; ++w) v += part[(w * 16 + r) * 64 + ln];
        const int irow = it * 32 + crow(r, ln >> 5), e = nt * 32 + (ln & 31);
        dst[(size_t)irow * 64 + e] = (bf16)f2bf(irow < 255 ? v + ((const float*)(F.ws + WS_CMPB))[kv * 64 + e] : 0.f); }
    __syncthreads();
}
__device__ __forceinline__ void chunk_gates(const Frame& F, int b, int h, int c, float& ig, float& g) {
    const bf16* Z = (const bf16*)(F.ws + WS_Z); const size_t row = (size_t)(b * SEQ + c * 64 + F.lane) * ZP;
    ig = bf2f(Z[row + ZC_IG + h]) + F.in[9][h];
    const float fp = bf2f(Z[row + ZC_FG + h]) + F.in[9][4 + h];
    float v = logsigmoidf_(fp);
#pragma unroll
    for (int o = 1; o < 64; o <<= 1) { const float t = __shfl_up(v, o); if (F.lane >= o) v += t; }
    g = v;
}
__device__ __forceinline__ void conv8(const Frame& F, int b, int t, int zc, int cc, float (&o)[8]) {
    const bf16* Z = (const bf16*)(F.ws + WS_Z); const float* cw = F.in[10];
#pragma unroll
    for (int j = 0; j < 8; ++j) o[j] = 0.f;
#pragma unroll
    for (int jj = 0; jj < 4; ++jj) { const int tt = t - 3 + jj;
        if (tt >= 0) { const bf16x8 v = *(const bf16x8*)(Z + (size_t)(b * SEQ + tt) * ZP + zc);
            const f32x4 w0 = *(const f32x4*)(cw + jj * 1024 + cc), w1 = *(const f32x4*)(cw + jj * 1024 + cc + 4);
#pragma unroll
            for (int j = 0; j < 4; ++j) { o[j] += w0[j] * bf2f((unsigned short)v[j]); o[4 + j] += w1[j] * bf2f((unsigned short)v[4 + j]); } } }
#pragma unroll
    for (int j = 0; j < 8; ++j) o[j] = siluf_(o[j]);
}
struct ConvRaw { bf16x8 v[4]; };
__device__ __forceinline__ void conv8_load(const Frame& F, int b, int t, int zc, ConvRaw& r) {
    const bf16* Z = (const bf16*)(F.ws + WS_Z);
#pragma unroll
    for (int jj = 0; jj < 4; ++jj) { const int tt = t - 3 + jj; r.v[jj] = (bf16x8){0, 0, 0, 0, 0, 0, 0, 0}; if (tt >= 0) r.v[jj] = *(const bf16x8*)(Z + (size_t)(b * SEQ + tt) * ZP + zc); }
}
__device__ __forceinline__ void conv8_calc(const Frame& F, const ConvRaw& r, int cc, float (&o)[8]) {
    const float* cw = F.in[10];
#pragma unroll
    for (int j = 0; j < 8; ++j) o[j] = 0.f;
#pragma unroll
    for (int jj = 0; jj < 4; ++jj) { const f32x4 w0 = *(const f32x4*)(cw + jj * 1024 + cc), w1 = *(const f32x4*)(cw + jj * 1024 + cc + 4);
#pragma unroll
        for (int j = 0; j < 4; ++j) { o[j] += w0[j] * bf2f((unsigned short)r.v[jj][j]); o[4 + j] += w1[j] * bf2f((unsigned short)r.v[jj][4 + j]); } }
#pragma unroll
    for (int j = 0; j < 8; ++j) o[j] = siluf_(o[j]);
}
constexpr int KT_STRIDE = 72, QS_STRIDE = 136;
__device__ __forceinline__ void conv8_calc_lds(const LAS float* cwl, int nch, const ConvRaw& r, int lc, float (&o)[8]) {
#pragma unroll
    for (int j = 0; j < 8; ++j) o[j] = 0.f;
#pragma unroll
    for (int jj = 0; jj < 4; ++jj) { const f32x4 w0 = *(const LAS f32x4*)(cwl + jj * nch + lc), w1 = *(const LAS f32x4*)(cwl + jj * nch + lc + 4);
#pragma unroll
        for (int j = 0; j < 4; ++j) { o[j] += w0[j] * bf2f((unsigned short)r.v[jj][j]); o[4 + j] += w1[j] * bf2f((unsigned short)r.v[jj][4 + j]); } }
#pragma unroll
    for (int j = 0; j < 8; ++j) o[j] = siluf_(o[j]);
}
__device__ __forceinline__ void p3_mlstm_a_items(Frame& F) {
    const int tid = F.tid, lane = F.lane, r32 = lane & 31, hi = lane >> 5;
    LAS bf16* kT = (LAS bf16*)F.lds; LAS bf16* vwT = kT + 128 * KT_STRIDE; LAS float* wexA = (LAS float*)(F.lds + 2 * 128 * KT_STRIDE * 2);
    LAS float* cwl = wexA + 256;
    const bf16* Z = (const bf16*)(F.ws + WS_Z);
    float* SCG = (float*)(F.ws + WS_SC); float* SCM = SCG + 1024;
    int cur_h = -1;
    for (int base = F.vcu; base < 1024; base += 4 * F.G) {
        __syncthreads();
        if (F.wave < 4) { const int item = base + F.wave * F.G;
            if (item < 1024) { const int b = item >> 8, h = (item >> 6) & 3, c = item & 63;
                float ig, g; chunk_gates(F, b, h, c, ig, g);
                const float G = __shfl(g, 63), wl = G - g + ig, ml = wave_max(wl);
                wexA[F.wave * 64 + lane] = __expf(wl - ml);
                if (lane == 0) { SCG[item] = G; SCM[item] = ml; } } }
        for (int kb = 0; kb < 4; ++kb) {
            const int item = base + kb * F.G; if (item >= 1024) break;
            const int b = item >> 8, h = (item >> 6) & 3, c = item & 63;
            ConvRaw rk[2]; bf16x8 rvv[2];
#pragma unroll
            for (int rep = 0; rep < 2; ++rep) { const int task = tid + NTHR * rep, l = task >> 4, ch = task & 15, t = c * 64 + l;
                conv8_load(F, b, t, ZC_KM + h * 128 + ch * 8, rk[rep]); rvv[rep] = *(const bf16x8*)(Z + (size_t)(b * SEQ + t) * ZP + ZC_VM + h * 128 + ch * 8); }
            if (h != cur_h) { __syncthreads(); cwl[tid] = F.in[10][(tid >> 7) * 1024 + 512 + h * 128 + (tid & 127)]; cur_h = h; }
            __syncthreads();
            const LAS float* wex = wexA + kb * 64;
#pragma unroll
            for (int rep = 0; rep < 2; ++rep) { const int task = tid + NTHR * rep, l = task >> 4, ch = task & 15;
                float kk[8]; conv8_calc_lds(cwl, 128, rk[rep], ch * 8, kk);
                const bf16x8 vv = rvv[rep]; const float we = wex[l];
#pragma unroll
                for (int j = 0; j < 8; ++j) { kT[(ch * 8 + j) * KT_STRIDE + l] = (bf16)f2bf(kk[j] * 0.08838834764831845f); vwT[(ch * 8 + j) * KT_STRIDE + l] = (bf16)f2bf(bf2f((unsigned short)vv[j]) * we); } }
            __syncthreads();
            {
                const int et = F.wave >> 1; bf16* DC = (bf16*)(F.ws + WS_DC) + (size_t)item * 16384;
#pragma unroll
                for (int dt2 = 0; dt2 < 2; ++dt2) { const int dt = 2 * (F.wave & 1) + dt2; f32x16 acc = {};
#pragma unroll
                    for (int ks = 0; ks < 4; ++ks) { const bf16x8 a = *(const LAS bf16x8*)(vwT + (et * 32 + r32) * KT_STRIDE + ks * 16 + hi * 8), bq = *(const LAS bf16x8*)(kT + (dt * 32 + r32) * KT_STRIDE + ks * 16 + hi * 8);
                        acc = __builtin_amdgcn_mfma_f32_32x32x16_bf16(a, bq, acc, 0, 0, 0); }
#pragma unroll
                    for (int r = 0; r < 16; ++r) DC[(size_t)(et * 32 + crow(r, hi)) * 128 + dt * 32 + r32] = (bf16)f2bf(acc[r]); }
                { const int d = tid >> 2, part = tid & 3; float s = 0.f;
#pragma unroll
                    for (int l = 0; l < 16; ++l) s += wex[part * 16 + l] * bf2f(kT[d * KT_STRIDE + part * 16 + l]);
                    s += __shfl_xor(s, 1); s += __shfl_xor(s, 2);
                    if (part == 0) ((float*)(F.ws + WS_DN))[(size_t)item * 128 + d] = s; }
            }
        }
    }
    __syncthreads();
}

__device__ __forceinline__ void p4_scan(Frame& F) {
    const float* SCG = (const float*)(F.ws + WS_SC); const float* SCM = SCG + 1024; float* MP = (float*)(F.ws + WS_SC) + 2048;
    for (int it = F.vcu; it < 256; it += F.G) {
        const int bh = it >> 4, idx = (it & 15) * 512 + F.tid; const bool wmp = ((it & 15) == 0) && F.tid == 0;
        const unsigned* __restrict__ src = (const unsigned*)(F.ws + WS_DC) + idx; unsigned* __restrict__ dst = (unsigned*)(F.ws + WS_CP) + idx;
        float m = -INFINITY, s0 = 0.f, s1 = 0.f;
        for (int cb = 0; cb < 4; ++cb) {
            unsigned v[16];
#pragma unroll
            for (int i = 0; i < 16; ++i) v[i] = __builtin_nontemporal_load(src + (size_t)(bh * 64 + cb * 16 + i) * 8192);
#pragma unroll
            for (int i = 0; i < 16; ++i) { const int ci = bh * 64 + cb * 16 + i; const float G = SCG[ci], ml = SCM[ci];
                const float mn = fmaxf(G + m, ml), a = __expf(G + m - mn), bc = __expf(ml - mn);
                dst[(size_t)ci * 8192] = pk2(s0, s1); if (wmp) MP[ci] = m;
                s0 = a * s0 + bc * bf2f(v[i] & 0xffffu); s1 = a * s1 + bc * bf2f(v[i] >> 16); m = mn; }
        }
        if (F.tid < 8) { const int flat = it * 8 + F.tid, bhn = flat >> 7, d = flat & 127;
            const float* __restrict__ sn = (const float*)(F.ws + WS_DN) + d; float* __restrict__ dn = (float*)(F.ws + WS_NP) + d;
            float mN = -INFINITY, st = 0.f;
            for (int cb = 0; cb < 4; ++cb) { float v[16];
#pragma unroll
                for (int i = 0; i < 16; ++i) v[i] = sn[(size_t)(bhn * 64 + cb * 16 + i) * 128];
#pragma unroll
                for (int i = 0; i < 16; ++i) { const int ci = bhn * 64 + cb * 16 + i; const float G = SCG[ci], ml = SCM[ci];
                    const float mn = fmaxf(G + mN, ml), a = __expf(G + mN - mn), bc = __expf(ml - mn);
                    dn[(size_t)ci * 128] = st; st = a * st + bc * v[i]; mN = mn; } } }
    }
}

namespace nsa {
constexpr int KOFF = 0, VOFF = 32768, TBOFF = 65536, WSFOFF = 71680, MSKOFF = 73728, UNIOFF = 74240, JLOFF = 74304, OACCOFF = 74752, QOFF0 = 123904;
constexpr float LOG2E = 1.4426950408889634f, C2 = 0.125f * LOG2E;
typedef short v4i16_t __attribute__((ext_vector_type(4)));
#define NSA_WAITV(n) asm volatile("s_waitcnt vmcnt(" #n ")" ::: "memory")
#define NSA_BAR() do { asm volatile("s_waitcnt lgkmcnt(0)" ::: "memory"); __builtin_amdgcn_s_barrier(); asm volatile("" ::: "memory"); } while (0)

__device__ __forceinline__ void dma_k(LAS unsigned char* L, int buf, int wid, int lane, const bf16* Kt, size_t P) {
    __builtin_amdgcn_global_load_lds((const unsigned*)(Kt + (size_t)lane * P + wid * 8), (LAS unsigned*)(L + KOFF + buf * 8192 + wid * 1024), 16, 0, 0);
}
__device__ __forceinline__ void dma_v(LAS unsigned char* L, int buf, int wid, int lane, const bf16* Vt, size_t P) {
    __builtin_amdgcn_global_load_lds((const unsigned*)(Vt + (size_t)(16 * (wid & 3) + (lane >> 2)) * P + (wid >> 2) * 32 + (lane & 3) * 8), (LAS unsigned*)(L + VOFF + buf * 8192 + wid * 1024), 16, 0, 0);
}
__device__ __forceinline__ void qkt(f32x16& p0, f32x16& p1, const LAS unsigned char* L, int buf, const LAS bf16x8* qr, int r32, int hi) {
    const LAS unsigned char* kb = L + KOFF + buf * 8192 + hi * 1024 + r32 * 16;
    p0 = (f32x16){}; p1 = (f32x16){};
#pragma unroll
    for (int d0 = 0; d0 < 4; ++d0) {
        const bf16x8 b0 = *(const LAS bf16x8*)(kb + d0 * 2048), b1 = *(const LAS bf16x8*)(kb + d0 * 2048 + 512), q = qr[d0 * 64];
        p0 = __builtin_amdgcn_mfma_f32_32x32x16_bf16(b0, q, p0, 0, 0, 0);
        p1 = __builtin_amdgcn_mfma_f32_32x32x16_bf16(b1, q, p1, 0, 0, 0); }
}
__device__ __forceinline__ s16x4 vtr(const LAS unsigned char* p) { return __builtin_bit_cast(s16x4, __builtin_amdgcn_ds_read_tr16_b64_v4i16((LAS v4i16_t*)p)); }
__device__ __forceinline__ void pv(f32x16 (&o)[2], const LAS unsigned char* L, int buf, const u32x4 (&pw)[4], int lane, int hi) {
    const LAS unsigned char* vp = L + VOFF + buf * 8192 + ((lane >> 4) & 1) * 32 + (lane & 3) * 8 + (4 * hi + ((lane & 15) >> 2)) * 64;
#pragma unroll
    for (int dh = 0; dh < 2; ++dh)
#pragma unroll
        for (int ks = 0; ks < 4; ++ks) {
            const s16x4 lo = vtr(vp + dh * 4096 + ks * 1024), hh = vtr(vp + dh * 4096 + ks * 1024 + 512);
            const bf16x8 vf = (bf16x8){lo[0], lo[1], lo[2], lo[3], hh[0], hh[1], hh[2], hh[3]};
            o[dh] = __builtin_amdgcn_mfma_f32_32x32x16_bf16(__builtin_bit_cast(bf16x8, pw[ks]), vf, o[dh], 0, 0, 0); }
}
__device__ __forceinline__ float xhalf(float x, int hi) {
    auto rr = __builtin_amdgcn_permlane32_swap(__float_as_uint(x), __float_as_uint(x), false, false); return __uint_as_float(hi ? rr[0] : rr[1]); }
__device__ __forceinline__ float dpp_xor1(float x) { return __int_as_float(__builtin_amdgcn_mov_dpp(__float_as_int(x), 0xB1, 0xF, 0xF, true)); }
__device__ __forceinline__ float dpp_xor2(float x) { return __int_as_float(__builtin_amdgcn_mov_dpp(__float_as_int(x), 0x4E, 0xF, 0xF, true)); }
__device__ __forceinline__ void score_tile(f32x16& p0, f32x16& p1, int dist0, int step, int dmax, bool laneok, bool usebias, const LAS float* tbh, int hi) {
    const int dbase = dist0 + step * 4 * hi;
#pragma unroll
    for (int r = 0; r < 16; ++r) {
        const int kk = (r & 3) + 8 * (r >> 2); const int da = dbase + step * kk, db = da + step * 32;
        float sa = p0[r] * C2, sb = p1[r] * C2;
        if (usebias) { sa += tbh[min(max(da, 0), 127)]; sb += tbh[min(max(db, 0), 127)]; }
        p0[r] = (laneok && da >= 0 && da < dmax) ? sa : -INFINITY;
        p1[r] = (laneok && db >= 0 && db < dmax) ? sb : -INFINITY; }
}
template <bool DIAG>
__device__ __forceinline__ void near_scores(f32x16& p0, f32x16& p1, const LAS float* tbD, int D0) {
#pragma unroll
    for (int r = 0; r < 16; ++r) { const int kk = (r & 3) + 8 * (r >> 2);
        float sa = __builtin_fmaf(p0[r], C2, tbD[-kk]), sb = __builtin_fmaf(p1[r], C2, tbD[-kk - 32]);
        if (DIAG) { sa = (kk <= D0) ? sa : -INFINITY; sb = (kk + 32 <= D0) ? sb : -INFINITY; }
        p0[r] = sa; p1[r] = sb; }
}
__device__ __forceinline__ void wedge_mask(f32x16& p0, f32x16& p1, int D) {
#pragma unroll
    for (int r = 0; r < 16; ++r) { const int kk = (r & 3) + 8 * (r >> 2); p0[r] = (kk > D) ? p0[r] : -INFINITY; p1[r] = (kk + 32 > D) ? p1[r] : -INFINITY; }
}
__device__ __forceinline__ float rowmax32(const f32x16& p0, const f32x16& p1) {
    float a = fmaxf(p0[0], p1[0]);
#pragma unroll
    for (int r = 1; r < 16; ++r) a = fmaxf(a, fmaxf(p0[r], p1[r]));
    return fmaxf(a, xchg_f<32>(a, threadIdx.x & 63));
}
template <bool HAS_O>
__device__ __forceinline__ void softmax_step(f32x16& p0, f32x16& p1, float& m, float& l, f32x16 (&o)[2], u32x4 (&pw)[4], LAS float* wsf, int r32, int hi, bool sel = true) {
    const float rm = sel ? rowmax32(p0, p1) : -INFINITY, mn = fmaxf(m, rm);
    if (__any(mn > m + 8.0f)) {
        const float alpha = __builtin_amdgcn_exp2f(m - mn); l *= alpha; m = mn;
        if (HAS_O) { if (hi == 0) wsf[r32] = alpha; LDS_WAIT();
#pragma unroll
            for (int r = 0; r < 16; ++r) { const float f = wsf[crow(r, hi)]; o[0][r] *= f; o[1][r] *= f; }
            LDS_WAIT(); }
    }
    const float off = sel ? -m : -INFINITY;
    float s0 = 0.f, s1 = 0.f;
#pragma unroll
    for (int r = 0; r < 16; ++r) { p0[r] = __builtin_amdgcn_exp2f(p0[r] + off); p1[r] = __builtin_amdgcn_exp2f(p1[r] + off); s0 += p0[r]; s1 += p1[r]; }
    l += s0 + s1;
#pragma unroll
    for (int k = 0; k < 2; ++k) { pw[k] = (u32x4){pk2(p0[8 * k], p0[8 * k + 1]), pk2(p0[8 * k + 2], p0[8 * k + 3]), pk2(p0[8 * k + 4], p0[8 * k + 5]), pk2(p0[8 * k + 6], p0[8 * k + 7])};
        pw[2 + k] = (u32x4){pk2(p1[8 * k], p1[8 * k + 1]), pk2(p1[8 * k + 2], p1[8 * k + 3]), pk2(p1[8 * k + 4], p1[8 * k + 5]), pk2(p1[8 * k + 6], p1[8 * k + 7])}; }
}
template <bool HAS_O = true>
__device__ __forceinline__ void softmax_fast(f32x16& p0, f32x16& p1, float& m, float& l, f32x16 (&o)[2], u32x4 (&pw)[4], LAS float* wsf, int r32, int hi, bool sel) {
    float a = fmaxf(fmaxf(p0[0], p0[1]), p1[0]), bq = fmaxf(fmaxf(p0[2], p0[3]), p1[1]); a = fmaxf(fmaxf(a, p1[2]), p1[3]);
#pragma unroll
    for (int r = 4; r < 16; r += 4) { a = fmaxf(fmaxf(a, p0[r]), p0[r + 1]); bq = fmaxf(fmaxf(bq, p0[r + 2]), p0[r + 3]); a = fmaxf(fmaxf(a, p1[r]), p1[r + 1]); bq = fmaxf(fmaxf(bq, p1[r + 2]), p1[r + 3]); }
    a = fmaxf(a, bq); a = fmaxf(a, xchg_f<32>(a, threadIdx.x & 63));
    const float rm = sel ? a * C2 : -INFINITY, mn = fmaxf(m, rm);
    if (__any(mn > m + 8.0f)) {
        const float alpha = __builtin_amdgcn_exp2f(m - mn); l *= alpha; m = mn;
        if (HAS_O) { if (hi == 0) wsf[r32] = alpha; LDS_WAIT();
#pragma unroll
            for (int r = 0; r < 16; ++r) { const float f = wsf[crow(r, hi)]; o[0][r] *= f; o[1][r] *= f; }
            LDS_WAIT(); }
    }
    const float off = sel ? -m : -INFINITY;
    float s0 = 0.f, s1 = 0.f;
#pragma unroll
    for (int r = 0; r < 16; ++r) { p0[r] = __builtin_amdgcn_exp2f(__builtin_fmaf(p0[r], C2, off)); p1[r] = __builtin_amdgcn_exp2f(__builtin_fmaf(p1[r], C2, off)); s0 += p0[r]; s1 += p1[r]; }
    l += s0 + s1;
#pragma unroll
    for (int k = 0; k < 2; ++k) { pw[k] = (u32x4){pk2(p0[8 * k], p0[8 * k + 1]), pk2(p0[8 * k + 2], p0[8 * k + 3]), pk2(p0[8 * k + 4], p0[8 * k + 5]), pk2(p0[8 * k + 6], p0[8 * k + 7])};
        pw[2 + k] = (u32x4){pk2(p1[8 * k], p1[8 * k + 1]), pk2(p1[8 * k + 2], p1[8 * k + 3]), pk2(p1[8 * k + 4], p1[8 * k + 5]), pk2(p1[8 * k + 6], p1[8 * k + 7])}; }
}
template <bool FIRST>
__device__ __forceinline__ void branch_merge(LAS bf16* oa, const f32x16 (&o)[2], float l, float gate, LAS float* wsf, int r32, int hi, int lane) {
    const float lt = l + xchg_f<32>(l, lane); const float f = lt > 0.f ? gate / lt : 0.f;
    LDS_WAIT(); if (hi == 0) wsf[r32] = f; LDS_WAIT();
#pragma unroll
    for (int r = 0; r < 16; ++r) { const float ff = wsf[crow(r, hi)];
        float a0 = o[0][r] * ff, a1 = o[1][r] * ff;
        if (!FIRST) { a0 += bf2f(oa[(2 * r) * 64 + lane]); a1 += bf2f(oa[(2 * r + 1) * 64 + lane]); }
        oa[(2 * r) * 64 + lane] = (bf16)f2bf(a0); oa[(2 * r + 1) * 64 + lane] = (bf16)f2bf(a1); }
    LDS_WAIT();
}

__device__ __forceinline__ float rowmax_raw(const f32x16& p0, const f32x16& p1, int lane) {
    float a = fmaxf(fmaxf(p0[0], p0[1]), p1[0]), bq = fmaxf(fmaxf(p0[2], p0[3]), p1[1]); a = fmaxf(fmaxf(a, p1[2]), p1[3]);
#pragma unroll
    for (int r = 4; r < 16; r += 4) { a = fmaxf(fmaxf(a, p0[r]), p0[r + 1]); bq = fmaxf(fmaxf(bq, p0[r + 2]), p0[r + 3]); a = fmaxf(fmaxf(a, p1[r]), p1[r + 1]); bq = fmaxf(fmaxf(bq, p1[r + 2]), p1[r + 3]); }
    a = fmaxf(a, bq); return fmaxf(a, xchg_f<32>(a, lane));
}
__device__ __forceinline__ void rescale_o(f32x16 (&o)[2], float& m, float& l, float mn, LAS float* wsf, int r32, int hi) {
    const float alpha = __builtin_amdgcn_exp2f(m - mn); l *= alpha; m = mn;
    if (hi == 0) wsf[r32] = alpha; LDS_WAIT();
#pragma unroll
    for (int r = 0; r < 16; ++r) { const float f = wsf[crow(r, hi)]; float t0 = o[0][r], t1 = o[1][r];
        asm volatile("v_mul_f32 %0, %0, %1" : "+v"(t0) : "v"(f)); asm volatile("v_mul_f32 %0, %0, %1" : "+v"(t1) : "v"(f)); o[0][r] = t0; o[1][r] = t1; }
    LDS_WAIT();
}
template <bool QK>
__device__ __forceinline__ void exp_qk(f32x16& a0, f32x16& a1, f32x16& n0, f32x16& n1, const LAS unsigned char* L, int nbuf, const LAS bf16x8* qr, int r32, int hi, float cs, float off, float& l, u32x4 (&pw)[4]) {
    const LAS unsigned char* kb = L + KOFF + nbuf * 8192 + hi * 1024 + r32 * 16;
    float s0 = 0.f, s1 = 0.f;
    if (QK) { n0 = (f32x16){}; n1 = (f32x16){}; }
#pragma unroll
    for (int d0 = 0; d0 < 4; ++d0) {
        if (QK) { const bf16x8 b0 = *(const LAS bf16x8*)(kb + d0 * 2048), b1 = *(const LAS bf16x8*)(kb + d0 * 2048 + 512), q = qr[d0 * 64];
            n0 = __builtin_amdgcn_mfma_f32_32x32x16_bf16(b0, q, n0, 0, 0, 0);
            n1 = __builtin_amdgcn_mfma_f32_32x32x16_bf16(b1, q, n1, 0, 0, 0); }
#pragma unroll
        for (int r = 4 * d0; r < 4 * d0 + 4; ++r) { a0[r] = __builtin_amdgcn_exp2f(__builtin_fmaf(a0[r], cs, off)); a1[r] = __builtin_amdgcn_exp2f(__builtin_fmaf(a1[r], cs, off)); s0 += a0[r]; s1 += a1[r]; }
    }
    l += s0 + s1;
#pragma unroll
    for (int k = 0; k < 2; ++k) { pw[k] = (u32x4){pk2(a0[8 * k], a0[8 * k + 1]), pk2(a0[8 * k + 2], a0[8 * k + 3]), pk2(a0[8 * k + 4], a0[8 * k + 5]), pk2(a0[8 * k + 6], a0[8 * k + 7])};
        pw[2 + k] = (u32x4){pk2(a1[8 * k], a1[8 * k + 1]), pk2(a1[8 * k + 2], a1[8 * k + 3]), pk2(a1[8 * k + 4], a1[8 * k + 5]), pk2(a1[8 * k + 6], a1[8 * k + 7])}; }
}
template <bool MX>
__device__ __forceinline__ float pv_max(f32x16 (&o)[2], const LAS unsigned char* L, int buf, const u32x4 (&pw)[4], int lane, int hi, const f32x16& n0, const f32x16& n1) {
    const LAS unsigned char* vp = L + VOFF + buf * 8192 + ((lane >> 4) & 1) * 32 + (lane & 3) * 8 + (4 * hi + ((lane & 15) >> 2)) * 64;
    float a = -INFINITY, bq = -INFINITY;
#pragma unroll
    for (int dh = 0; dh < 2; ++dh)
#pragma unroll
        for (int ks = 0; ks < 4; ++ks) {
            const s16x4 lo = vtr(vp + dh * 4096 + ks * 1024), hh = vtr(vp + dh * 4096 + ks * 1024 + 512);
            const bf16x8 vf = (bf16x8){lo[0], lo[1], lo[2], lo[3], hh[0], hh[1], hh[2], hh[3]};
            o[dh] = __builtin_amdgcn_mfma_f32_32x32x16_bf16(__builtin_bit_cast(bf16x8, pw[ks]), vf, o[dh], 0, 0, 0);
            if (MX) { const int t = 2 * (dh * 4 + ks); a = fmaxf(fmaxf(a, n0[t]), n0[t + 1]); bq = fmaxf(fmaxf(bq, n1[t]), n1[t + 1]); } }
    if (!MX) return 0.f;
    a = fmaxf(a, bq); return fmaxf(a, xchg_f<32>(a, lane));
}
#define NSA2_X(i_, P0, P1, CS, SL) do { const int j_ = TILEJ(i_); SL = TSEL(j_); const int d_ = cur - j_; \
        if (d_ < 3) { const int D0 = tq - 64 * j_ - 4 * hi; if (d_ == 0) near_scores<true>(P0, P1, tbh + D0, D0); else near_scores<false>(P0, P1, tbh + D0, D0); CS = 1.0f; } \
        else { if (WEDGE && d_ >= 8) wedge_mask(P0, P1, tq - 64 * cur - 4 * hi); CS = C2; } } while (0)
#define NSA2_BODY(idx_, A0, A1, RMA, CSA, SLA, B0, B1, RMB, CSB, SLB) do { const int i_ = (idx_); \
        if (i_ + 2 < n_) NSA_WAITV(2); else NSA_WAITV(0); \
        NSA_BAR(); \
        if (i_ + 3 < n_) { ISSUE(i_ + 3, (i_ + 3) & 3); } \
        { const float mn_ = fmaxf(m, RMA); if (__any(mn_ > m + 8.0f)) rescale_o(o, m, l, mn_, wsf, r32, hi); } \
        const float off_ = SLA ? -m : -INFINITY; \
        exp_qk<true>(A0, A1, B0, B1, L, (i_ + 1) & 3, qr, r32, hi, CSA, off_, l, pw);        \
        SLB = false; CSB = C2; \
        if (i_ + 1 < n_) { NSA2_X(i_ + 1, B0, B1, CSB, SLB); } \
        { const float a_ = pv_max<true>(o, L, i_ & 3, pw, lane, hi, B0, B1); RMB = SLB ? a_ * CSB : -INFINITY; } \
    } while (0)
#define NSA2_LOOP(NTILES) do { const int n_ = (NTILES); \
        ISSUE(0, 0); if (n_ > 1) { ISSUE(1, 1); } if (n_ > 2) { ISSUE(2, 2); } \
        if (n_ > 2) NSA_WAITV(4); else if (n_ > 1) NSA_WAITV(2); else NSA_WAITV(0); \
        NSA_BAR(); \
        qkt(pa0, pa1, L, 0, qr, r32, hi); NSA2_X(0, pa0, pa1, csa, sla); rma = sla ? rowmax_raw(pa0, pa1, lane) * csa : -INFINITY; \
        for (int idx = 0; idx < n_; idx += 2) { \
            NSA2_BODY(idx, pa0, pa1, rma, csa, sla, pb0, pb1, rmb, csb, slb); \
            if (idx + 1 < n_) NSA2_BODY(idx + 1, pb0, pb1, rmb, csb, slb, pa0, pa1, rma, csa, sla); } \
        NSA_BAR(); } while (0)

#define NSA_LOOP(NTILES, NDMA, ISSUE, COMPUTE) do { const int n_ = (NTILES); \
        ISSUE(0, 0); if (n_ > 1) { ISSUE(1, 1); } \
        for (int idx = 0; idx < n_; ++idx) { \
            if (idx + 1 < n_) { if (NDMA == 2) NSA_WAITV(2); else NSA_WAITV(1); } else { NSA_WAITV(0); } \
            NSA_BAR(); \
            if (idx + 2 < n_) { ISSUE(idx + 2, (idx + 2) & 3); } \
            COMPUTE(idx, idx & 3); } \
        NSA_BAR(); } while (0)

template <int VAR>
__device__ __forceinline__ void attn_unit(const Frame& F, int b, int g, int cur, bf16* Y, bool FILL_TB) {
    LAS unsigned char* L = F.lds;
    int lane_ = F.lane; asm volatile("" : "+v"(lane_));
    const int lane = lane_, wid = F.wave, r32 = lane & 31, hi = lane >> 5, tid = F.tid;
    const bf16* Z = (const bf16*)(F.ws + WS_Z);
    const int qi = r32 >> 2, hp = r32 & 3, head = g * 4 + hp;
    const int tq = cur * 64 + wid * 8 + qi;
    const size_t zrow = (size_t)(b * SEQ + tq) * ZP;
    LAS float* tb = (LAS float*)(L + TBOFF);
    if (FILL_TB) for (int i = tid; i < 4 * 384; i += NTHR) { const int hpp = i / 384, dd = i % 384 - 64; tb[i] = (dd >= 0 && dd < 128) ? (F.in[15][T5B[dd & 127] * 8 + g * 4 + hpp] - F.in[15][31 * 8 + g * 4 + hpp]) * LOG2E : 0.f; }
    const LAS float* tbh = tb + hp * 384 + 64;
    LAS bf16x8* qr = (LAS bf16x8*)(L + (wid == 0 ? QOFF0 : TAB_OFF + (wid - 1) * 4096)) + lane;
#pragma unroll
    for (int d0 = 0; d0 < 4; ++d0) qr[d0 * 64] = *(const bf16x8*)(Z + zrow + ZC_QA + head * 64 + d0 * 16 + hi * 8);
#define NSA_GATE(br) sigmoidf_(bf2f(Z[zrow + ZC_GA + head * 3 + (br)]))
    LAS float* wsf = (LAS float*)(L + WSFOFF) + wid * 64;
    LAS unsigned long long* msk = (LAS unsigned long long*)(L + MSKOFF);
    LAS unsigned long long* uni = (LAS unsigned long long*)(L + UNIOFF);
    LAS int* jl = (LAS int*)(L + JLOFF);
    LAS bf16* oa = (LAS bf16*)(L + OACCOFF) + wid * 2048;
    LAS float* sc = (LAS float*)oa;
    f32x16 p0, p1, o[2]; u32x4 pw[4];
    NSA_BAR();

    {
        const bf16* KCb = (const bf16*)(F.ws + WS_KC) + (size_t)((b * 2 + g) * 256) * 64;
        const bf16* VCb = (const bf16*)(F.ws + WS_VC) + (size_t)((b * 2 + g) * 256) * 64;
        const int nT = (4 * cur + 2) / 64 + 1;
        float m = -1e30f, l = 0.f;
#define B1_COMP1(T, s) do { qkt(p0, p1, L, s, qr, r32, hi); \
            if (cur >= 16 * (T) + 19) softmax_fast<false>(p0, p1, m, l, o, pw, wsf, r32, hi, true); \
            else { score_tile(p0, p1, tq - 31 - 16 * 64 * (T), -16, 1 << 30, true, true, tbh, hi); softmax_step<false>(p0, p1, m, l, o, pw, wsf, r32, hi); } } while (0)
        for (int T = 0; T < nT; ++T) { dma_k(L, T, wid, lane, KCb + (size_t)T * 64 * 64, 64); dma_v(L, T, wid, lane, VCb + (size_t)T * 64 * 64, 64); }
        NSA_WAITV(0); NSA_BAR();
        for (int T = 0; T < nT; ++T) B1_COMP1(T, T);
        const float lt = l + xchg_f<32>(l, lane); const float inv_l = lt > 0.f ? 1.0f / lt : 0.f;
        o[0] = (f32x16){}; o[1] = (f32x16){};
        float carry = 0.f;
#define B1_COMP2(T, s) do { qkt(p0, p1, L, s, qr, r32, hi); \
            if (cur >= 16 * (T) + 19) { _Pragma("unroll") for (int r = 0; r < 16; ++r) { p0[r] *= C2; p1[r] *= C2; } } \
            else score_tile(p0, p1, tq - 31 - 16 * 64 * (T), -16, 1 << 30, true, true, tbh, hi); \
            float ps8[9]; \
            _Pragma("unroll") for (int i = 0; i < 9; ++i) ps8[i] = 0.f; \
            ps8[0] = (hi == 0) ? carry : 0.f; \
            _Pragma("unroll") for (int r = 0; r < 16; ++r) { p0[r] = __builtin_amdgcn_exp2f(p0[r] - m) * inv_l; p1[r] = __builtin_amdgcn_exp2f(p1[r] - m) * inv_l; } \
            _Pragma("unroll") for (int sub = 0; sub < 2; ++sub) _Pragma("unroll") for (int n = 0; n < 4; ++n) { \
                const float q0 = sub ? p1[4 * n] : p0[4 * n], q1 = sub ? p1[4 * n + 1] : p0[4 * n + 1], q2 = sub ? p1[4 * n + 2] : p0[4 * n + 2], q3 = sub ? p1[4 * n + 3] : p0[4 * n + 3]; \
                const float a = (q0 + q1) + (q2 + 0.5f * q3), bq = 0.5f * q3, bsw = xhalf(bq, hi); \
                if (hi == 1) ps8[sub * 4 + n] += a + bsw; else { ps8[sub * 4 + n] += a; ps8[sub * 4 + n + 1] += bsw; } } \
            carry = ps8[8]; \
            _Pragma("unroll") for (int i = 0; i < 8; ++i) { float v = ps8[i]; v += dpp_xor1(v); v += dpp_xor2(v); if (hp == 0) sc[qi * 64 + 16 * (T) + 2 * i + hi] = v; } \
            _Pragma("unroll") for (int k = 0; k < 2; ++k) { pw[k] = (u32x4){pk2(p0[8 * k], p0[8 * k + 1]), pk2(p0[8 * k + 2], p0[8 * k + 3]), pk2(p0[8 * k + 4], p0[8 * k + 5]), pk2(p0[8 * k + 6], p0[8 * k + 7])}; \
                pw[2 + k] = (u32x4){pk2(p1[8 * k], p1[8 * k + 1]), pk2(p1[8 * k + 2], p1[8 * k + 3]), pk2(p1[8 * k + 4], p1[8 * k + 5]), pk2(p1[8 * k + 6], p1[8 * k + 7])}; } \
            pv(o, L, s, pw, lane, hi); } while (0)
        for (int T = 0; T < nT; ++T) B1_COMP2(T, T);
        NSA_BAR();
    }
    unsigned long long mymask; int nsel;
    {
        LDS_WAIT();
        f32x4 va = {0.f, 0.f, 0.f, 0.f}, vb = va;
        if (cur >= 16) { va = *(const LAS f32x4*)(sc + (lane >> 3) * 64 + (lane & 7) * 8); vb = *(const LAS f32x4*)(sc + (lane >> 3) * 64 + (lane & 7) * 8 + 4); }
        branch_merge<true>(oa, o, 0.5f, NSA_GATE(0), wsf, r32, hi, lane);
        if (cur >= 16) {
            {
                const int q = lane >> 3, ch = lane & 7;
                unsigned bits[8]; unsigned vmask = 0u;
#pragma unroll
                for (int j = 0; j < 8; ++j) { const int blk = ch * 8 + j; const bool valid = blk <= cur; const bool forced = (blk == 0) || (blk == cur) || (blk == cur - 1);
                    const float v = (j < 4 ? va[j & 3] : vb[j & 3]) + (forced ? 1000.f : 0.f);
                    bits[j] = valid ? (__float_as_uint(v) & 0xfffff000u) : 0u; vmask |= valid ? (1u << j) : 0u; }
#define SUM8(x) do { x += __builtin_amdgcn_mov_dpp(x, 0xB1, 0xF, 0xF, true); x += __builtin_amdgcn_mov_dpp(x, 0x4E, 0xF, 0xF, true); x += __builtin_amdgcn_mov_dpp(x, 0x141, 0xF, 0xF, true); } while (0)
                unsigned T = 0u;
#pragma unroll
                for (int bt = 30; bt >= 12; --bt) { const unsigned cand = T | (1u << bt); int cnt = 0;
#pragma unroll
                    for (int j = 0; j < 8; ++j) cnt += (bits[j] >= cand) ? 1 : 0;
                    SUM8(cnt); T = (cnt >= 16) ? cand : T; }
                int ngt = 0, eqc = 0; unsigned gtm = 0u, eqm = 0u;
#pragma unroll
                for (int j = 0; j < 8; ++j) { const bool g_ = bits[j] > T, e_ = (bits[j] == T) && ((vmask >> j) & 1u); gtm |= g_ ? (1u << j) : 0u; eqm |= e_ ? (1u << j) : 0u; ngt += g_ ? 1 : 0; eqc += e_ ? 1 : 0; }
                SUM8(ngt);
                int pre = eqc;
                { int t = __builtin_amdgcn_mov_dpp(pre, 0x111, 0xF, 0xF, true); if (ch >= 1) pre += t; t = __builtin_amdgcn_mov_dpp(pre, 0x112, 0xF, 0xF, true); if (ch >= 2) pre += t; t = __builtin_amdgcn_mov_dpp(pre, 0x114, 0xF, 0xF, true); if (ch >= 4) pre += t; }
                int run = pre - eqc; const int need = 16 - ngt; unsigned m8 = gtm;
#pragma unroll
                for (int j = 0; j < 8; ++j) { const bool e_ = (eqm >> j) & 1u; if (e_ && run < need) m8 |= 1u << j; run += e_ ? 1 : 0; }
                ((LAS unsigned char*)msk)[(wid * 8 + q) * 8 + ch] = (unsigned char)m8;
#undef SUM8
            }
        } else {
            if (lane < 8) msk[wid * 8 + lane] = (2ull << cur) - 1ull;
        }
        LDS_WAIT();
        mymask = msk[wid * 8 + qi];
        unsigned long long u = mymask;
#pragma unroll
        for (int o_ = 4; o_ < 32; o_ <<= 1) { const unsigned lo = __shfl_xor((unsigned)u, o_), hh = __shfl_xor((unsigned)(u >> 32), o_); u |= ((unsigned long long)hh << 32) | lo; }
        if (lane == 0) uni[wid] = u;
        NSA_BAR();
        unsigned long long umask = 0ull;
#pragma unroll
        for (int w = 0; w < 8; ++w) umask |= uni[w];
        umask = ((unsigned long long)__builtin_amdgcn_readfirstlane((unsigned)(umask >> 32)) << 32) | (unsigned)__builtin_amdgcn_readfirstlane((unsigned)umask);
        nsel = __builtin_popcountll(umask);
        if (wid == 0 && ((umask >> lane) & 1ull)) jl[__builtin_popcountll(umask & ((1ull << lane) - 1ull))] = lane;
        NSA_BAR();
    }
    {
        const bf16* Kb = Z + (size_t)(b * SEQ) * ZP + ZC_KS + g * 64; const bf16* Vb = Z + (size_t)(b * SEQ) * ZP + ZC_VS + g * 64;
        float m = -1e30f, l = 0.f; o[0] = (f32x16){}; o[1] = (f32x16){};
f32x16 pa0, pa1, pb0, pb1; float rma, rmb = 0.f, csa, csb = 0.f; bool sla, slb = false;
#define ISSUE(i_, s) do { const int jj_ = __builtin_amdgcn_readfirstlane(jl[i_]); dma_k(L, s, wid, lane, Kb + (size_t)(64 * jj_) * ZP, ZP); dma_v(L, s, wid, lane, Vb + (size_t)(64 * jj_) * ZP, ZP); } while (0)
#define TILEJ(i_) __builtin_amdgcn_readfirstlane(jl[i_])
#define TSEL(j_) (((mymask >> (j_)) & 1ull) != 0ull)
#define WEDGE false
        NSA2_LOOP(nsel);
#undef ISSUE
#undef TILEJ
#undef TSEL
#undef WEDGE
        branch_merge<false>(oa, o, l, NSA_GATE(1), wsf, r32, hi, lane);
    }
    {
        const bf16* Kb = Z + (size_t)(b * SEQ) * ZP + ZC_KW + g * 64; const bf16* Vb = Z + (size_t)(b * SEQ) * ZP + ZC_VW + g * 64;
        float m = -1e30f, l = 0.f; o[0] = (f32x16){}; o[1] = (f32x16){};
        const int j0 = cur >= 8 ? cur - 8 : 0, nT = cur - j0 + 1;
f32x16 pa0, pa1, pb0, pb1; float rma, rmb = 0.f, csa, csb = 0.f; bool sla, slb = false;
#define ISSUE(T, s) do { dma_k(L, s, wid, lane, Kb + (size_t)(64 * (j0 + (T))) * ZP, ZP); dma_v(L, s, wid, lane, Vb + (size_t)(64 * (j0 + (T))) * ZP, ZP); } while (0)
#define TILEJ(i_) (j0 + (i_))
#define TSEL(j_) true
#define WEDGE true
        NSA2_LOOP(nT);
#undef ISSUE
#undef TILEJ
#undef TSEL
#undef WEDGE
        branch_merge<false>(oa, o, l, NSA_GATE(2), wsf, r32, hi, lane);
    }
#pragma unroll
    for (int r = 0; r < 16; ++r) { const int row = crow(r, hi), q_ = row >> 2, hp_ = row & 3;
        bf16* dst = Y + (size_t)(b * SEQ + cur * 64 + wid * 8 + q_) * 1024 + 512 + (g * 4 + hp_) * 64 + r32;
        dst[0] = oa[(2 * r) * 64 + lane]; dst[32] = oa[(2 * r + 1) * 64 + lane]; }
#undef B1_COMP1
#undef B1_COMP2
#undef NSA_GATE
}
template <int VAR>
__device__ __forceinline__ void p4_attention(Frame& F, bf16* Y) {
    for (int v = F.vcu; v < 256; v += F.G) {
        const int bg = v >> 5, s = v & 31;
#pragma unroll 1
        for (int u2 = 0; u2 < 2; ++u2) attn_unit<VAR>(F, bg >> 1, bg & 1, u2 ? s : 63 - s, Y, u2 == 0);
    }
}
}

__device__ __forceinline__ f32x16 mma32_lds(const LAS bf16* A, int sa, const LAS bf16* Bt, int sb, int ksteps, int r32, int hi, f32x16 acc) {
#pragma unroll
    for (int ks = 0; ks < 8; ++ks) if (ks < ksteps) {
        const bf16x8 a = *(const LAS bf16x8*)(A + r32 * sa + ks * 16 + hi * 8), bq = *(const LAS bf16x8*)(Bt + r32 * sb + ks * 16 + hi * 8);
        acc = __builtin_amdgcn_mfma_f32_32x32x16_bf16(a, bq, acc, 0, 0, 0); }
    return acc;
}
__device__ __forceinline__ void p5_mlstm_c_items(Frame& F) {
    const int tid = F.tid, lane = F.lane, r32 = lane & 31, hi = lane >> 5, wid = F.wave;
    LAS bf16* Qs = (LAS bf16*)F.lds;
    LAS bf16* Qp = Qs + 64 * QS_STRIDE;
    LAS bf16* Ks = Qp + 64 * QS_STRIDE;
    LAS bf16* VT = Ks + 64 * QS_STRIDE;
    LAS bf16* CT = VT + 128 * KT_STRIDE;
    LAS bf16* Wm = CT + 128 * QS_STRIDE;
    LAS float* fu = (LAS float*)(Wm + 64 * KT_STRIDE);
    LAS float* frd = fu + 256; LAS float* fnp = fu + 320;
    LAS float* gtab = (LAS float*)(F.lds + 120 * 1024);
    LAS float* cwl = (LAS float*)(F.lds + 124 * 1024);
    const bf16* Z = (const bf16*)(F.ws + WS_Z);
    ConvRaw rq[2], rk[2]; bf16x8 rvv[2]; u32x4 cpv[4]; unsigned short ogn[16]; float np_n = 0.f;
#define P5_LOAD(item_) do { const int b_ = (item_) >> 8, h_ = ((item_) >> 6) & 3, c_ = (item_) & 63; \
    _Pragma("unroll") for (int rep = 0; rep < 2; ++rep) { const int task = tid + NTHR * rep, l = task >> 4, ch = task & 15, t = c_ * 64 + l; \
        conv8_load(F, b_, t, ZC_QM + h_ * 128 + ch * 8, rq[rep]); conv8_load(F, b_, t, ZC_KM + h_ * 128 + ch * 8, rk[rep]); \
        rvv[rep] = *(const bf16x8*)(Z + (size_t)(b_ * SEQ + t) * ZP + ZC_VM + h_ * 128 + ch * 8); } \
    { const bf16* cp = (const bf16*)(F.ws + WS_CP) + (size_t)(item_) * 16384; \
      _Pragma("unroll") for (int i = 0; i < 4; ++i) { const int q = tid + NTHR * i; cpv[i] = *(const u32x4*)(cp + q * 8); } } \
    { const int lt = wid & 1, et = wid >> 1; \
      _Pragma("unroll") for (int r = 0; r < 16; ++r) ogn[r] = Z[(size_t)(b_ * SEQ + c_ * 64 + lt * 32 + crow(r, hi)) * ZP + ZC_OM + h_ * 128 + et * 32 + r32]; } \
    if (tid >= 64 && tid < 192) np_n = ((const float*)(F.ws + WS_NP))[(size_t)(item_) * 128 + tid - 64]; } while (0)
    int item = F.vcu, kb = 0, cur_h = -1;
    if (item >= 1024) return;
    P5_LOAD(item);
    for (;;) {
    const int b = item >> 8, h = (item >> 6) & 3, c = item & 63;
    if ((kb & 3) == 0 && wid < 4) {
        const int it2 = item + wid * F.G;
        if (it2 < 1024) { const int b2 = it2 >> 8, h2 = (it2 >> 6) & 3, c2 = it2 & 63; const size_t zr = (size_t)(b2 * SEQ + c2 * 64 + lane) * ZP;
            const float ig = bf2f(Z[zr + ZC_IG + h2]) + F.in[9][h2]; float g = logsigmoidf_(bf2f(Z[zr + ZC_FG + h2]) + F.in[9][4 + h2]);
            const float Mp = ((const float*)(F.ws + WS_SC))[2048 + it2];
#pragma unroll
            for (int o = 1; o < 64; o <<= 1) { const float t = __shfl_up(g, o); if (lane >= o) g += t; }
            const float u = ig - g; float pm = u;
#pragma unroll
            for (int o = 1; o < 64; o <<= 1) { const float t = __shfl_up(pm, o); if (lane >= o) pm = fmaxf(pm, t); }
            const float mm = fmaxf(Mp, pm);
            LAS float* gt = gtab + wid * 256;
            gt[lane] = u; gt[64 + lane] = mm; gt[128 + lane] = __expf(Mp - mm); gt[192 + lane] = __expf(-(g + mm)); } }
    if (h != cur_h) {
#pragma unroll
        for (int k = 0; k < 2; ++k) { const int i = tid + NTHR * k, tap = i >> 8, lc = i & 255; cwl[i] = F.in[10][tap * 1024 + (lc < 128 ? h * 128 + lc : 512 + h * 128 + lc - 128)]; }
        cur_h = h; }
    const LAS float* fu = gtab + (kb & 3) * 256; const LAS float* fmm = fu + 64; const LAS float* fiw = fu + 128; const LAS float* ffl = fu + 192;
    if (tid >= 64 && tid < 192) fnp[tid - 64] = np_n;
    __syncthreads();
#pragma unroll
    for (int rep = 0; rep < 2; ++rep) { const int task = tid + NTHR * rep, l = task >> 4, ch = task & 15;
        float qq[8], kk[8];
        conv8_calc_lds(cwl, 256, rq[rep], ch * 8, qq);
        conv8_calc_lds(cwl, 256, rk[rep], 128 + ch * 8, kk);
        const float iw = fiw[l];
        u32x4 wq, wp, wk;
        wq.x = pk2(qq[0], qq[1]); wq.y = pk2(qq[2], qq[3]); wq.z = pk2(qq[4], qq[5]); wq.w = pk2(qq[6], qq[7]);
        wp.x = pk2(qq[0] * iw, qq[1] * iw); wp.y = pk2(qq[2] * iw, qq[3] * iw); wp.z = pk2(qq[4] * iw, qq[5] * iw); wp.w = pk2(qq[6] * iw, qq[7] * iw);
        const float sk = 0.08838834764831845f;
        wk.x = pk2(kk[0] * sk, kk[1] * sk); wk.y = pk2(kk[2] * sk, kk[3] * sk); wk.z = pk2(kk[4] * sk, kk[5] * sk); wk.w = pk2(kk[6] * sk, kk[7] * sk);
        *(LAS u32x4*)(Qs + l * QS_STRIDE + ch * 8) = wq; *(LAS u32x4*)(Qp + l * QS_STRIDE + ch * 8) = wp; *(LAS u32x4*)(Ks + l * QS_STRIDE + ch * 8) = wk;
        const bf16x8 vv = rvv[rep];
#pragma unroll
        for (int j = 0; j < 8; ++j) VT[(ch * 8 + j) * KT_STRIDE + l] = (bf16)vv[j]; }
    {
#pragma unroll
        for (int i = 0; i < 4; ++i) { const int q = tid + NTHR * i, e = q >> 4, d8 = (q & 15) * 8; *(LAS u32x4*)(CT + e * QS_STRIDE + d8) = cpv[i]; } }
    unsigned short og[16];
#pragma unroll
    for (int r = 0; r < 16; ++r) og[r] = ogn[r];
    const int nitem = item + F.G;
    if (nitem < 1024) P5_LOAD(nitem);
    __syncthreads();
    if (wid < 4) {
        const int lt = wid >> 1, st = wid & 1;
        f32x16 acc = {}; acc = mma32_lds(Qs + lt * 32 * QS_STRIDE, QS_STRIDE, Ks + st * 32 * QS_STRIDE, QS_STRIDE, 8, r32, hi, acc);
        const int s = st * 32 + r32; const float us = fu[s];
#pragma unroll
        for (int r = 0; r < 16; ++r) { const int l = lt * 32 + crow(r, hi); const float w = (s <= l) ? __expf(us - fmm[l]) * acc[r] : 0.f; Wm[l * KT_STRIDE + s] = (bf16)f2bf(w); }
    }
    __syncthreads();
    {
        const int l = tid >> 3, part = tid & 7; float dsum = 0.f;
#pragma unroll
        for (int s = 0; s < 8; ++s) dsum += bf2f(Wm[l * KT_STRIDE + part * 8 + s]);
#pragma unroll
        for (int d = 0; d < 16; ++d) dsum += bf2f(Qp[l * QS_STRIDE + part * 16 + d]) * fnp[part * 16 + d];
        dsum += __shfl_xor(dsum, 1); dsum += __shfl_xor(dsum, 2); dsum += __shfl_xor(dsum, 4);
        if (part == 0) frd[l] = 1.0f / fmaxf(fabsf(dsum), ffl[l]);
    }
    f32x16 acc = {};
    {
        const int lt = wid & 1, et = wid >> 1;
        acc = mma32_lds(Wm + lt * 32 * KT_STRIDE, KT_STRIDE, VT + et * 32 * KT_STRIDE, KT_STRIDE, 4, r32, hi, acc);
        acc = mma32_lds(Qp + lt * 32 * QS_STRIDE, QS_STRIDE, CT + et * 32 * QS_STRIDE, QS_STRIDE, 8, r32, hi, acc);
        __syncthreads();
        bf16* Y = (bf16*)(F.ws + WS_YMIX);
        const int e = et * 32 + r32;
#pragma unroll
        for (int r = 0; r < 16; ++r) { const int l = lt * 32 + crow(r, hi); const size_t row = (size_t)(b * SEQ + c * 64 + l);
            Y[row * 1024 + h * 128 + e] = (bf16)f2bf(acc[r] * frd[l] * sigmoidf_(bf2f(og[r]))); }
    }
    __syncthreads();
    if (nitem >= 1024) break;
    item = nitem; ++kb;
    }
#undef P5_LOAD
}

template <int L> __device__ __forceinline__ float rtree(const LAS float* WR, const f32x4 (&h2)[4], int base, int lane) {
    if constexpr (L == 0) { float s = 0.f;
#pragma unroll
        for (int j = 0; j < 4; ++j) { const f32x4 w = *(const LAS f32x4*)(WR + base * 1024 + 4 * lane + 256 * j); s += (h2[j].x * w.x + h2[j].y * w.y) + (h2[j].z * w.z + h2[j].w * w.w); }
        return s;
    } else {
        const float lo = rtree<L - 1>(WR, h2, base, lane), hh = rtree<L - 1>(WR, h2, base + (1 << (L - 1)), lane);
        const bool up = (lane & (1 << L)) != 0;
        return (up ? hh : lo) + __shfl_xor(up ? lo : hh, 1 << L);
    }
}
__device__ __forceinline__ void wave_sum2(float (&v)[2]) {
    const int lane = threadIdx.x & 63;
#define WS2_STEP(M) do { const float a = xchg_f<M>(v[0], lane), b = xchg_f<M>(v[1], lane); v[0] += a; v[1] += b; } while (0)
    WS2_STEP(1); WS2_STEP(2); WS2_STEP(4); WS2_STEP(8); WS2_STEP(16); WS2_STEP(32);
#undef WS2_STEP
}
#define RT_MASK(L) ((L) == 1 ? 1 : (L) == 2 ? 2 : (L) == 3 ? 32 : (L) == 4 ? 4 : 8)
__device__ __forceinline__ int router_expert(int lane) { return (lane & 3) | (((lane >> 5) & 1) << 2) | (((lane >> 2) & 3) << 3); }
template <int L> __device__ __forceinline__ f32x2 rtree2(const LAS float* WR, const f32x4 (&h2)[2][4], int base, int lane) {
    if constexpr (L == 0) { f32x2 a0 = {0.f, 0.f}, a1 = {0.f, 0.f};
#pragma unroll
        for (int j = 0; j < 4; ++j) { const f32x4 w = *(const LAS f32x4*)(WR + base * 1024 + 4 * lane + 256 * j);
            const f32x2 wl = {w.x, w.y}, wh = {w.z, w.w};
            a0 = __builtin_elementwise_fma((f32x2){h2[0][j].x, h2[0][j].y}, wl, a0); a0 = __builtin_elementwise_fma((f32x2){h2[0][j].z, h2[0][j].w}, wh, a0);
            a1 = __builtin_elementwise_fma((f32x2){h2[1][j].x, h2[1][j].y}, wl, a1); a1 = __builtin_elementwise_fma((f32x2){h2[1][j].z, h2[1][j].w}, wh, a1); }
        f32x2 s; s.x = a0.x + a0.y; s.y = a1.x + a1.y;
        return s;
    } else {
        const f32x2 lo = rtree2<L - 1>(WR, h2, base, lane), hh = rtree2<L - 1>(WR, h2, base + (1 << (L - 1)), lane);
        const bool up = (lane & RT_MASK(L)) != 0;
        f32x2 r; r.x = (up ? hh.x : lo.x) + xchg_f<RT_MASK(L)>(up ? lo.x : hh.x, lane); r.y = (up ? hh.y : lo.y) + xchg_f<RT_MASK(L)>(up ? lo.y : hh.y, lane);
        return r;
    }
}
__device__ __forceinline__ void p7_rows(Frame& F) {
    LAS float* WR = (LAS float*)F.lds;
    LAS int* lcnt = (LAS int*)(F.lds + TAB_OFF);
    LAS int* gbase = lcnt + 32;
    LAS int* rinfo = gbase + 32;
    const float* MODF = (const float*)(F.ws + WS_MODF);
    const int lane = F.lane, tid = F.tid;
    for (int i = tid; i < 32 * 1024 / 4; i += NTHR) ((LAS f32x4*)WR)[i] = ((const f32x4*)(F.ws + WS_WRT))[i];
    for (int rb = F.vcu; rb < M / 64; rb += F.G) {
        const int b = (rb * 64) / SEQ;
        if (tid < 32) lcnt[tid] = 0;
        __syncthreads();
        LAS float* A7 = (LAS float*)(F.lds + TAB_OFF + 4096); LAS float* G2 = A7 + 1024; LAS float* S2 = G2 + 1024;
        for (int c0 = tid; c0 < 1024; c0 += NTHR) { A7[c0] = F.in[5][c0] * MODF[b * 6144 + 2048 + c0]; G2[c0] = F.in[6][c0] * (MODF[b * 6144 + 4096 + c0] + 1.0f); S2[c0] = MODF[b * 6144 + 3072 + c0]; }
        __syncthreads();
        u32x2 yw[2][2][4]; f32x4 xw[2][2][4];
        const int row0 = rb * 64 + F.wave * 8;
#pragma unroll
        for (int r = 0; r < 2; ++r) { const u32x2* yr = (const u32x2*)((const bf16*)(F.ws + WS_Y) + (size_t)(row0 + r) * 1024) + lane; const f32x4* xr = (const f32x4*)(F.in[0] + (size_t)(row0 + r) * 1024) + lane;
#pragma unroll
            for (int j = 0; j < 4; ++j) { yw[0][r][j] = yr[64 * j]; xw[0][r][j] = xr[64 * j]; } }
        const float brt = F.in[18][router_expert(lane)];
#pragma unroll
        for (int ip = 0; ip < 4; ++ip) {
            const int rl0 = F.wave * 8 + 2 * ip, rowp = rb * 64 + rl0;
            if (ip < 3) {
#pragma unroll
                for (int r = 0; r < 2; ++r) { const u32x2* yr = (const u32x2*)((const bf16*)(F.ws + WS_Y) + (size_t)(rowp + 2 + r) * 1024) + lane; const f32x4* xr = (const f32x4*)(F.in[0] + (size_t)(rowp + 2 + r) * 1024) + lane;
#pragma unroll
                    for (int j = 0; j < 4; ++j) { yw[(ip + 1) & 1][r][j] = yr[64 * j]; xw[(ip + 1) & 1][r][j] = xr[64 * j]; } } }
            f32x4 y[2][4], x1[2][4], h2[2][4]; float ss[2] = {0.f, 0.f};
#pragma unroll
            for (int r = 0; r < 2; ++r)
#pragma unroll
                for (int j = 0; j < 4; ++j) { const u32x2 w = yw[ip & 1][r][j]; y[r][j] = (f32x4){bf2f(w.x & 0xffffu), bf2f(w.x >> 16), bf2f(w.y & 0xffffu), bf2f(w.y >> 16)};
                    ss[r] += (y[r][j].x * y[r][j].x + y[r][j].y * y[r][j].y) + (y[r][j].z * y[r][j].z + y[r][j].w * y[r][j].w); }
            wave_sum2(ss);
            float s1[2] = {0.f, 0.f};
#pragma unroll
            for (int r = 0; r < 2; ++r) { const float rs = rsqrtf(ss[r] * (1.0f / 1024.0f) + EPS);
#pragma unroll
                for (int j = 0; j < 4; ++j) { x1[r][j] = xw[ip & 1][r][j] + *(const LAS f32x4*)(A7 + 4 * lane + 256 * j) * (y[r][j] * rs); s1[r] += (x1[r][j].x * x1[r][j].x + x1[r][j].y * x1[r][j].y) + (x1[r][j].z * x1[r][j].z + x1[r][j].w * x1[r][j].w);
                    ((f32x4*)(F.out + (size_t)(rowp + r) * 1024))[lane + 64 * j] = x1[r][j]; } }
            wave_sum2(s1);
#pragma unroll
            for (int r = 0; r < 2; ++r) { const float rs1 = rsqrtf(s1[r] * (1.0f / 1024.0f) + EPS);
                unsigned* ho = (unsigned*)(F.ws + WS_H + (size_t)(rowp + r) * 1024) + lane;
#pragma unroll
                for (int j = 0; j < 4; ++j) { h2[r][j] = x1[r][j] * rs1 * *(const LAS f32x4*)(G2 + 4 * lane + 256 * j) + *(const LAS f32x4*)(S2 + 4 * lane + 256 * j); ho[64 * j] = pk4_fp8(h2[r][j].x, h2[r][j].y, h2[r][j].z, h2[r][j].w); } }
            f32x2 lg = rtree2<5>(WR, h2, 0, lane);
            lg.x += __shfl_xor(lg.x, 16); lg.y += __shfl_xor(lg.y, 16);
            lg.x += brt; lg.y += brt;
            const int e = router_expert(lane);
            float tvv[2][4]; int tee[2][4]; float cand0 = lg.x, cand1 = lg.y;
#define TOPK_STEP(MASK) do { const float ov0 = xchg_f<MASK>(v0, lane), ov1 = xchg_f<MASK>(v1, lane); const int oi0 = xchg_i<MASK>(i0, lane), oi1 = xchg_i<MASK>(i1, lane); \
                    if (ov0 > v0 || (ov0 == v0 && oi0 < i0)) { v0 = ov0; i0 = oi0; } if (ov1 > v1 || (ov1 == v1 && oi1 < i1)) { v1 = ov1; i1 = oi1; } } while (0)
#pragma unroll
            for (int k = 0; k < 4; ++k) { float v0 = cand0, v1 = cand1; int i0 = e, i1 = e;
                TOPK_STEP(1); TOPK_STEP(2); TOPK_STEP(32); TOPK_STEP(4); TOPK_STEP(8);
                tvv[0][k] = v0; tee[0][k] = i0; tvv[1][k] = v1; tee[1][k] = i1; if (e == i0) cand0 = -INFINITY; if (e == i1) cand1 = -INFINITY; }
#undef TOPK_STEP
#pragma unroll
            for (int r = 0; r < 2; ++r) { int te[4]; float tv[4];
#pragma unroll
                for (int k = 0; k < 4; ++k) { te[k] = tee[r][k]; tv[k] = tvv[r][k]; }
                const float e1 = __expf(tv[1] - tv[0]), e2 = __expf(tv[2] - tv[0]), e3 = __expf(tv[3] - tv[0]); const float inv = 1.0f / (1.0f + e1 + e2 + e3);
                if (lane < 4) { const int ek = lane == 0 ? te[0] : lane == 1 ? te[1] : lane == 2 ? te[2] : te[3]; const float gk = (lane == 0 ? 1.0f : lane == 1 ? e1 : lane == 2 ? e2 : e3) * inv;
                    const int lr = __hip_atomic_fetch_add(&lcnt[ek], 1, __ATOMIC_RELAXED, __HIP_MEMORY_SCOPE_WORKGROUP); const int rl = rl0 + r;
                    rinfo[(rl * 4 + lane) * 3 + 0] = ek; rinfo[(rl * 4 + lane) * 3 + 1] = lr; rinfo[(rl * 4 + lane) * 3 + 2] = __float_as_int(gk); } }
        }
        __syncthreads();
        if (tid < 32) gbase[tid] = (int)__hip_atomic_fetch_add(F.ctl + CW_CNT + 64 * tid, (unsigned)lcnt[tid], RLX_AGENT);
        __syncthreads();
        if (tid < 256) { const int rl = tid >> 2, k = tid & 3, row = rb * 64 + rl; const int ek = rinfo[tid * 3], rank = gbase[ek] + rinfo[tid * 3 + 1];
            ((int*)(F.ws + WS_TOKE))[row * 4 + k] = ek; ((int*)(F.ws + WS_TOKR))[row * 4 + k] = rank; ((int*)(F.ws + WS_TOKG))[row * 4 + k] = rinfo[tid * 3 + 2];
            ((int*)(F.ws + WS_ROWTOK))[(size_t)ek * ECAP + rank] = row; }
        __syncthreads();
    }
}

struct MoeTabs { LAS int* cnt; LAS int* tbase; LAS int* tile_e; LAS int* tile_r0; LAS int* idx; };
__device__ __forceinline__ MoeTabs moe_tabs(const Frame& F) { MoeTabs t; t.cnt = (LAS int*)(F.lds + TAB_OFF); t.tbase = t.cnt + 32; t.tile_e = t.tbase + 40; t.tile_r0 = t.tile_e + MAXT; t.idx = t.tile_r0 + MAXT; return t; }
__device__ __forceinline__ int moe_build_tabs(const Frame& F, const MoeTabs& T) {
    if (F.tid < 32) T.cnt[F.tid] = (int)__hip_atomic_load(F.ctl + CW_CNT + 64 * F.tid, RLX_AGENT);
    __syncthreads();
    if (F.tid < 32) { int s0 = 0, tot = 0;
#pragma unroll
        for (int e = 0; e < 32; ++e) { const int n = (T.cnt[e] + 255) >> 8; s0 += (e < F.tid) ? n : 0; tot += n; }
        T.tbase[F.tid] = s0; if (F.tid == 0) T.tbase[32] = tot;
        const int n = (T.cnt[F.tid] + 255) >> 8; for (int t = 0; t < n; ++t) { T.tile_e[s0 + t] = F.tid; T.tile_r0[s0 + t] = t * 256; } }
    __syncthreads();
    return T.tbase[32];
}
constexpr int MAXU = 12;
struct MoeUpSched {
    int NT, G, c; LAS const int* tile_e; LAS const int* idx;
    __device__ __forceinline__ bool next(int i, pg8::Unit& u) const { const int L = i * G + c; if (L >= NT * 8 || i >= MAXU) return false; u.pm = L >> 3; u.pn = L & 7; u.e = tile_e[u.pm]; u.ui = i; return true; }
    __device__ __forceinline__ unsigned arow(const pg8::Unit& u, int r) const { return (unsigned)idx[u.ui * 256 + r]; }
    __device__ __forceinline__ size_t boff(const pg8::Unit& u) const { return ((size_t)u.e * 2048 + (size_t)u.pn * 256) * 1024; }
};
struct MoeDownSched {
    int NT, G, c; LAS const int* tile_e;
    __device__ __forceinline__ bool next(int i, pg8::Unit& u) const { const int L = i * G + c; if (L >= NT * 4) return false; u.pm = L >> 2; u.pn = L & 3; u.e = tile_e[u.pm]; u.ui = i; return true; }
    __device__ __forceinline__ unsigned arow(const pg8::Unit& u, int r) const { return (unsigned)(u.pm * 256 + r); }
    __device__ __forceinline__ size_t boff(const pg8::Unit& u) const { return ((size_t)u.e * 1024 + (size_t)u.pn * 256) * 1024; }
};

__device__ __forceinline__ void p11_final(Frame& F, float* dstp) {
    const MoeTabs T = moe_tabs(F); (void)moe_build_tabs(F, T);
    const float* MODF = (const float*)(F.ws + WS_MODF); const int lane = F.lane;
    const bf16* YB = (const bf16*)(F.ws + WS_YB);
    for (int rb = F.vcu; rb < M / 64; rb += F.G) {
        const int b = (rb * 64) / SEQ;
        LAS float* A9 = (LAS float*)(F.lds + TAB_OFF + 16384);
        __syncthreads();
        for (int c0 = F.tid; c0 < 1024; c0 += NTHR) A9[c0] = F.in[7][c0] * MODF[b * 6144 + 5120 + c0];
        __syncthreads();
        const int row0 = rb * 64 + F.wave * 8;
        typedef int i32x4 __attribute__((ext_vector_type(4)));
        const i32x4* TE = (const i32x4*)(F.ws + WS_TOKE); const i32x4* TR = (const i32x4*)(F.ws + WS_TOKR); const f32x4* TG = (const f32x4*)(F.ws + WS_TOKG);
        i32x4 ie1 = TE[row0 + 1], ir1 = TR[row0 + 1]; f32x4 ig0 = TG[row0], ig1 = TG[row0 + 1];
        u32x4 ywc[4][2], ywn[4][2]; f32x4 xwc[4], xwn[4];
        { const i32x4 ie0 = TE[row0], ir0 = TR[row0];
#pragma unroll
          for (int k = 0; k < 4; ++k) { const u32x4* yr = (const u32x4*)(YB + ((size_t)T.tbase[ie0[k]] * 256 + ir0[k]) * 1024) + lane;
#pragma unroll
              for (int jj = 0; jj < 2; ++jj) ywc[k][jj] = yr[64 * jj]; } }
#pragma unroll
        for (int jj = 0; jj < 2; ++jj) { const f32x4* xr = (const f32x4*)(F.out + (size_t)row0 * 1024) + 2 * lane + 128 * jj; xwc[2 * jj] = xr[0]; xwc[2 * jj + 1] = xr[1]; }
#pragma unroll 1
        for (int i = 0; i < 8; ++i) {
            const int row = row0 + i;
            i32x4 ie2 = ie1, ir2 = ir1; f32x4 ig2 = ig1;
            if (i + 2 < 8) { ie2 = TE[row + 2]; ir2 = TR[row + 2]; ig2 = TG[row + 2]; }
            if (i + 1 < 8) {
#pragma unroll
                for (int k = 0; k < 4; ++k) { const u32x4* yr = (const u32x4*)(YB + ((size_t)T.tbase[ie1[k]] * 256 + ir1[k]) * 1024) + lane;
#pragma unroll
                    for (int jj = 0; jj < 2; ++jj) ywn[k][jj] = yr[64 * jj]; }
#pragma unroll
                for (int jj = 0; jj < 2; ++jj) { const f32x4* xr = (const f32x4*)(F.out + (size_t)(row + 1) * 1024) + 2 * lane + 128 * jj; xwn[2 * jj] = xr[0]; xwn[2 * jj + 1] = xr[1]; } }
            f32x4 y[4];
#pragma unroll
            for (int j = 0; j < 4; ++j) y[j] = (f32x4){0.f, 0.f, 0.f, 0.f};
#pragma unroll
            for (int k = 0; k < 4; ++k)
#pragma unroll
                for (int jj = 0; jj < 2; ++jj) { const u32x4 w = ywc[k][jj];
                    y[2 * jj] += (f32x4){bf2f(w.x & 0xffffu), bf2f(w.x >> 16), bf2f(w.y & 0xffffu), bf2f(w.y >> 16)} * ig0[k];
                    y[2 * jj + 1] += (f32x4){bf2f(w.z & 0xffffu), bf2f(w.z >> 16), bf2f(w.w & 0xffffu), bf2f(w.w >> 16)} * ig0[k]; }
            float ss = 0.f;
#pragma unroll
            for (int j = 0; j < 4; ++j) ss += (y[j].x * y[j].x + y[j].y * y[j].y) + (y[j].z * y[j].z + y[j].w * y[j].w);
            const float rs = rsqrtf(wave_sum(ss) * (1.0f / 1024.0f) + EPS);
#pragma unroll
            for (int jj = 0; jj < 2; ++jj) { f32x4* orow = (f32x4*)(dstp + (size_t)row * 1024) + 2 * lane + 128 * jj; const LAS f32x4* a9 = (const LAS f32x4*)(A9 + 8 * lane + 512 * jj);
                orow[0] = xwc[2 * jj] + a9[0] * (y[2 * jj] * rs); orow[1] = xwc[2 * jj + 1] + a9[1] * (y[2 * jj + 1] * rs); }
            ig0 = ig1; ie1 = ie2; ir1 = ir2; ig1 = ig2;
#pragma unroll
            for (int k = 0; k < 4; ++k)
#pragma unroll
                for (int jj = 0; jj < 2; ++jj) ywc[k][jj] = ywn[k][jj];
#pragma unroll
            for (int j = 0; j < 4; ++j) xwc[j] = xwn[j];
        }
    }
}

#ifndef MLSTM_FUSED
#define MLSTM_FUSED 0
#endif
__device__ __forceinline__ void mlstm_fused(Frame& F, int b, int h, int eh) {
    const int tid = F.tid, lane = F.lane, r32 = lane & 31, hi = lane >> 5, wid = F.wave;
    LAS bf16* Qs = (LAS bf16*)F.lds;
    LAS bf16* Qp = Qs + 64 * QS_STRIDE;
    LAS bf16* Ks = Qp + 64 * QS_STRIDE;
    LAS bf16* KT = Ks + 64 * QS_STRIDE;
    LAS bf16* VT = KT + 128 * KT_STRIDE;
    LAS bf16* VwT = VT + 64 * KT_STRIDE;
    LAS bf16* CT = VwT + 64 * KT_STRIDE;
    LAS bf16* Wm = CT + 64 * QS_STRIDE;
    LAS float* fu = (LAS float*)(Wm + 64 * KT_STRIDE);
    LAS float* fmm = fu + 64; LAS float* fiw = fu + 128; LAS float* ffl = fu + 192; LAS float* frd = fu + 256; LAS float* fwx = fu + 320; LAS float* fnp = fu + 384; LAS float* ms = fu + 512;
    const bf16* Z = (const bf16*)(F.ws + WS_Z);
    bf16* Y = (bf16*)(F.ws + WS_YMIX);
    const int e0 = eh * 64;
    for (int i = tid; i < 64 * QS_STRIDE; i += NTHR) CT[i] = 0;
    if (tid < 128) fnp[tid] = 0.f;
    if (tid == 0) ms[0] = -INFINITY;
    f32x16 st = {};
    ConvRaw rq[2], rk[2]; bf16x8 rv; unsigned short og[16]; unsigned short gi_raw = 0, gf_raw = 0;
#define MF_PREFETCH(c_) do { \
        _Pragma("unroll") for (int rep = 0; rep < 2; ++rep) { const int task = tid + NTHR * rep, l = task >> 4, ch = task & 15, t = (c_) * 64 + l; \
            conv8_load(F, b, t, ZC_QM + h * 128 + ch * 8, rq[rep]); conv8_load(F, b, t, ZC_KM + h * 128 + ch * 8, rk[rep]); } \
        { const int l = tid >> 3, chv = tid & 7; rv = *(const bf16x8*)(Z + (size_t)(b * SEQ + (c_) * 64 + l) * ZP + ZC_VM + h * 128 + e0 + chv * 8); } \
        if (wid < 4) { _Pragma("unroll") for (int r = 0; r < 16; ++r) { const int l = (wid & 1) * 32 + crow(r, hi); og[r] = Z[(size_t)(b * SEQ + (c_) * 64 + l) * ZP + ZC_OM + h * 128 + e0 + (wid >> 1) * 32 + r32]; } } \
        if (wid == 0) { const size_t zr_ = (size_t)(b * SEQ + (c_) * 64 + lane) * ZP; gi_raw = Z[zr_ + ZC_IG + h]; gf_raw = Z[zr_ + ZC_FG + h]; } } while (0)
    MF_PREFETCH(0);
    __syncthreads();
    for (int c = 0; c < 64; ++c) {
        if (wid == 0) {
            const float ig = bf2f(gi_raw) + F.in[9][h]; float g = logsigmoidf_(bf2f(gf_raw) + F.in[9][4 + h]);
#pragma unroll
            for (int o = 1; o < 64; o <<= 1) { const float t = __shfl_up(g, o); if (lane >= o) g += t; }
            const float u = ig - g; float pm = u;
#pragma unroll
            for (int o = 1; o < 64; o <<= 1) { const float t = __shfl_up(pm, o); if (lane >= o) pm = fmaxf(pm, t); }
            const float G = __shfl(g, 63), wl = G - g + ig, ml = wave_max(wl);
            const float m_old = ms[0], mm = fmaxf(m_old, pm), m_new = fmaxf(G + m_old, ml);
            fu[lane] = u; fmm[lane] = mm; fiw[lane] = __expf(m_old - mm); ffl[lane] = __expf(-(g + mm)); fwx[lane] = __expf(wl - m_new);
            if (lane == 0) { ms[1] = __expf(G + m_old - m_new); ms[2] = m_new; }
        }
        __syncthreads();
#pragma unroll
        for (int rep = 0; rep < 2; ++rep) { const int task = tid + NTHR * rep, l = task >> 4, ch = task & 15;
            float qq[8], kk[8];
            conv8_calc(F, rq[rep], h * 128 + ch * 8, qq); conv8_calc(F, rk[rep], 512 + h * 128 + ch * 8, kk);
            const float iw = fiw[l], sk = 0.08838834764831845f;
            u32x4 wq, wp, wk;
            wq.x = pk2(qq[0], qq[1]); wq.y = pk2(qq[2], qq[3]); wq.z = pk2(qq[4], qq[5]); wq.w = pk2(qq[6], qq[7]);
            wp.x = pk2(qq[0] * iw, qq[1] * iw); wp.y = pk2(qq[2] * iw, qq[3] * iw); wp.z = pk2(qq[4] * iw, qq[5] * iw); wp.w = pk2(qq[6] * iw, qq[7] * iw);
            wk.x = pk2(kk[0] * sk, kk[1] * sk); wk.y = pk2(kk[2] * sk, kk[3] * sk); wk.z = pk2(kk[4] * sk, kk[5] * sk); wk.w = pk2(kk[6] * sk, kk[7] * sk);
            *(LAS u32x4*)(Qs + l * QS_STRIDE + ch * 8) = wq; *(LAS u32x4*)(Qp + l * QS_STRIDE + ch * 8) = wp; *(LAS u32x4*)(Ks + l * QS_STRIDE + ch * 8) = wk;
#pragma unroll
            for (int j = 0; j < 8; ++j) KT[(ch * 8 + j) * KT_STRIDE + l] = (bf16)f2bf(kk[j] * sk); }
        { const int l = tid >> 3, chv = tid & 7; const float we = fwx[l];
#pragma unroll
            for (int j = 0; j < 8; ++j) { VT[(chv * 8 + j) * KT_STRIDE + l] = (bf16)rv[j]; VwT[(chv * 8 + j) * KT_STRIDE + l] = (bf16)f2bf(bf2f((unsigned short)rv[j]) * we); } }
        unsigned short ogc[16];
#pragma unroll
        for (int r = 0; r < 16; ++r) ogc[r] = og[r];
        if (c + 1 < 64) MF_PREFETCH(c + 1);
        __syncthreads();
        if (wid < 4) {
            const int lt = wid >> 1, stl = wid & 1;
            f32x16 acc = {}; acc = mma32_lds(Qs + lt * 32 * QS_STRIDE, QS_STRIDE, Ks + stl * 32 * QS_STRIDE, QS_STRIDE, 8, r32, hi, acc);
            const int s_ = stl * 32 + r32; const float us = fu[s_];
#pragma unroll
            for (int r = 0; r < 16; ++r) { const int l = lt * 32 + crow(r, hi); const float w = (s_ <= l) ? __expf(us - fmm[l]) * acc[r] : 0.f; Wm[l * KT_STRIDE + s_] = (bf16)f2bf(w); }
        }
        __syncthreads();
        if (tid < 64) { float dsum = 0.f;
#pragma unroll 8
            for (int s_ = 0; s_ < 64; ++s_) dsum += bf2f(Wm[tid * KT_STRIDE + s_]);
#pragma unroll 8
            for (int d = 0; d < 128; ++d) dsum += bf2f(Qp[tid * QS_STRIDE + d]) * fnp[d];
            frd[tid] = 1.0f / fmaxf(fabsf(dsum), ffl[tid]); }
        f32x16 num = {};
        if (wid < 4) { const int lt = wid & 1, et = wid >> 1;
            num = mma32_lds(Wm + lt * 32 * KT_STRIDE, KT_STRIDE, VT + et * 32 * KT_STRIDE, KT_STRIDE, 4, r32, hi, num);
            num = mma32_lds(Qp + lt * 32 * QS_STRIDE, QS_STRIDE, CT + et * 32 * QS_STRIDE, QS_STRIDE, 8, r32, hi, num); }
        { const float a = ms[1];
#pragma unroll
            for (int r = 0; r < 16; ++r) st[r] *= a;
            st = mma32_lds(VwT + (wid & 1) * 32 * KT_STRIDE, KT_STRIDE, KT + (wid >> 1) * 32 * KT_STRIDE, KT_STRIDE, 4, r32, hi, st); }
        __syncthreads();
        if (wid < 4) { const int lt = wid & 1, et = wid >> 1, e = e0 + et * 32 + r32;
#pragma unroll
            for (int r = 0; r < 16; ++r) { const int l = lt * 32 + crow(r, hi); const size_t row = (size_t)(b * SEQ + c * 64 + l);
                Y[row * 1024 + h * 128 + e] = (bf16)f2bf(num[r] * frd[l] * sigmoidf_(bf2f(ogc[r]))); } }
#pragma unroll
        for (int r = 0; r < 16; ++r) CT[((wid & 1) * 32 + crow(r, hi)) * QS_STRIDE + (wid >> 1) * 32 + r32] = (bf16)f2bf(st[r]);
        if (tid >= 256 && tid < 384) { const int d = tid - 256; float s_ = 0.f;
#pragma unroll 8
            for (int l = 0; l < 64; ++l) s_ += fwx[l] * bf2f(KT[d * KT_STRIDE + l]);
            fnp[d] = ms[1] * fnp[d] + s_; }
        __syncthreads();
        if (tid == 0) ms[0] = ms[2];
    }
    __syncthreads();
#undef MF_PREFETCH
}

__device__ __forceinline__ void ph2_zgemm(Frame& F) {
    unsigned char* ws = F.ws;
    pg8::StaticSched S; S.init(M, ZP, 1024, F.G, (int)blockIdx.x);
    pg8::EpiBf16 E{(bf16*)(ws + WS_Z), ZP, nullptr, 0};
    pg8::gemm_phase<false>(F.lds, (const bf16*)(ws + WS_H), (const bf16*)(ws + WS_WIN), 1024, S, E);
}
__device__ __forceinline__ void ph3_local(Frame& F) {
    for (int wi = F.vcu; wi < 256; wi += F.G) p3_compress_item(F, wi);
#if !MLSTM_FUSED
    p3_mlstm_a_items(F);
#endif
}
#ifndef ATT_PROBE
#define ATT_PROBE -1
#endif
constexpr int CW_AQ = 20480;
__device__ __forceinline__ void ph4_scan_attn(Frame& F) {
#if MLSTM_FUSED
    if (F.vcu < 32) mlstm_fused(F, F.vcu >> 3, (F.vcu >> 1) & 3, F.vcu & 1);
    volatile LAS unsigned* qslot = (volatile LAS unsigned*)(F.lds + LDSCTL_OFF + 512);
    for (;;) {
        __syncthreads();
        if (F.tid == 0) qslot[0] = __hip_atomic_fetch_add(F.ctl + CW_AQ, 1u, RLX_AGENT);
        __syncthreads();
        const int q = (int)qslot[0];
        if (q >= 512) break;
        const int cur = 63 - (q >> 3), bg = q & 7;
        nsa::attn_unit<0>(F, bg >> 1, bg & 1, cur, (bf16*)(F.ws + WS_YMIX), true);
    }
#else
    p4_scan(F); __syncthreads();
    if (ATT_PROBE >= 0) { nsa::p4_attention<(ATT_PROBE < 0 ? 0 : ATT_PROBE)>(F, (bf16*)(F.ws + WS_ACT)); __syncthreads(); }
    nsa::p4_attention<0>(F, (bf16*)(F.ws + WS_YMIX));
#endif
}
__device__ __forceinline__ void ph5_mlstm_out(Frame& F) {
#if !MLSTM_FUSED
    p5_mlstm_c_items(F);
#endif
}
__device__ __forceinline__ void ph6_wout(Frame& F) {
    unsigned char* ws = F.ws;
    pg8::StaticSched S; S.init(M, 1024, 1024, F.G, (int)blockIdx.x);
    pg8::EpiBf16 E{(bf16*)(ws + WS_Y), 1024, nullptr, 0};
    pg8::gemm_phase<false>(F.lds, (const bf16*)(ws + WS_YMIX), (const bf16*)(ws + WS_WOUT), 1024, S, E);
}
__device__ __forceinline__ void ph8_up(Frame& F) {
    unsigned char* ws = F.ws;
    const MoeTabs T = moe_tabs(F); const int NT = moe_build_tabs(F, T);
    const int* rowtok = (const int*)(ws + WS_ROWTOK);
    for (int i = 0; i < MAXU; ++i) { const int L = i * F.G + F.vcu; if (L >= NT * 8) break; const int t = L >> 3, e = T.tile_e[t], r0 = T.tile_r0[t];
        for (int r = F.tid; r < 256; r += NTHR) { const int gi = r0 + r; T.idx[i * 256 + r] = gi < T.cnt[e] ? rowtok[(size_t)e * ECAP + gi] : 0; } }
    __syncthreads();
    MoeUpSched S{NT, F.G, F.vcu, T.tile_e, T.idx};
    pg8::EpiSwiglu E{(unsigned char*)(ws + WS_ACT), F.in[20]};
    pg8::gemm_phase<true>(F.lds, (const bf16*)(ws + WS_H), (const bf16*)(ws + WS_WUP), 512, S, E);
}
__device__ __forceinline__ void ph9_down(Frame& F) {
    unsigned char* ws = F.ws;
    const MoeTabs T = moe_tabs(F); const int NT = moe_build_tabs(F, T);
    MoeDownSched S{NT, F.G, F.vcu, T.tile_e};
    pg8::EpiBf16 E{(bf16*)(ws + WS_YB), 1024, F.in[22], 1024};
    pg8::gemm_phase<true>(F.lds, (const bf16*)(ws + WS_ACT), (const bf16*)(ws + WS_WDN), 512, S, E);
}

constexpr int N_PHASES = 11;
struct Args { const float* in[23]; float* out; unsigned char* ws; int ph_lo, ph_hi; };
__global__ void __launch_bounds__(NTHR, 2) hybrid_fwd(Args args) {
    extern __shared__ __attribute__((aligned(16))) unsigned char lds_raw[];
    Frame F;
    F.lds = (LAS unsigned char*)lds_raw;
    F.tid = threadIdx.x; F.lane = F.tid & 63; F.wave = __builtin_amdgcn_readfirstlane(F.tid >> 6);
    F.G = gridDim.x; { const int bx = blockIdx.x; F.vcu = (F.G % 8 == 0) ? (bx % 8) * (F.G / 8) + bx / 8 : bx; }
    F.ws = args.ws; F.ctl = (unsigned*)(args.ws + WS_CTL); F.out = args.out;
    F.in = (const float* const __attribute__((address_space(4)))*)__builtin_amdgcn_kernarg_segment_ptr();
    for (int u = F.tid; u < (LDS_BYTES - LDSCTL_OFF) / 4; u += NTHR) ((LAS unsigned*)(F.lds + LDSCTL_OFF))[u] = 0u;
    __syncthreads();
    volatile LAS unsigned* MISC = (volatile LAS unsigned*)(F.lds + MISC_OFF);
    XcdBarrier bar; bar.bar = F.ctl + CW_BAR; bar.x = 0; bar.st = nullptr;
    if (!MK_PER_PHASE) bar = xcd_barrier_post(F.ctl + CW_BAR, MISC + 8);
    const int lo = args.ph_lo, hi = args.ph_hi;
#ifndef PH_MASK
#define PH_MASK 0x7ff
#endif
#define IN(k) (((PH_MASK >> (k)) & 1) && lo <= (k) && (k) < hi)
#define SEAM(k) do { if (IN(k) && IN((k) + 1)) xcd_barrier(bar); } while (0)
#ifndef PH_TWICE
#define PH_TWICE 0
#endif
#define RUNPH(k, call) do { if (IN(k)) { call; if ((PH_TWICE >> (k)) & 1) { xcd_barrier(bar); call; } } } while (0)
    RUNPH(0, p0_prologue(F)); SEAM(0);
    RUNPH(1, p1_rows(F)); SEAM(1);
    RUNPH(2, ph2_zgemm(F)); SEAM(2);
    RUNPH(3, ph3_local(F)); SEAM(3);
    RUNPH(4, ph4_scan_attn(F));
#if !MLSTM_FUSED
    SEAM(4);
#endif
    RUNPH(5, ph5_mlstm_out(F)); SEAM(5);
    RUNPH(6, ph6_wout(F)); SEAM(6);
    RUNPH(7, p7_rows(F)); SEAM(7);
    RUNPH(8, ph8_up(F)); SEAM(8);
    RUNPH(9, ph9_down(F)); SEAM(9);
#ifdef P10_TWICE
    if (IN(10)) { p11_final(F, (float*)(F.ws + WS_DC)); xcd_barrier(bar); }
#endif
    RUNPH(10, p11_final(F, F.out));
#ifdef EXTRA_BARS
#pragma unroll 1
    for (int eb = 0; eb < EXTRA_BARS; ++eb) xcd_barrier(bar);
#endif
#undef RUNPH
#undef IN
#undef SEAM
}

extern "C" void kernel_launch(void* const* d_in, const int* in_sizes, int n_in, void* d_out, int out_size, void* d_ws, size_t ws_size, hipStream_t stream) {
    static int grid = 0;
    if (grid == 0) {
        if (n_in != 23 || out_size != M * D || ws_size < WS_END) { fprintf(stderr, "kernel_launch: unexpected shapes (n_in %d out %d ws %zu)\n", n_in, out_size, ws_size); grid = -1; return; }
        int dev = 0, cus = 0;
        if (hipGetDevice(&dev) != hipSuccess || hipDeviceGetAttribute(&cus, hipDeviceAttributeMultiprocessorCount, dev) != hipSuccess) { grid = -1; return; }
        if (hipFuncSetAttribute((const void*)hybrid_fwd, hipFuncAttributeMaxDynamicSharedMemorySize, LDS_BYTES) != hipSuccess) { fprintf(stderr, "kernel_launch: hipFuncSetAttribute failed\n"); grid = -1; return; }
        int per_cu = 0;
        if (hipOccupancyMaxActiveBlocksPerMultiprocessor(&per_cu, (const void*)hybrid_fwd, NTHR, LDS_BYTES) != hipSuccess || per_cu < 1) fprintf(stderr, "kernel_launch: occupancy query reports %d\n", per_cu);
        (void)hipGetLastError();
        grid = cus > 256 ? 256 : cus;
    }
    if (grid < 0) return;
    (void)hipMemsetAsync((char*)d_ws + WS_CTL, 0, CTL_ZERO_BYTES, stream);
    Args a{};
    for (int i = 0; i < 23; ++i) a.in[i] = (const float*)d_in[i];
    a.out = (float*)d_out; a.ws = (unsigned char*)d_ws;
#if MK_PER_PHASE
    for (int p = 0; p < N_PHASES; ++p) { a.ph_lo = p; a.ph_hi = p + 1; hipLaunchKernelGGL(hybrid_fwd, dim3(grid), dim3(NTHR), LDS_BYTES, stream, a); }
#else
    a.ph_lo = 0; a.ph_hi = N_PHASES;
    hipLaunchKernelGGL(hybrid_fwd, dim3(grid), dim3(NTHR), LDS_BYTES, stream, a);
#endif
}
```

```cpp
#include <hip/hip_runtime.h>
#include <cstdio>
#include <cstdint>
#include <cmath>

#define GAS __attribute__((address_space(1)))
#define LAS __attribute__((address_space(3)))
typedef unsigned short bf16;
typedef short bf16x8 __attribute__((ext_vector_type(8)));
typedef short s16x4 __attribute__((ext_vector_type(4)));
typedef float f32x4 __attribute__((ext_vector_type(4)));
typedef float f32x2 __attribute__((ext_vector_type(2)));
typedef float f32x16 __attribute__((ext_vector_type(16)));
typedef unsigned u32x4 __attribute__((ext_vector_type(4)));
typedef unsigned u32x2 __attribute__((ext_vector_type(2)));

#ifndef MK_PER_PHASE
#define MK_PER_PHASE 0
#endif

constexpr int BATCH = 4, SEQ = 4096, D = 1024, M = BATCH * SEQ;
constexpr int D_IN = 3360, ZP = 3584;
constexpr int ZC_QM = 0, ZC_KM = 512, ZC_VM = 1024, ZC_OM = 1536, ZC_QA = 2048, ZC_KC = 2560, ZC_VC = 2688, ZC_KS = 2816, ZC_VS = 2944,
              ZC_KW = 3072, ZC_VW = 3200, ZC_IG = 3328, ZC_FG = 3332, ZC_GA = 3336;
constexpr int NEXP = 32, TOPK = 4, ECAP = 16384, MAXT = 288;
constexpr float EPS = 1e-6f;
constexpr int NWAVES = 8, NTHR = 512;

constexpr size_t MiB = 1u << 20;
constexpr size_t WS_CTL = 0, CTL_ZERO_BYTES = 1 * MiB;
constexpr size_t WS_MODP = 1 * MiB;
constexpr size_t WS_MODF = 2 * MiB;
constexpr size_t WS_CMPB = 2 * MiB + 128 * 1024;
constexpr size_t WS_WCMP = 3 * MiB;
constexpr size_t WS_WIN = 4 * MiB;
constexpr size_t WS_WOUT = 12 * MiB;
constexpr size_t WS_WRT = 14 * MiB;
constexpr size_t WS_WUP = 16 * MiB;
constexpr size_t WS_WDN = 144 * MiB;
constexpr size_t WS_H = 208 * MiB;
constexpr size_t WS_Z = 240 * MiB;
constexpr size_t WS_YMIX = 352 * MiB;
constexpr size_t WS_Y = 384 * MiB;
constexpr size_t WS_DC = 416 * MiB;
constexpr size_t WS_DN = 480 * MiB;
constexpr size_t WS_SC = 481 * MiB;
constexpr size_t WS_KC = 482 * MiB;
constexpr size_t WS_VC = 483 * MiB;
constexpr size_t WS_ACT = 484 * MiB;
constexpr size_t WS_YB = 628 * MiB;
constexpr float YB_SCALE = 8.0f;
constexpr size_t WS_TOKE = 772 * MiB;
constexpr size_t WS_TOKR = 772 * MiB + 256 * 1024;
constexpr size_t WS_TOKG = 772 * MiB + 512 * 1024;
constexpr size_t WS_ROWTOK = 774 * MiB;
constexpr size_t WS_CP = 776 * MiB;
constexpr size_t WS_NP = 840 * MiB;
constexpr size_t WS_END = 841 * MiB;
constexpr int CW_TMO = 0, CW_BAR = 4096, CW_CNT = 16384;

constexpr int RING_BYTES = 131072;
constexpr int LDSCTL_OFF = RING_BYTES, MISC_OFF = LDSCTL_OFF + 320;
constexpr int TAB_OFF = LDSCTL_OFF + 1024;
constexpr int LDS_BYTES = 163840;

#define RLX_AGENT __ATOMIC_RELAXED, __HIP_MEMORY_SCOPE_AGENT
__device__ __forceinline__ float bf2f(unsigned v) { return __uint_as_float(v << 16); }
__device__ __forceinline__ unsigned f2bf(float f) { unsigned u = __float_as_uint(f); return (u + 0x7fffu + ((u >> 16) & 1u)) >> 16; }
__device__ __forceinline__ unsigned pk2(float lo, float hi) { unsigned r; asm volatile("v_cvt_pk_bf16_f32 %0, %1, %2" : "=v"(r) : "v"(lo), "v"(hi)); return r; }
__device__ __forceinline__ unsigned pk4_fp8(float a, float b, float c, float d) { int w = 0; w = __builtin_amdgcn_cvt_pk_fp8_f32(a, b, w, false); w = __builtin_amdgcn_cvt_pk_fp8_f32(c, d, w, true); return (unsigned)w; }
template <int MASK> __device__ __forceinline__ float xchg_f(float x, int lane) {
    if constexpr (MASK == 1) return __int_as_float(__builtin_amdgcn_mov_dpp(__float_as_int(x), 0xB1, 0xF, 0xF, true));
    else if constexpr (MASK == 2) return __int_as_float(__builtin_amdgcn_mov_dpp(__float_as_int(x), 0x4E, 0xF, 0xF, true));
    else if constexpr (MASK == 32) { auto rr = __builtin_amdgcn_permlane32_swap(__float_as_uint(x), __float_as_uint(x), false, false); return __uint_as_float((lane >> 5) ? rr[0] : rr[1]); }
    else return __shfl_xor(x, MASK);
}
template <int MASK> __device__ __forceinline__ int xchg_i(int x, int lane) { return __float_as_int(xchg_f<MASK>(__int_as_float(x), lane)); }
__device__ __forceinline__ float wave_sum(float v) {
    const int lane = threadIdx.x & 63;
    v += xchg_f<1>(v, lane); v += xchg_f<2>(v, lane); v += xchg_f<4>(v, lane); v += xchg_f<8>(v, lane); v += xchg_f<16>(v, lane); v += xchg_f<32>(v, lane);
    return v;
}
__device__ __forceinline__ float wave_max(float v) {
#pragma unroll
    for (int o = 1; o < 64; o <<= 1) v = fmaxf(v, __shfl_xor(v, o));
    return v;
}
__device__ __forceinline__ float sigmoidf_(float x) { return __builtin_amdgcn_rcpf(1.0f + __builtin_amdgcn_exp2f(-1.4426950408889634f * x)); }
__device__ __forceinline__ float siluf_(float x) { return x * sigmoidf_(x); }
__device__ __forceinline__ float logsigmoidf_(float x) { return fminf(x, 0.f) - log1pf(__expf(-fabsf(x))); }
__device__ __forceinline__ int crow(int r, int hi) { return (r & 3) + 8 * (r >> 2) + 4 * hi; }

__device__ __constant__ unsigned char T5B[128] = {0, 1, 2, 3, 4, 5, 6, 7, 8, 9, 10, 11, 12, 13, 14, 15, 16, 16, 16, 17, 17, 18, 18, 18, 19, 19, 19, 20, 20, 20, 20, 21, 21, 21, 21, 22, 22, 22, 22, 22, 23, 23, 23, 23, 23, 23, 24, 24, 24, 24, 24, 24, 25, 25, 25, 25, 25, 25, 25, 26, 26, 26, 26, 26, 26, 26, 26, 27, 27, 27, 27, 27, 27, 27, 27, 27, 27, 28, 28, 28, 28, 28, 28, 28, 28, 28, 28, 29, 29, 29, 29, 29, 29, 29, 29, 29, 29, 29, 29, 30, 30, 30, 30, 30, 30, 30, 30, 30, 30, 30, 30, 30, 30, 31, 31, 31, 31, 31, 31, 31, 31, 31, 31, 31, 31, 31, 31, 31};

namespace pg8 {
typedef int v8i32 __attribute__((ext_vector_type(8)));
typedef int v4i32 __attribute__((ext_vector_type(4)));
constexpr int BM = 256, BK = 64, HALF = 128, HTB = HALF * BK * 2, STAGE_BYTES = 8 * HTB, NXCD = 8, WGM = 8;
__host__ __device__ __forceinline__ int lds_byte(int r, int c) { const int st = (r >> 4) * 2 + (c >> 5), rr = r & 15, cc = c & 31, ob = rr * 64 + cc * 2; return st * 1024 + (ob ^ (((ob >> 9) & 1) << 5)); }
__host__ __device__ __forceinline__ void stage_rc(int b, int& R, int& C) { const int st = b / 1024, sb = b % 1024, swz = sb ^ (((sb >> 9) & 1) << 5); R = (st >> 1) * 16 + swz / 64; C = (st & 1) * 32 + (swz % 64) / 2; }
__host__ __device__ __forceinline__ int perm32(int rho) { const int n = rho >> 4, i = rho & 15; return 8 * (i >> 2) + 4 * n + (i & 3); }

__device__ __forceinline__ void glds16_s(const char* sbase, unsigned voff, unsigned lds_dst) { unsigned keep;
    asm volatile("s_mov_b32 %0, m0\n\ts_mov_b32 m0, %3\n\ts_nop 0\n\tglobal_load_lds_dwordx4 %1, %2\n\ts_mov_b32 m0, %0" : "=&s"(keep) : "v"(voff), "s"(sbase), "s"(lds_dst) : "memory"); }
__device__ __forceinline__ const char* uniform_ptr(const char* p) { const unsigned long long v = (unsigned long long)p;
    return (const char*)(((unsigned long long)(unsigned)__builtin_amdgcn_readfirstlane((int)(v >> 32)) << 32) | (unsigned)__builtin_amdgcn_readfirstlane((int)v)); }
struct Unit { int pm, pn, e, ui; };

struct StaticSched {
    int nM, nN, nwg, G, c, K;
    __device__ void init(int M_, int N_, int K_, int G_, int c_) { nM = M_ / BM; nN = N_ / BM; nwg = nM * nN; G = G_; c = c_; K = K_; }
    __device__ __forceinline__ bool next(int i, Unit& u) const {
        const long L = (long)i * G + c; if (L >= nwg) return false;
        int wgid = (int)L; { const int q = nwg / NXCD, r = nwg % NXCD, xcd = wgid % NXCD, off = wgid / NXCD; wgid = (xcd < r ? xcd * (q + 1) : r * (q + 1) + (xcd - r) * q) + off; }
        const int nig = WGM * nN, gid = wgid / nig, fm = gid * WGM, gsz = (nM - fm) < WGM ? (nM - fm) : WGM;
        u.pm = fm + ((wgid % nig) % gsz); u.pn = (wgid % nig) / gsz; u.e = 0; u.ui = i; return true;
    }
    __device__ __forceinline__ unsigned arow(const Unit& u, int r) const { return (unsigned)(u.pm * BM + r); }
    __device__ __forceinline__ size_t boff(const Unit& u) const { return (size_t)u.pn * BM * K * 2; }
};

struct EpiBf16 {
    bf16* O; int ldc; const float* bias; int bstride;
    __device__ __forceinline__ void operator()(const f32x4 (&acc)[2][2][4][2], const Unit& u, int wr, int wc, int fr, int fq) const {
        const int row0 = u.pm * BM + wr * 64 + fr; const int col0 = u.pn * BM + wc * 32 + 8 * fq;
#pragma unroll
        for (int bj = 0; bj < 2; ++bj) {
            f32x4 bv0 = (f32x4){0.f, 0.f, 0.f, 0.f}, bv1 = bv0;
            if (bias) { bv0 = *(const f32x4*)(bias + (size_t)u.e * bstride + col0 + bj * HALF); bv1 = *(const f32x4*)(bias + (size_t)u.e * bstride + col0 + bj * HALF + 4); }
#pragma unroll
            for (int ai = 0; ai < 2; ++ai)
#pragma unroll
                for (int m = 0; m < 4; ++m) { bf16* rowp = O + (size_t)(row0 + ai * HALF + m * 16) * ldc + col0;
                    const f32x4 v0 = acc[ai][bj][m][0] + bv0, v1 = acc[ai][bj][m][1] + bv1;
                    u32x4 w; w.x = pk2(v0[0], v0[1]); w.y = pk2(v0[2], v0[3]); w.z = pk2(v1[0], v1[1]); w.w = pk2(v1[2], v1[3]);
                    *(u32x4*)(rowp + bj * HALF) = w; } }
    }
};
struct EpiFp8 {
    unsigned char* O; int ldc; const float* bias; int bstride; float scale;
    __device__ __forceinline__ void operator()(const f32x4 (&acc)[2][2][4][2], const Unit& u, int wr, int wc, int fr, int fq) const {
        const int row0 = u.pm * BM + wr * 64 + fr; const int col0 = u.pn * BM + wc * 32 + 8 * fq;
#pragma unroll
        for (int bj = 0; bj < 2; ++bj) {
            const f32x4 bv0 = *(const f32x4*)(bias + (size_t)u.e * bstride + col0 + bj * HALF), bv1 = *(const f32x4*)(bias + (size_t)u.e * bstride + col0 + bj * HALF + 4);
#pragma unroll
            for (int ai = 0; ai < 2; ++ai)
#pragma unroll
                for (int m = 0; m < 4; ++m) { unsigned char* rowp = O + (size_t)(row0 + ai * HALF + m * 16) * ldc + col0;
                    const f32x4 v0 = (acc[ai][bj][m][0] + bv0) * scale, v1 = (acc[ai][bj][m][1] + bv1) * scale;
                    u32x2 w; w.x = pk4_fp8(v0[0], v0[1], v0[2], v0[3]); w.y = pk4_fp8(v1[0], v1[1], v1[2], v1[3]);
                    *(u32x2*)(rowp + bj * HALF) = w; } }
    }
};
struct EpiSwiglu {
    unsigned char* O; const float* bup;
    __device__ __forceinline__ void operator()(const f32x4 (&acc)[2][2][4][2], const Unit& u, int wr, int wc, int fr, int fq) const {
        const int row0 = u.pm * BM + wr * 64 + fr; const int c0 = u.pn * HALF + wc * 32 + 8 * fq;
        const float* bg = bup + (size_t)u.e * 2048 + c0; const float* bl = bg + 1024;
        const f32x4 g0 = *(const f32x4*)bg, g1 = *(const f32x4*)(bg + 4), l0 = *(const f32x4*)bl, l1 = *(const f32x4*)(bl + 4);
#pragma unroll
        for (int ai = 0; ai < 2; ++ai)
#pragma unroll
            for (int m = 0; m < 4; ++m) { unsigned char* rowp = O + (size_t)(row0 + ai * HALF + m * 16) * 1024 + c0;
                float a[8];
#pragma unroll
                for (int n = 0; n < 2; ++n) { const f32x4 gv = acc[ai][0][m][n] + (n ? g1 : g0), lv = acc[ai][1][m][n] + (n ? l1 : l0);
#pragma unroll
                    for (int j2 = 0; j2 < 2; ++j2) {
                        f32x2 gl = {fminf(gv[2 * j2], 7.0f), fminf(gv[2 * j2 + 1], 7.0f)};
                        f32x2 li = {__builtin_amdgcn_fmed3f(lv[2 * j2], -7.0f, 7.0f), __builtin_amdgcn_fmed3f(lv[2 * j2 + 1], -7.0f, 7.0f)};
                        const f32x2 ea = gl * (-1.702f * 1.4426950408889634f);
                        f32x2 d = {__builtin_amdgcn_exp2f(ea.x), __builtin_amdgcn_exp2f(ea.y)}; d = d + 1.0f;
                        const f32x2 r = {__builtin_amdgcn_rcpf(d.x), __builtin_amdgcn_rcpf(d.y)};
                        const f32x2 t = gl * r, o = __builtin_elementwise_fma(t, li, t);
                        a[n * 4 + 2 * j2] = o.x; a[n * 4 + 2 * j2 + 1] = o.y; } }
                u32x2 w; w.x = pk4_fp8(a[0], a[1], a[2], a[3]); w.y = pk4_fp8(a[4], a[5], a[6], a[7]);
                *(u32x2*)rowp = w; }
    }
};

template <bool FP8, class Epi, class Sched>
__device__ __forceinline__ void gemm_phase(LAS unsigned char* lds, const bf16* Abase, const bf16* Bbase, const int K, const Sched& S, const Epi& E) {
    const int tid = threadIdx.x, wid = __builtin_amdgcn_readfirstlane(tid >> 6), lane = tid & 63, wr = wid >> 2, wc = wid & 3, fr = lane & 15, fq = lane >> 4;
    const int nt = K / BK;
    unsigned voffB[2];
#pragma unroll
    for (int i = 0; i < 2; ++i) { int R, C; stage_rc(tid * 16 + i * 8192, R, C); const int Rb = (R & ~31) + perm32(R & 31); voffB[i] = (unsigned)(Rb * K + C) * 2u; }
    const size_t kstep = (size_t)(BK * 2);
    const size_t hstepB = (size_t)HALF * K * 2;
    const unsigned rowB = (unsigned)K * 2u;
    const unsigned ldsb = (unsigned)__builtin_amdgcn_readfirstlane((int)((unsigned)(unsigned long long)lds + (unsigned)wid * 1024u));
    const int aoff = lds_byte(wr * 64 + fr, fq * 8), boff = lds_byte(wc * 32 + fr, fq * 8);
#define PG8_SA(b, h) (((b) * 2 + (h)) * HTB)
#define PG8_SB(b, h) ((4 + (b) * 2 + (h)) * HTB)
#define PG8_STAGE(bufoff, gbase, voff) do { _Pragma("unroll") for (int _i = 0; _i < 2; ++_i) glds16_s(gbase, (voff)[_i], ldsb + (unsigned)((bufoff) + _i * 8192)); } while (0)
#define PG8_LD16(off) (*(const LAS v4i32*)(lds + (off)))
#define PG8_LDA(dst, b, h) do { if constexpr (FP8) { _Pragma("unroll") for (int m = 0; m < 4; ++m) dst##8[m] = __builtin_shufflevector(PG8_LD16(PG8_SA(b, h) + aoff + m * 2048), PG8_LD16(PG8_SA(b, h) + aoff + m * 2048 + 1024), 0, 1, 2, 3, 4, 5, 6, 7); } \
        else { _Pragma("unroll") for (int m = 0; m < 4; ++m) _Pragma("unroll") for (int k = 0; k < 2; ++k) dst##4[m][k] = *(const LAS bf16x8*)(lds + PG8_SA(b, h) + aoff + m * 2048 + k * 1024); } } while (0)
#define PG8_LDB(dst, b, h) do { if constexpr (FP8) { _Pragma("unroll") for (int n = 0; n < 2; ++n) dst##8[n] = __builtin_shufflevector(PG8_LD16(PG8_SB(b, h) + boff + n * 2048), PG8_LD16(PG8_SB(b, h) + boff + n * 2048 + 1024), 0, 1, 2, 3, 4, 5, 6, 7); } \
        else { _Pragma("unroll") for (int n = 0; n < 2; ++n) _Pragma("unroll") for (int k = 0; k < 2; ++k) dst##4[n][k] = *(const LAS bf16x8*)(lds + PG8_SB(b, h) + boff + n * 2048 + k * 1024); } } while (0)
#define PG8_MMA(ai, bj, At, Bt) do { __builtin_amdgcn_s_setprio(1); _Pragma("unroll") for (int m = 0; m < 4; ++m) _Pragma("unroll") for (int n = 0; n < 2; ++n) { \
        if constexpr (FP8) { asm volatile("v_mfma_scale_f32_16x16x128_f8f6f4 %0, %1, %2, %0, %3, %4 op_sel_hi:[0,0,0]" : "+v"(acc[ai][bj][m][n]) : "v"(Bt##8[n]), "v"(At##8[m]), "v"(scl), "v"(scl)); } \
        else { _Pragma("unroll") for (int k = 0; k < 2; ++k) acc[ai][bj][m][n] = __builtin_amdgcn_mfma_f32_16x16x32_bf16(Bt##4[n][k], At##4[m][k], acc[ai][bj][m][n], 0, 0, 0); } } \
        __builtin_amdgcn_s_setprio(0); } while (0)
#define PG8_WAIT_V(n) asm volatile("s_waitcnt vmcnt(" #n ")" ::: "memory")
#define PG8_WAIT_L(n) asm volatile("s_waitcnt lgkmcnt(" #n ")" ::: "memory")
#define PG8_BAR __builtin_amdgcn_s_barrier()
#define PG8_SCHED __builtin_amdgcn_sched_barrier(0)
#define PG8_MKVA(dst, u) do { _Pragma("unroll") for (int _i = 0; _i < 2; ++_i) { int R_, C_; stage_rc(tid * 16 + _i * 8192, R_, C_); _Pragma("unroll") for (int _h = 0; _h < 2; ++_h) dst[_h][_i] = S.arow(u, _h * HALF + R_) * rowB + (unsigned)C_ * 2u; } } while (0)
    Unit cur, nxt; int ui = 0;
    if (!S.next(0, cur)) return;
    f32x4 acc[2][2][4][2];
#pragma unroll
    for (int a = 0; a < 2; ++a)
#pragma unroll
        for (int b = 0; b < 2; ++b)
#pragma unroll
            for (int m = 0; m < 4; ++m)
#pragma unroll
                for (int n = 0; n < 2; ++n) acc[a][b][m][n] = (f32x4){0.f, 0.f, 0.f, 0.f};
    v8i32 At8[4], B08[2], B18[2]; bf16x8 At4[4][2], B04[2][2], B14[2][2];
    const unsigned scl = 0x7c7c7c7cu;
    unsigned vc[2][2];
    PG8_MKVA(vc, cur);
    const char* cA = uniform_ptr((const char*)Abase);
    const char* cB = uniform_ptr((const char*)Bbase + S.boff(cur));
    PG8_STAGE(PG8_SB(0, 0), cB, voffB); PG8_STAGE(PG8_SB(0, 1), cB + hstepB, voffB); PG8_STAGE(PG8_SA(0, 0), cA, vc[0]); PG8_STAGE(PG8_SA(0, 1), cA, vc[1]);
    if (wr == 1) PG8_BAR;
    PG8_WAIT_V(2); PG8_BAR;
    PG8_STAGE(PG8_SB(1, 0), cB + kstep, voffB); PG8_STAGE(PG8_SA(1, 0), cA + kstep, vc[0]); PG8_STAGE(PG8_SB(1, 1), cB + hstepB + kstep, voffB);
    PG8_WAIT_V(6); PG8_BAR;
    for (;;) {
        const bool has_next = S.next(ui + 1, nxt);
        const char* nB = uniform_ptr(has_next ? (const char*)Bbase + S.boff(nxt) : cB);
#pragma unroll 1
        for (int t = 0; t < nt; t += 2) {
            const bool last = (t == nt - 2);
            const char* a1 = cA + (size_t)(t + 1) * kstep;
            const char* a2 = last ? cA : cA + (size_t)(t + 2) * kstep; const char* b2 = last ? nB : cB + (size_t)(t + 2) * kstep;
            const char* a3 = a2 + kstep; const char* b3 = b2 + kstep;
            unsigned v2a[2], v2b[2];
#pragma unroll
            for (int i = 0; i < 2; ++i) { v2a[i] = vc[0][i]; v2b[i] = vc[1][i]; }
            if (last && has_next) {
#pragma unroll
                for (int i = 0; i < 2; ++i) { int R_, C_; stage_rc(tid * 16 + i * 8192, R_, C_); v2a[i] = S.arow(nxt, R_) * rowB + (unsigned)C_ * 2u; v2b[i] = S.arow(nxt, HALF + R_) * rowB + (unsigned)C_ * 2u; } }
            PG8_LDB(B0, 0, 0); PG8_LDB(B1, 0, 1); PG8_SCHED; PG8_LDA(At, 0, 0); PG8_STAGE(PG8_SA(1, 1), a1, vc[1]);
            PG8_WAIT_V(8); PG8_WAIT_L(0); PG8_BAR; PG8_MMA(0, 0, At, B0); PG8_MMA(0, 1, At, B1); PG8_BAR; PG8_SCHED;
            PG8_LDA(At, 0, 1); PG8_STAGE(PG8_SB(0, 0), b2, voffB); PG8_STAGE(PG8_SB(0, 1), b2 + hstepB, voffB); PG8_STAGE(PG8_SA(0, 0), a2, v2a);
            PG8_WAIT_V(8); PG8_WAIT_L(0); PG8_BAR; PG8_MMA(1, 0, At, B0); PG8_MMA(1, 1, At, B1); PG8_BAR; PG8_SCHED;
            PG8_LDB(B0, 1, 0); PG8_LDB(B1, 1, 1); PG8_SCHED; PG8_LDA(At, 1, 0); PG8_STAGE(PG8_SA(0, 1), a2, v2b);
            PG8_WAIT_V(8); PG8_WAIT_L(0); PG8_BAR; PG8_MMA(0, 0, At, B0); PG8_MMA(0, 1, At, B1); PG8_BAR; PG8_SCHED;
            PG8_LDA(At, 1, 1); PG8_STAGE(PG8_SB(1, 0), b3, voffB); PG8_STAGE(PG8_SB(1, 1), b3 + hstepB, voffB); PG8_STAGE(PG8_SA(1, 0), a3, v2a);
            PG8_WAIT_V(8); PG8_WAIT_L(0); PG8_BAR; PG8_MMA(1, 0, At, B0); PG8_MMA(1, 1, At, B1); PG8_BAR; PG8_SCHED;
        }
        if (wr == 0) PG8_BAR;
        if constexpr (FP8) asm volatile("s_nop 15\n\ts_nop 15" ::: "memory");
        E(acc, cur, wr, wc, fr, fq);
        if (!has_next) break;
#pragma unroll
        for (int a = 0; a < 2; ++a)
#pragma unroll
            for (int b = 0; b < 2; ++b)
#pragma unroll
                for (int m = 0; m < 4; ++m)
#pragma unroll
                    for (int n = 0; n < 2; ++n) acc[a][b][m][n] = (f32x4){0.f, 0.f, 0.f, 0.f};
        cur = nxt; cB = nB; ++ui;
        PG8_MKVA(vc, cur);
        if (wr == 1) PG8_BAR;
    }
    PG8_WAIT_V(0);
    PG8_BAR;
#undef PG8_SA
#undef PG8_SB
#undef PG8_STAGE
#undef PG8_LDA
#undef PG8_LD16
#undef PG8_LDB
#undef PG8_MMA
#undef PG8_WAIT_V
#undef PG8_WAIT_L
#undef PG8_BAR
#undef PG8_SCHED
#undef PG8_MKVA
}
}

#define XB_TMO      128
#define XB_XCNT(j)  (256  + 64 * (j))
#define XB_XSUB(j)  (1280 + 64 * (j))
#define XB_XGEN(j)  (2304 + 64 * (j))
#define XB_TOP      3328
#define XB_TOPGEN   3392
#define XCD_BAR_WORDS 3456
#define XB_SPIN_CAP (1u << 18)

__device__ __forceinline__ unsigned xb_ld(unsigned* p)              { return __hip_atomic_load(p, __ATOMIC_RELAXED, __HIP_MEMORY_SCOPE_AGENT); }
__device__ __forceinline__ unsigned xb_add(unsigned* p, unsigned v) { return __hip_atomic_fetch_add(p, v, __ATOMIC_RELAXED, __HIP_MEMORY_SCOPE_AGENT); }
__device__ __forceinline__ unsigned xb_xcc_id() { return (unsigned)__builtin_amdgcn_s_getreg((3 << 11) | 20) & 0xFu; }
#define XB_SPIN(cond, bar) do { unsigned _sp = 0; while (cond) { __builtin_amdgcn_s_sleep(1); \
    if ((++_sp & 255u) == 0u) { if (xb_ld(&(bar)[XB_TMO])) break; if (_sp > XB_SPIN_CAP) { atomicAdd(&(bar)[XB_TMO], 1u); break; } } } } while (0)

struct XcdBarrier {
    unsigned* bar; unsigned x;
    volatile LAS unsigned* st;
};
__device__ __forceinline__ XcdBarrier xcd_barrier_post(unsigned* bar, volatile LAS unsigned* st) {
    XcdBarrier b; b.bar = bar; b.x = xb_xcc_id(); b.st = st;
    if (threadIdx.x == 0) (void)xb_add(&bar[XB_XCNT(b.x)], 1u);
    return b;
}
__device__ __forceinline__ void xcd_barrier_complete(unsigned* bar, unsigned x, unsigned& nloc, unsigned& nx) {
    const unsigned G = gridDim.x * gridDim.y * gridDim.z;
    unsigned sum, cnt, mine, sp = 0u;
    for (;;) {
        sum = 0u; cnt = 0u; mine = 0u;
#pragma unroll
        for (unsigned j = 0; j < 16; ++j) { const unsigned c = xb_ld(&bar[XB_XCNT(j)]); sum += c; cnt += (c > 0u) ? 1u : 0u; mine = (j == x) ? c : mine; }
        if (sum == G) break;
        __builtin_amdgcn_s_sleep(1);
        if ((++sp & 255u) == 0u) { if (xb_ld(&bar[XB_TMO])) break; if (sp > XB_SPIN_CAP) { atomicAdd(&bar[XB_TMO], 1u); break; } }
    }
    nloc = mine > 0u ? mine : 1u; nx = cnt > 0u ? cnt : 1u;
}
__device__ __forceinline__ void xcd_barrier(const XcdBarrier& b) {
    asm volatile("s_waitcnt vmcnt(0)" ::: "memory");
    __syncthreads();
    if (threadIdx.x == 0) {
        unsigned* bar = b.bar;
        __builtin_amdgcn_s_waitcnt(0);
        unsigned nloc = b.st[0], nx = b.st[1];
        if (nloc == 0u) { xcd_barrier_complete(bar, b.x, nloc, nx); b.st[0] = nloc; b.st[1] = nx; }
        const unsigned old = xb_add(&bar[XB_XSUB(b.x)], 1u);
        const unsigned gen = old / nloc;
        if (old + 1u == (gen + 1u) * nloc) {
            __builtin_amdgcn_fence(__ATOMIC_RELEASE, "agent");
            asm volatile("s_waitcnt vmcnt(0)" ::: "memory");
            const unsigned og = xb_add(&bar[XB_TOP], 1u);
            const unsigned tg = og / nx;
            if (og + 1u == (tg + 1u) * nx) xb_add(&bar[XB_TOPGEN], 1u);
            else XB_SPIN(xb_ld(&bar[XB_TOPGEN]) == tg, bar);
            __builtin_amdgcn_fence(__ATOMIC_ACQUIRE, "agent");
            xb_add(&bar[XB_XGEN(b.x)], 1u);
            asm volatile("s_waitcnt vmcnt(0)" ::: "memory");
        } else {
            XB_SPIN(xb_ld(&bar[XB_XGEN(b.x)]) == gen, bar);
            __builtin_amdgcn_fence(__ATOMIC_ACQUIRE, "agent");
            asm volatile("s_waitcnt vmcnt(0)" ::: "memory");
        }
    }
    __syncthreads();
}

struct Frame {
    LAS unsigned char* lds;
    unsigned* ctl;
    unsigned char* ws;
    int tid, lane, wave, vcu, G;
    const float* const __attribute__((address_space(4)))* in;
    float* out;
};
#define LDS_WAIT() asm volatile("s_waitcnt lgkmcnt(0)" ::: "memory")
#define VM_WAIT() asm volatile("s_waitcnt vmcnt(0)" ::: "memory")

__device__ __forceinline__ int map_n(int mode, int n) {
    if (mode == 1) return n < 2048 ? n : (n < 2056 ? 3328 + (n - 2048) : (n < 3336 ? n - 8 : n));
    if (mode == 2) return n < 1024 ? ((n >> 7) * 256 + (n & 127)) : (((n - 1024) >> 7) * 256 + 128 + ((n - 1024) & 127));
    return n;
}
template <bool FP8>
__device__ __forceinline__ void p0_transpose_item(const float* W, int K, int N, void* WTv, int mode, LAS float* scr, int item, int lane) {
    const int nblk = N / 32, kb = item / nblk, nb = item % nblk, k0 = 64 * kb, n0 = 32 * nb;
    float tv_[32];
#pragma unroll
    for (int i = 0; i < 32; ++i) { const int kk = 2 * i + (lane >> 5); tv_[i] = W[(size_t)(k0 + kk) * N + n0 + (lane & 31)]; }
#pragma unroll
    for (int i = 0; i < 32; ++i) { const int kk = 2 * i + (lane >> 5); scr[kk * 33 + (lane & 31)] = tv_[i]; }
    LDS_WAIT(); asm volatile("" ::: "memory");
    const int c = lane & 7;
#pragma unroll
    for (int j = 0; j < 4; ++j) { const int n = (lane >> 3) + 8 * j; const LAS float* s = scr + (8 * c) * 33 + n;
        if constexpr (FP8) { u32x2 o; o.x = pk4_fp8(64.f * s[0 * 33], 64.f * s[1 * 33], 64.f * s[2 * 33], 64.f * s[3 * 33]); o.y = pk4_fp8(64.f * s[4 * 33], 64.f * s[5 * 33], 64.f * s[6 * 33], 64.f * s[7 * 33]);
            *(u32x2*)((unsigned char*)WTv + (size_t)map_n(mode, n0 + n) * K + k0 + 8 * c) = o; }
        else { u32x4 o; o.x = pk2(s[0 * 33], s[1 * 33]); o.y = pk2(s[2 * 33], s[3 * 33]); o.z = pk2(s[4 * 33], s[5 * 33]); o.w = pk2(s[6 * 33], s[7 * 33]);
            *(u32x4*)((bf16*)WTv + (size_t)map_n(mode, n0 + n) * K + k0 + 8 * c) = o; } }
    LDS_WAIT(); asm volatile("" ::: "memory");
}
__device__ __forceinline__ void p0_prologue(Frame& F) {
    LAS float* scr = (LAS float*)(F.lds + F.wave * 16384);
    const int gw = F.vcu * NWAVES + F.wave, NGW = F.G * NWAVES, lane = F.lane;
    constexpr int I_ADA = 192, I_CMP = 128, I_WRT = 32, I_PAD = 224, I_WIN = 16 * 105, I_WOUT = 16 * 32, I_WUP = 32 * 16 * 64, I_WDN = 32 * 16 * 32;
    unsigned char* ws = F.ws;
    for (int r = F.vcu; r < I_ADA; r += F.G) {
        const int ks = r / 24, jb = r % 24, j0 = jb * 256 + 4 * lane;
        const float* wa = F.in[2]; const float* c = F.in[1];
        f32x4 acc[4], w4[16];
#pragma unroll
        for (int b = 0; b < 4; ++b) acc[b] = (f32x4){0.f, 0.f, 0.f, 0.f};
#pragma unroll
        for (int kk = 0; kk < 16; ++kk) w4[kk] = __builtin_nontemporal_load((const f32x4*)(wa + (size_t)(ks * 128 + F.wave * 16 + kk) * 6144 + j0));
#pragma unroll
        for (int kk = 0; kk < 16; ++kk) {
#pragma unroll
            for (int b = 0; b < 4; ++b) { const float sv = siluf_(c[b * 1024 + ks * 128 + F.wave * 16 + kk]); acc[b] += w4[kk] * sv; } }
        LAS f32x4* red = (LAS f32x4*)F.lds;
#pragma unroll
        for (int b = 0; b < 4; ++b) red[(F.wave * 4 + b) * 64 + lane] = acc[b];
        __syncthreads();
        if (F.tid < 256) { const int b = F.tid >> 6, ln = F.tid & 63; f32x4 sum = red[b * 64 + ln];
#pragma unroll
            for (int w = 1; w < 8; ++w) sum += red[(w * 4 + b) * 64 + ln];
            *(f32x4*)((float*)(ws + WS_MODP) + (size_t)(ks * 4 + b) * 6144 + jb * 256 + 4 * ln) = sum; }
        __syncthreads();
    }
    for (int it = gw; it < I_CMP + I_WRT + I_PAD; it += NGW) {
        int r = it;
        if (r < I_CMP) {
            const int kv = r >> 6, e = r & 63; const float* w = kv ? F.in[12] : F.in[11]; const float* pos = kv ? F.in[14] : F.in[13];
            bf16* wt = (bf16*)(ws + WS_WCMP) + (size_t)(kv * 64 + e) * 2048; float s = 0.f;
            float wv[32], pv_[32];
#pragma unroll
            for (int i = 0; i < 32; ++i) { wv[i] = w[(size_t)(lane + 64 * i) * 64 + e]; pv_[i] = pos[lane + 64 * i]; }
#pragma unroll
            for (int i = 0; i < 32; ++i) { wt[lane + 64 * i] = (bf16)f2bf(wv[i]); s += pv_[i] * wv[i]; }
            s = wave_sum(s); if (lane == 0) ((float*)(ws + WS_CMPB))[kv * 64 + e] = s;
            continue; }
        r -= I_CMP;
        if (r < I_WRT) { const float* wr_ = F.in[17]; float* wt = (float*)(ws + WS_WRT) + (size_t)r * 1024;
            float wv[16];
#pragma unroll
            for (int i = 0; i < 16; ++i) wv[i] = wr_[(size_t)(lane + 64 * i) * 32 + r];
#pragma unroll
            for (int i = 0; i < 16; ++i) wt[lane + 64 * i] = wv[i];
            continue; }
        r -= I_WRT;
        { u32x4* p = (u32x4*)((bf16*)(ws + WS_WIN) + (size_t)(D_IN + r) * 1024); p[lane] = (u32x4){0u, 0u, 0u, 0u}; p[lane + 64] = (u32x4){0u, 0u, 0u, 0u}; }
    }
    constexpr int NT_ITEMS = I_WIN + I_WOUT;
    struct TItem { const float* src; unsigned char* dst; int N, mode, fp8, k0, n0; };
#define P0_DECODE(d, rr) do { int r_ = (rr); int item_; \
        if (r_ < I_WIN) { d.src = F.in[8]; d.dst = ws + WS_WIN; d.N = D_IN; d.mode = 1; d.fp8 = 0; item_ = r_; } \
        else { r_ -= I_WIN; d.src = F.in[16]; d.dst = ws + WS_WOUT; d.N = 1024; d.mode = 0; d.fp8 = 0; item_ = r_; } \
        const int nblk_ = d.N / 32; d.k0 = 64 * (item_ / nblk_); d.n0 = 32 * (item_ % nblk_); } while (0)
#define P0_LOAD(d, tv) do { _Pragma("unroll") for (int i = 0; i < 32; ++i) tv[i] = d.src[(size_t)(d.k0 + 2 * i + (lane >> 5)) * d.N + d.n0 + (lane & 31)]; } while (0)
    int itx = gw;
    if (itx < NT_ITEMS) {
        TItem d0, d1; float ta[32], tb[32];
        P0_DECODE(d0, itx); P0_LOAD(d0, ta);
        for (;;) {
            const int nx = itx + NGW; const bool has = nx < NT_ITEMS;
            if (has) { P0_DECODE(d1, nx); P0_LOAD(d1, tb); }
#pragma unroll
            for (int i = 0; i < 32; ++i) scr[(2 * i + (lane >> 5)) * 33 + (lane & 31)] = ta[i];
            LDS_WAIT(); asm volatile("" ::: "memory");
            const int c = lane & 7;
#pragma unroll
            for (int j = 0; j < 4; ++j) { const int n = (lane >> 3) + 8 * j; const LAS float* sp = scr + (8 * c) * 33 + n; const size_t orow = (size_t)map_n(d0.mode, d0.n0 + n) * 1024 + d0.k0 + 8 * c;
                if (d0.fp8) { u32x2 o; o.x = pk4_fp8(64.f * sp[0 * 33], 64.f * sp[1 * 33], 64.f * sp[2 * 33], 64.f * sp[3 * 33]); o.y = pk4_fp8(64.f * sp[4 * 33], 64.f * sp[5 * 33], 64.f * sp[6 * 33], 64.f * sp[7 * 33]);
                    *(u32x2*)(d0.dst + orow) = o; }
                else { u32x4 o; o.x = pk2(sp[0 * 33], sp[1 * 33]); o.y = pk2(sp[2 * 33], sp[3 * 33]); o.z = pk2(sp[4 * 33], sp[5 * 33]); o.w = pk2(sp[6 * 33], sp[7 * 33]);
                    *(u32x4*)(d0.dst + orow * 2) = o; } }
            LDS_WAIT(); asm volatile("" ::: "memory");
            if (!has) break;
            itx = nx; d0 = d1;
#pragma unroll
            for (int i = 0; i < 32; ++i) ta[i] = tb[i];
        }
    }
#undef P0_DECODE
#undef P0_LOAD
    {
        constexpr int NH = 2 * (32 * 8 * 32 + 32 * 8 * 16);
        LAS unsigned char* scr8 = (LAS unsigned char*)scr;
        struct HItem { const float* src; unsigned char* dst; int N, mode, k0, n0, half; };
#define P8_DECODE(d, hh) do { int it_ = (hh) >> 1; d.half = (hh) & 1; \
            if (it_ < 32 * 256) { const int e_ = it_ >> 8, q_ = it_ & 255; d.src = F.in[19] + (size_t)e_ * 1024 * 2048; d.dst = ws + WS_WUP + (size_t)e_ * 2048 * 1024; d.N = 2048; d.mode = 2; d.k0 = 128 * (q_ >> 5); d.n0 = 64 * (q_ & 31); } \
            else { it_ -= 32 * 256; const int e_ = it_ >> 7, q_ = it_ & 127; d.src = F.in[21] + (size_t)e_ * 1024 * 1024; d.dst = ws + WS_WDN + (size_t)e_ * 1024 * 1024; d.N = 1024; d.mode = 0; d.k0 = 128 * (q_ >> 4); d.n0 = 64 * (q_ & 15); } } while (0)
#define P8_LOAD(d, tv) do { _Pragma("unroll") for (int i = 0; i < 16; ++i) tv[i] = __builtin_nontemporal_load((const f32x4*)(d.src + (size_t)(d.k0 + 64 * d.half + 16 * (i >> 2) + 4 * (lane >> 4) + (i & 3)) * d.N + d.n0 + 4 * (lane & 15))); } while (0)
        int item = gw;
        if (item < NH / 2) {
            HItem d0, d1; f32x4 ta[16], tb[16];
            int hcur = 2 * item; P8_DECODE(d0, hcur); P8_LOAD(d0, ta);
            for (;;) {
                const bool has = (hcur & 1) == 0 || (item + NGW) < NH / 2;
                const int hn = (hcur & 1) == 0 ? hcur + 1 : 2 * (item + NGW);
                if (has) { P8_DECODE(d1, hn); P8_LOAD(d1, tb); }
#pragma unroll
                for (int g = 0; g < 4; ++g) {
                    const unsigned r0 = pk4_fp8(64.f * ta[4 * g][0], 64.f * ta[4 * g][1], 64.f * ta[4 * g][2], 64.f * ta[4 * g][3]);
                    const unsigned r1 = pk4_fp8(64.f * ta[4 * g + 1][0], 64.f * ta[4 * g + 1][1], 64.f * ta[4 * g + 1][2], 64.f * ta[4 * g + 1][3]);
                    const unsigned r2 = pk4_fp8(64.f * ta[4 * g + 2][0], 64.f * ta[4 * g + 2][1], 64.f * ta[4 * g + 2][2], 64.f * ta[4 * g + 2][3]);
                    const unsigned r3 = pk4_fp8(64.f * ta[4 * g + 3][0], 64.f * ta[4 * g + 3][1], 64.f * ta[4 * g + 3][2], 64.f * ta[4 * g + 3][3]);
                    const unsigned t01l = __builtin_amdgcn_perm(r1, r0, 0x05010400u), t01h = __builtin_amdgcn_perm(r1, r0, 0x07030602u), t23l = __builtin_amdgcn_perm(r3, r2, 0x05010400u), t23h = __builtin_amdgcn_perm(r3, r2, 0x07030602u);
                    const unsigned o0 = __builtin_amdgcn_perm(t23l, t01l, 0x05040100u), o1 = __builtin_amdgcn_perm(t23l, t01l, 0x07060302u), o2 = __builtin_amdgcn_perm(t23h, t01h, 0x05040100u), o3 = __builtin_amdgcn_perm(t23h, t01h, 0x07060302u);
                    LAS unsigned char* wp = scr8 + (4 * (lane & 15)) * 132 + 64 * d0.half + 16 * g + 4 * (lane >> 4);
                    *(LAS unsigned*)(wp) = o0; *(LAS unsigned*)(wp + 132) = o1; *(LAS unsigned*)(wp + 264) = o2; *(LAS unsigned*)(wp + 396) = o3; }
                if (d0.half == 1) {
                    LDS_WAIT(); asm volatile("" ::: "memory");
#pragma unroll
                    for (int i = 0; i < 8; ++i) { const int n = (lane >> 3) + 8 * i, ch = lane & 7; const LAS unsigned* rp = (const LAS unsigned*)(scr8 + n * 132 + ch * 16);
                        u32x4 o; o.x = rp[0]; o.y = rp[1]; o.z = rp[2]; o.w = rp[3];
                        __builtin_nontemporal_store(o, (u32x4*)(d0.dst + (size_t)map_n(d0.mode, d0.n0 + n) * 1024 + d0.k0 + ch * 16)); }
                    LDS_WAIT(); asm volatile("" ::: "memory");
                }
                if (!has) break;
                if (hcur & 1) item += NGW;
                hcur = hn; d0 = d1;
#pragma unroll
                for (int i = 0; i < 16; ++i) ta[i] = tb[i];
            }
        }
#undef P8_DECODE
#undef P8_LOAD
    }
}

__device__ __forceinline__ float mod_val(const Frame& F, int b, int j) {
    const float* mp = (const float*)(F.ws + WS_MODP); float s = F.in[3][j];
#pragma unroll
    for (int ks = 0; ks < 8; ++ks) s += mp[(size_t)(ks * 4 + b) * 6144 + j];
    return s;
}
__device__ __forceinline__ void p1_rows(Frame& F) {
    LAS float* A1 = (LAS float*)F.lds; LAS float* B1 = A1 + 1024;
    bf16* H = (bf16*)(F.ws + WS_H);
    for (int rb = F.vcu; rb < M / 64; rb += F.G) {
        const int b = (rb * 64) / SEQ;
        f32x4 v[8][4];
#pragma unroll
        for (int i = 0; i < 8; ++i) { const f32x4* xr = (const f32x4*)(F.in[0] + (size_t)(rb * 64 + F.wave * 8 + i) * 1024) + F.lane;
#pragma unroll
            for (int j = 0; j < 4; ++j) v[i][j] = __builtin_nontemporal_load(xr + 64 * j); }
        for (int col = F.tid; col < 1024; col += NTHR) { A1[col] = F.in[4][col] * (1.0f + mod_val(F, b, 1024 + col)); B1[col] = mod_val(F, b, col); }
        if (rb < 96 && F.tid < 256) { const int idx = rb * 256 + F.tid; ((float*)(F.ws + WS_MODF))[idx] = mod_val(F, idx / 6144, idx % 6144); }
        __syncthreads();
#pragma unroll
        for (int i = 0; i < 8; ++i) {
            const int row = rb * 64 + F.wave * 8 + i;
            float ss = 0.f;
#pragma unroll
            for (int j = 0; j < 4; ++j) ss += (v[i][j].x * v[i][j].x + v[i][j].y * v[i][j].y) + (v[i][j].z * v[i][j].z + v[i][j].w * v[i][j].w);
            const float rs = rsqrtf(wave_sum(ss) * (1.0f / 1024.0f) + EPS);
            u32x2* o8 = (u32x2*)(H + (size_t)row * 1024) + F.lane;
#pragma unroll
            for (int j = 0; j < 4; ++j) { const int c0 = 4 * F.lane + 256 * j;
                const f32x4 a = *(const LAS f32x4*)(A1 + c0), bb = *(const LAS f32x4*)(B1 + c0);
                const f32x4 y = v[i][j] * rs * a + bb; u32x2 w; w.x = pk2(y.x, y.y); w.y = pk2(y.z, y.w); o8[64 * j] = w; }
        }
        __syncthreads();
    }
}

__device__ __forceinline__ void p3_compress_item(Frame& F, int wi) {
    const int lane = F.lane, r32 = lane & 31, hi = lane >> 5;
    const int nt = wi & 1, kv = (wi >> 1) & 1, it = (wi >> 2) & 7, g = (wi >> 5) & 1, b = wi >> 6;
    const bf16* Z = (const bf16*)(F.ws + WS_Z);
    const int i = it * 32 + r32; const bool ok = i < 255; const int ic = ok ? i : 0;
    const bf16* zrow0 = Z + (size_t)(b * SEQ + 16 * ic) * ZP + (kv ? ZC_VC : ZC_KC) + g * 64 + hi * 8;
    const bf16* wrow = (const bf16*)(F.ws + WS_WCMP) + (size_t)(kv * 64 + nt * 32 + r32) * 2048 + hi * 8;
    f32x16 acc = {};
    bf16x8 av[16], bv[16];
#pragma unroll
    for (int k = 0; k < 16; ++k) { const int ks = F.wave * 16 + k, l = ks >> 2, dq = ks & 3; av[k] = *(const bf16x8*)(zrow0 + (size_t)l * ZP + dq * 16); bv[k] = *(const bf16x8*)(wrow + ks * 16); }
#pragma unroll
    for (int k = 0; k < 16; ++k) { bf16x8 a = av[k]; if (!ok) a = (bf16x8){0, 0, 0, 0, 0, 0, 0, 0}; acc = __builtin_amdgcn_mfma_f32_32x32x16_bf16(a, bv[k], acc, 0, 0, 0); }
    LAS float* part = (LAS float*)F.lds;
#pragma unroll
    for (int r = 0; r < 16; ++r) part[(F.wave * 16 + r) * 64 + lane] = acc[r];
    __syncthreads();
    bf16* dst = (bf16*)(F.ws + (kv ? WS_VC : WS_KC)) + (size_t)((b * 2 + g) * 256) * 64;
#pragma unroll
    for (int k = 0; k < 2; ++k) { const int o = F.tid + NTHR * k, r = o >> 6, ln = o & 63; float v = 0.f;
#pragma unroll
        for (int w = 0; w < 8; ++w) v += part[(w * 16 + r) * 64 + ln];
        const int irow = it * 32 + crow(r, ln >> 5), e = nt * 32 + (ln & 31);
        dst[(size_t)irow * 64 + e] = (bf16)f2bf(irow < 255 ? v + ((const float*)(F.ws + WS_CMPB))[kv * 64 + e] : 0.f); }
    __syncthreads();
}
__device__ __forceinline__ void chunk_gates(const Frame& F, int b, int h, int c, float& ig, float& g) {
    const bf16* Z = (const bf16*)(F.ws + WS_Z); const size_t row = (size_t)(b * SEQ + c * 64 + F.lane) * ZP;
    ig = bf2f(Z[row + ZC_IG + h]) + F.in[9][h];
    const float fp = bf2f(Z[row + ZC_FG + h]) + F.in[9][4 + h];
    float v = logsigmoidf_(fp);
#pragma unroll
    for (int o = 1; o < 64; o <<= 1) { const float t = __shfl_up(v, o); if (F.lane >= o) v += t; }
    g = v;
}
__device__ __forceinline__ void conv8(const Frame& F, int b, int t, int zc, int cc, float (&o)[8]) {
    const bf16* Z = (const bf16*)(F.ws + WS_Z); const float* cw = F.in[10];
#pragma unroll
    for (int j = 0; j < 8; ++j) o[j] = 0.f;
#pragma unroll
    for (int jj = 0; jj < 4; ++jj) { const int tt = t - 3 + jj;
        if (tt >= 0) { const bf16x8 v = *(const bf16x8*)(Z + (size_t)(b * SEQ + tt) * ZP + zc);
            const f32x4 w0 = *(const f32x4*)(cw + jj * 1024 + cc), w1 = *(const f32x4*)(cw + jj * 1024 + cc + 4);
#pragma unroll
            for (int j = 0; j < 4; ++j) { o[j] += w0[j] * bf2f((unsigned short)v[j]); o[4 + j] += w1[j] * bf2f((unsigned short)v[4 + j]); } } }
#pragma unroll
    for (int j = 0; j < 8; ++j) o[j] = siluf_(o[j]);
}
struct ConvRaw { bf16x8 v[4]; };
__device__ __forceinline__ void conv8_load(const Frame& F, int b, int t, int zc, ConvRaw& r) {
    const bf16* Z = (const bf16*)(F.ws + WS_Z);
#pragma unroll
    for (int jj = 0; jj < 4; ++jj) { const int tt = t - 3 + jj; r.v[jj] = (bf16x8){0, 0, 0, 0, 0, 0, 0, 0}; if (tt >= 0) r.v[jj] = *(const bf16x8*)(Z + (size_t)(b * SEQ + tt) * ZP + zc); }
}
__device__ __forceinline__ void conv8_calc(const Frame& F, const ConvRaw& r, int cc, float (&o)[8]) {
    const float* cw = F.in[10];
#pragma unroll
    for (int j = 0; j < 8; ++j) o[j] = 0.f;
#pragma unroll
    for (int jj = 0; jj < 4; ++jj) { const f32x4 w0 = *(const f32x4*)(cw + jj * 1024 + cc), w1 = *(const f32x4*)(cw + jj * 1024 + cc + 4);
#pragma unroll
        for (int j = 0; j < 4; ++j) { o[j] += w0[j] * bf2f((unsigned short)r.v[jj][j]); o[4 + j] += w1[j] * bf2f((unsigned short)r.v[jj][4 + j]); } }
#pragma unroll
    for (int j = 0; j < 8; ++j) o[j] = siluf_(o[j]);
}
constexpr int KT_STRIDE = 72, QS_STRIDE = 136;
__device__ __forceinline__ void conv8_calc_lds(const LAS float* cwl, int nch, const ConvRaw& r, int lc, float (&o)[8]) {
#pragma unroll
    for (int j = 0; j < 8; ++j) o[j] = 0.f;
#pragma unroll
    for (int jj = 0; jj < 4; ++jj) { const f32x4 w0 = *(const LAS f32x4*)(cwl + jj * nch + lc), w1 = *(const LAS f32x4*)(cwl + jj * nch + lc + 4);
#pragma unroll
        for (int j = 0; j < 4; ++j) { o[j] += w0[j] * bf2f((unsigned short)r.v[jj][j]); o[4 + j] += w1[j] * bf2f((unsigned short)r.v[jj][4 + j]); } }
#pragma unroll
    for (int j = 0; j < 8; ++j) o[j] = siluf_(o[j]);
}
__device__ __forceinline__ void p3_mlstm_a_items(Frame& F) {
    const int tid = F.tid, lane = F.lane, r32 = lane & 31, hi = lane >> 5;
    LAS bf16* kT = (LAS bf16*)F.lds; LAS bf16* vwT = kT + 128 * KT_STRIDE; LAS float* wexA = (LAS float*)(F.lds + 2 * 128 * KT_STRIDE * 2);
    LAS float* cwl = wexA + 256;
    const bf16* Z = (const bf16*)(F.ws + WS_Z);
    float* SCG = (float*)(F.ws + WS_SC); float* SCM = SCG + 1024;
    int cur_h = -1;
    for (int base = F.vcu; base < 1024; base += 4 * F.G) {
        __syncthreads();
        if (F.wave < 4) { const int item = base + F.wave * F.G;
            if (item < 1024) { const int b = item >> 8, h = (item >> 6) & 3, c = item & 63;
                float ig, g; chunk_gates(F, b, h, c, ig, g);
                const float G = __shfl(g, 63), wl = G - g + ig, ml = wave_max(wl);
                wexA[F.wave * 64 + lane] = __expf(wl - ml);
                if (lane == 0) { SCG[item] = G; SCM[item] = ml; } } }
        for (int kb = 0; kb < 4; ++kb) {
            const int item = base + kb * F.G; if (item >= 1024) break;
            const int b = item >> 8, h = (item >> 6) & 3, c = item & 63;
            ConvRaw rk[2]; bf16x8 rvv[2];
#pragma unroll
            for (int rep = 0; rep < 2; ++rep) { const int task = tid + NTHR * rep, l = task >> 4, ch = task & 15, t = c * 64 + l;
                conv8_load(F, b, t, ZC_KM + h * 128 + ch * 8, rk[rep]); rvv[rep] = *(const bf16x8*)(Z + (size_t)(b * SEQ + t) * ZP + ZC_VM + h * 128 + ch * 8); }
            if (h != cur_h) { __syncthreads(); cwl[tid] = F.in[10][(tid >> 7) * 1024 + 512 + h * 128 + (tid & 127)]; cur_h = h; }
            __syncthreads();
            const LAS float* wex = wexA + kb * 64;
#pragma unroll
            for (int rep = 0; rep < 2; ++rep) { const int task = tid + NTHR * rep, l = task >> 4, ch = task & 15;
                float kk[8]; conv8_calc_lds(cwl, 128, rk[rep], ch * 8, kk);
                const bf16x8 vv = rvv[rep]; const float we = wex[l];
#pragma unroll
                for (int j = 0; j < 8; ++j) { kT[(ch * 8 + j) * KT_STRIDE + l] = (bf16)f2bf(kk[j] * 0.08838834764831845f); vwT[(ch * 8 + j) * KT_STRIDE + l] = (bf16)f2bf(bf2f((unsigned short)vv[j]) * we); } }
            __syncthreads();
            {
                const int et = F.wave >> 1; bf16* DC = (bf16*)(F.ws + WS_DC) + (size_t)item * 16384;
#pragma unroll
                for (int dt2 = 0; dt2 < 2; ++dt2) { const int dt = 2 * (F.wave & 1) + dt2; f32x16 acc = {};
#pragma unroll
                    for (int ks = 0; ks < 4; ++ks) { const bf16x8 a = *(const LAS bf16x8*)(vwT + (et * 32 + r32) * KT_STRIDE + ks * 16 + hi * 8), bq = *(const LAS bf16x8*)(kT + (dt * 32 + r32) * KT_STRIDE + ks * 16 + hi * 8);
                        acc = __builtin_amdgcn_mfma_f32_32x32x16_bf16(a, bq, acc, 0, 0, 0); }
#pragma unroll
                    for (int r = 0; r < 16; ++r) DC[(size_t)(et * 32 + crow(r, hi)) * 128 + dt * 32 + r32] = (bf16)f2bf(acc[r]); }
                { const int d = tid >> 2, part = tid & 3; float s = 0.f;
#pragma unroll
                    for (int l = 0; l < 16; ++l) s += wex[part * 16 + l] * bf2f(kT[d * KT_STRIDE + part * 16 + l]);
                    s += __shfl_xor(s, 1); s += __shfl_xor(s, 2);
                    if (part == 0) ((float*)(F.ws + WS_DN))[(size_t)item * 128 + d] = s; }
            }
        }
    }
    __syncthreads();
}

__device__ __forceinline__ void p4_scan(Frame& F) {
    const float* SCG = (const float*)(F.ws + WS_SC); const float* SCM = SCG + 1024; float* MP = (float*)(F.ws + WS_SC) + 2048;
    for (int it = F.vcu; it < 256; it += F.G) {
        const int bh = it >> 4, idx = (it & 15) * 512 + F.tid; const bool wmp = ((it & 15) == 0) && F.tid == 0;
        const unsigned* __restrict__ src = (const unsigned*)(F.ws + WS_DC) + idx; unsigned* __restrict__ dst = (unsigned*)(F.ws + WS_CP) + idx;
        float m = -INFINITY, s0 = 0.f, s1 = 0.f;
        for (int cb = 0; cb < 4; ++cb) {
            unsigned v[16];
#pragma unroll
            for (int i = 0; i < 16; ++i) v[i] = __builtin_nontemporal_load(src + (size_t)(bh * 64 + cb * 16 + i) * 8192);
#pragma unroll
            for (int i = 0; i < 16; ++i) { const int ci = bh * 64 + cb * 16 + i; const float G = SCG[ci], ml = SCM[ci];
                const float mn = fmaxf(G + m, ml), a = __expf(G + m - mn), bc = __expf(ml - mn);
                dst[(size_t)ci * 8192] = pk2(s0, s1); if (wmp) MP[ci] = m;
                s0 = a * s0 + bc * bf2f(v[i] & 0xffffu); s1 = a * s1 + bc * bf2f(v[i] >> 16); m = mn; }
        }
        if (F.tid < 8) { const int flat = it * 8 + F.tid, bhn = flat >> 7, d = flat & 127;
            const float* __restrict__ sn = (const float*)(F.ws + WS_DN) + d; float* __restrict__ dn = (float*)(F.ws + WS_NP) + d;
            float mN = -INFINITY, st = 0.f;
            for (int cb = 0; cb < 4; ++cb) { float v[16];
#pragma unroll
                for (int i = 0; i < 16; ++i) v[i] = sn[(size_t)(bhn * 64 + cb * 16 + i) * 128];
#pragma unroll
                for (int i = 0; i < 16; ++i) { const int ci = bhn * 64 + cb * 16 + i; const float G = SCG[ci], ml = SCM[ci];
                    const float mn = fmaxf(G + mN, ml), a = __expf(G + mN - mn), bc = __expf(ml - mn);
                    dn[(size_t)ci * 128] = st; st = a * st + bc * v[i]; mN = mn; } } }
    }
}

namespace nsa {
constexpr int KOFF = 0, VOFF = 32768, TBOFF = 65536, WSFOFF = 71680, MSKOFF = 73728, UNIOFF = 74240, JLOFF = 74304, OACCOFF = 74752, QOFF0 = 123904;
constexpr float LOG2E = 1.4426950408889634f, C2 = 0.125f * LOG2E;
typedef short v4i16_t __attribute__((ext_vector_type(4)));
#define NSA_WAITV(n) asm volatile("s_waitcnt vmcnt(" #n ")" ::: "memory")
#define NSA_BAR() do { asm volatile("s_waitcnt lgkmcnt(0)" ::: "memory"); __builtin_amdgcn_s_barrier(); asm volatile("" ::: "memory"); } while (0)

__device__ __forceinline__ void dma_k(LAS unsigned char* L, int buf, int wid, int lane, const bf16* Kt, size_t P) {
    __builtin_amdgcn_global_load_lds((const unsigned*)(Kt + (size_t)lane * P + wid * 8), (LAS unsigned*)(L + KOFF + buf * 8192 + wid * 1024), 16, 0, 0);
}
__device__ __forceinline__ void dma_v(LAS unsigned char* L, int buf, int wid, int lane, const bf16* Vt, size_t P) {
    __builtin_amdgcn_global_load_lds((const unsigned*)(Vt + (size_t)(16 * (wid & 3) + (lane >> 2)) * P + (wid >> 2) * 32 + (lane & 3) * 8), (LAS unsigned*)(L + VOFF + buf * 8192 + wid * 1024), 16, 0, 0);
}
__device__ __forceinline__ void qkt(f32x16& p0, f32x16& p1, const LAS unsigned char* L, int buf, const LAS bf16x8* qr, int r32, int hi) {
    const LAS unsigned char* kb = L + KOFF + buf * 8192 + hi * 1024 + r32 * 16;
    p0 = (f32x16){}; p1 = (f32x16){};
#pragma unroll
    for (int d0 = 0; d0 < 4; ++d0) {
        const bf16x8 b0 = *(const LAS bf16x8*)(kb + d0 * 2048), b1 = *(const LAS bf16x8*)(kb + d0 * 2048 + 512), q = qr[d0 * 64];
        p0 = __builtin_amdgcn_mfma_f32_32x32x16_bf16(b0, q, p0, 0, 0, 0);
        p1 = __builtin_amdgcn_mfma_f32_32x32x16_bf16(b1, q, p1, 0, 0, 0); }
}
__device__ __forceinline__ s16x4 vtr(const LAS unsigned char* p) { return __builtin_bit_cast(s16x4, __builtin_amdgcn_ds_read_tr16_b64_v4i16((LAS v4i16_t*)p)); }
__device__ __forceinline__ void pv(f32x16 (&o)[2], const LAS unsigned char* L, int buf, const u32x4 (&pw)[4], int lane, int hi) {
    const LAS unsigned char* vp = L + VOFF + buf * 8192 + ((lane >> 4) & 1) * 32 + (lane & 3) * 8 + (4 * hi + ((lane & 15) >> 2)) * 64;
#pragma unroll
    for (int dh = 0; dh < 2; ++dh)
#pragma unroll
        for (int ks = 0; ks < 4; ++ks) {
            const s16x4 lo = vtr(vp + dh * 4096 + ks * 1024), hh = vtr(vp + dh * 4096 + ks * 1024 + 512);
            const bf16x8 vf = (bf16x8){lo[0], lo[1], lo[2], lo[3], hh[0], hh[1], hh[2], hh[3]};
            o[dh] = __builtin_amdgcn_mfma_f32_32x32x16_bf16(__builtin_bit_cast(bf16x8, pw[ks]), vf, o[dh], 0, 0, 0); }
}
__device__ __forceinline__ float xhalf(float x, int hi) {
    auto rr = __builtin_amdgcn_permlane32_swap(__float_as_uint(x), __float_as_uint(x), false, false); return __uint_as_float(hi ? rr[0] : rr[1]); }
__device__ __forceinline__ float dpp_xor1(float x) { return __int_as_float(__builtin_amdgcn_mov_dpp(__float_as_int(x), 0xB1, 0xF, 0xF, true)); }
__device__ __forceinline__ float dpp_xor2(float x) { return __int_as_float(__builtin_amdgcn_mov_dpp(__float_as_int(x), 0x4E, 0xF, 0xF, true)); }
__device__ __forceinline__ void score_tile(f32x16& p0, f32x16& p1, int dist0, int step, int dmax, bool laneok, bool usebias, const LAS float* tbh, int hi) {
    const int dbase = dist0 + step * 4 * hi;
#pragma unroll
    for (int r = 0; r < 16; ++r) {
        const int kk = (r & 3) + 8 * (r >> 2); const int da = dbase + step * kk, db = da + step * 32;
        float sa = p0[r] * C2, sb = p1[r] * C2;
        if (usebias) { sa += tbh[min(max(da, 0), 127)]; sb += tbh[min(max(db, 0), 127)]; }
        p0[r] = (laneok && da >= 0 && da < dmax) ? sa : -INFINITY;
        p1[r] = (laneok && db >= 0 && db < dmax) ? sb : -INFINITY; }
}
template <bool DIAG>
__device__ __forceinline__ void near_scores(f32x16& p0, f32x16& p1, const LAS float* tbD, int D0) {
#pragma unroll
    for (int r = 0; r < 16; ++r) { const int kk = (r & 3) + 8 * (r >> 2);
        float sa = __builtin_fmaf(p0[r], C2, tbD[-kk]), sb = __builtin_fmaf(p1[r], C2, tbD[-kk - 32]);
        if (DIAG) { sa = (kk <= D0) ? sa : -INFINITY; sb = (kk + 32 <= D0) ? sb : -INFINITY; }
        p0[r] = sa; p1[r] = sb; }
}
__device__ __forceinline__ void wedge_mask(f32x16& p0, f32x16& p1, int D) {
#pragma unroll
    for (int r = 0; r < 16; ++r) { const int kk = (r & 3) + 8 * (r >> 2); p0[r] = (kk > D) ? p0[r] : -INFINITY; p1[r] = (kk + 32 > D) ? p1[r] : -INFINITY; }
}
__device__ __forceinline__ float rowmax32(const f32x16& p0, const f32x16& p1) {
    float a = fmaxf(p0[0], p1[0]);
#pragma unroll
    for (int r = 1; r < 16; ++r) a = fmaxf(a, fmaxf(p0[r], p1[r]));
    return fmaxf(a, xchg_f<32>(a, threadIdx.x & 63));
}
template <bool HAS_O>
__device__ __forceinline__ void softmax_step(f32x16& p0, f32x16& p1, float& m, float& l, f32x16 (&o)[2], u32x4 (&pw)[4], LAS float* wsf, int r32, int hi, bool sel = true) {
    const float rm = sel ? rowmax32(p0, p1) : -INFINITY, mn = fmaxf(m, rm);
    if (__any(mn > m + 8.0f)) {
        const float alpha = __builtin_amdgcn_exp2f(m - mn); l *= alpha; m = mn;
        if (HAS_O) { if (hi == 0) wsf[r32] = alpha; LDS_WAIT();
#pragma unroll
            for (int r = 0; r < 16; ++r) { const float f = wsf[crow(r, hi)]; o[0][r] *= f; o[1][r] *= f; }
            LDS_WAIT(); }
    }
    const float off = sel ? -m : -INFINITY;
    float s0 = 0.f, s1 = 0.f;
#pragma unroll
    for (int r = 0; r < 16; ++r) { p0[r] = __builtin_amdgcn_exp2f(p0[r] + off); p1[r] = __builtin_amdgcn_exp2f(p1[r] + off); s0 += p0[r]; s1 += p1[r]; }
    l += s0 + s1;
#pragma unroll
    for (int k = 0; k < 2; ++k) { pw[k] = (u32x4){pk2(p0[8 * k], p0[8 * k + 1]), pk2(p0[8 * k + 2], p0[8 * k + 3]), pk2(p0[8 * k + 4], p0[8 * k + 5]), pk2(p0[8 * k + 6], p0[8 * k + 7])};
        pw[2 + k] = (u32x4){pk2(p1[8 * k], p1[8 * k + 1]), pk2(p1[8 * k + 2], p1[8 * k + 3]), pk2(p1[8 * k + 4], p1[8 * k + 5]), pk2(p1[8 * k + 6], p1[8 * k + 7])}; }
}
template <bool HAS_O = true>
__device__ __forceinline__ void softmax_fast(f32x16& p0, f32x16& p1, float& m, float& l, f32x16 (&o)[2], u32x4 (&pw)[4], LAS float* wsf, int r32, int hi, bool sel) {
    float a = fmaxf(fmaxf(p0[0], p0[1]), p1[0]), bq = fmaxf(fmaxf(p0[2], p0[3]), p1[1]); a = fmaxf(fmaxf(a, p1[2]), p1[3]);
#pragma unroll
    for (int r = 4; r < 16; r += 4) { a = fmaxf(fmaxf(a, p0[r]), p0[r + 1]); bq = fmaxf(fmaxf(bq, p0[r + 2]), p0[r + 3]); a = fmaxf(fmaxf(a, p1[r]), p1[r + 1]); bq = fmaxf(fmaxf(bq, p1[r + 2]), p1[r + 3]); }
    a = fmaxf(a, bq); a = fmaxf(a, xchg_f<32>(a, threadIdx.x & 63));
    const float rm = sel ? a * C2 : -INFINITY, mn = fmaxf(m, rm);
    if (__any(mn > m + 8.0f)) {
        const float alpha = __builtin_amdgcn_exp2f(m - mn); l *= alpha; m = mn;
        if (HAS_O) { if (hi == 0) wsf[r32] = alpha; LDS_WAIT();
#pragma unroll
            for (int r = 0; r < 16; ++r) { const float f = wsf[crow(r, hi)]; o[0][r] *= f; o[1][r] *= f; }
            LDS_WAIT(); }
    }
    const float off = sel ? -m : -INFINITY;
    float s0 = 0.f, s1 = 0.f;
#pragma unroll
    for (int r = 0; r < 16; ++r) { p0[r] = __builtin_amdgcn_exp2f(__builtin_fmaf(p0[r], C2, off)); p1[r] = __builtin_amdgcn_exp2f(__builtin_fmaf(p1[r], C2, off)); s0 += p0[r]; s1 += p1[r]; }
    l += s0 + s1;
#pragma unroll
    for (int k = 0; k < 2; ++k) { pw[k] = (u32x4){pk2(p0[8 * k], p0[8 * k + 1]), pk2(p0[8 * k + 2], p0[8 * k + 3]), pk2(p0[8 * k + 4], p0[8 * k + 5]), pk2(p0[8 * k + 6], p0[8 * k + 7])};
        pw[2 + k] = (u32x4){pk2(p1[8 * k], p1[8 * k + 1]), pk2(p1[8 * k + 2], p1[8 * k + 3]), pk2(p1[8 * k + 4], p1[8 * k + 5]), pk2(p1[8 * k + 6], p1[8 * k + 7])}; }
}
template <bool FIRST>
__device__ __forceinline__ void branch_merge(LAS bf16* oa, const f32x16 (&o)[2], float l, float gate, LAS float* wsf, int r32, int hi, int lane) {
    const float lt = l + xchg_f<32>(l, lane); const float f = lt > 0.f ? gate / lt : 0.f;
    LDS_WAIT(); if (hi == 0) wsf[r32] = f; LDS_WAIT();
#pragma unroll
    for (int r = 0; r < 16; ++r) { const float ff = wsf[crow(r, hi)];
        float a0 = o[0][r] * ff, a1 = o[1][r] * ff;
        if (!FIRST) { a0 += bf2f(oa[(2 * r) * 64 + lane]); a1 += bf2f(oa[(2 * r + 1) * 64 + lane]); }
        oa[(2 * r) * 64 + lane] = (bf16)f2bf(a0); oa[(2 * r + 1) * 64 + lane] = (bf16)f2bf(a1); }
    LDS_WAIT();
}

__device__ __forceinline__ float rowmax_raw(const f32x16& p0, const f32x16& p1, int lane) {
    float a = fmaxf(fmaxf(p0[0], p0[1]), p1[0]), bq = fmaxf(fmaxf(p0[2], p0[3]), p1[1]); a = fmaxf(fmaxf(a, p1[2]), p1[3]);
#pragma unroll
    for (int r = 4; r < 16; r += 4) { a = fmaxf(fmaxf(a, p0[r]), p0[r + 1]); bq = fmaxf(fmaxf(bq, p0[r + 2]), p0[r + 3]); a = fmaxf(fmaxf(a, p1[r]), p1[r + 1]); bq = fmaxf(fmaxf(bq, p1[r + 2]), p1[r + 3]); }
    a = fmaxf(a, bq); return fmaxf(a, xchg_f<32>(a, lane));
}
__device__ __forceinline__ void rescale_o(f32x16 (&o)[2], float& m, float& l, float mn, LAS float* wsf, int r32, int hi) {
    const float alpha = __builtin_amdgcn_exp2f(m - mn); l *= alpha; m = mn;
    if (hi == 0) wsf[r32] = alpha; LDS_WAIT();
#pragma unroll
    for (int r = 0; r < 16; ++r) { const float f = wsf[crow(r, hi)]; float t0 = o[0][r], t1 = o[1][r];
        asm volatile("v_mul_f32 %0, %0, %1" : "+v"(t0) : "v"(f)); asm volatile("v_mul_f32 %0, %0, %1" : "+v"(t1) : "v"(f)); o[0][r] = t0; o[1][r] = t1; }
    LDS_WAIT();
}
template <bool QK>
__device__ __forceinline__ void exp_qk(f32x16& a0, f32x16& a1, f32x16& n0, f32x16& n1, const LAS unsigned char* L, int nbuf, const bf16x8 (&qf)[4], int r32, int hi, float cs, float off, float& l, u32x4 (&pw)[4]) {
    const LAS unsigned char* kb = L + KOFF + nbuf * 8192 + hi * 1024 + r32 * 16;
    float s0 = 0.f, s1 = 0.f;
    if (QK) { n0 = (f32x16){}; n1 = (f32x16){}; }
#pragma unroll
    for (int d0 = 0; d0 < 4; ++d0) {
        if (QK) { const bf16x8 b0 = *(const LAS bf16x8*)(kb + d0 * 2048), b1 = *(const LAS bf16x8*)(kb + d0 * 2048 + 512), q = qf[d0];
            n0 = __builtin_amdgcn_mfma_f32_32x32x16_bf16(b0, q, n0, 0, 0, 0);
            n1 = __builtin_amdgcn_mfma_f32_32x32x16_bf16(b1, q, n1, 0, 0, 0); }
#pragma unroll
        for (int r = 4 * d0; r < 4 * d0 + 4; ++r) { a0[r] = __builtin_amdgcn_exp2f(__builtin_fmaf(a0[r], cs, off)); a1[r] = __builtin_amdgcn_exp2f(__builtin_fmaf(a1[r], cs, off)); s0 += a0[r]; s1 += a1[r]; }
    }
    l += s0 + s1;
#pragma unroll
    for (int k = 0; k < 2; ++k) { pw[k] = (u32x4){pk2(a0[8 * k], a0[8 * k + 1]), pk2(a0[8 * k + 2], a0[8 * k + 3]), pk2(a0[8 * k + 4], a0[8 * k + 5]), pk2(a0[8 * k + 6], a0[8 * k + 7])};
        pw[2 + k] = (u32x4){pk2(a1[8 * k], a1[8 * k + 1]), pk2(a1[8 * k + 2], a1[8 * k + 3]), pk2(a1[8 * k + 4], a1[8 * k + 5]), pk2(a1[8 * k + 6], a1[8 * k + 7])}; }
}
template <bool MX>
__device__ __forceinline__ float pv_max(f32x16 (&o)[2], const LAS unsigned char* L, int buf, const u32x4 (&pw)[4], int lane, int hi, const f32x16& n0, const f32x16& n1) {
    const LAS unsigned char* vp = L + VOFF + buf * 8192 + ((lane >> 4) & 1) * 32 + (lane & 3) * 8 + (4 * hi + ((lane & 15) >> 2)) * 64;
    float a = -INFINITY, bq = -INFINITY;
#pragma unroll
    for (int dh = 0; dh < 2; ++dh)
#pragma unroll
        for (int ks = 0; ks < 4; ++ks) {
            const s16x4 lo = vtr(vp + dh * 4096 + ks * 1024), hh = vtr(vp + dh * 4096 + ks * 1024 + 512);
            const bf16x8 vf = (bf16x8){lo[0], lo[1], lo[2], lo[3], hh[0], hh[1], hh[2], hh[3]};
            o[dh] = __builtin_amdgcn_mfma_f32_32x32x16_bf16(__builtin_bit_cast(bf16x8, pw[ks]), vf, o[dh], 0, 0, 0);
            if (MX) { const int t = 2 * (dh * 4 + ks); a = fmaxf(fmaxf(a, n0[t]), n0[t + 1]); bq = fmaxf(fmaxf(bq, n1[t]), n1[t + 1]); } }
    if (!MX) return 0.f;
    a = fmaxf(a, bq); return fmaxf(a, xchg_f<32>(a, lane));
}
#define NSA2_X(i_, P0, P1, CS, SL) do { const int j_ = TILEJ(i_); SL = TSEL(j_); const int d_ = cur - j_; \
        if (d_ < 3) { const int D0 = tq - 64 * j_ - 4 * hi; if (d_ == 0) near_scores<true>(P0, P1, tbh + D0, D0); else near_scores<false>(P0, P1, tbh + D0, D0); CS = 1.0f; } \
        else { if (WEDGE && d_ >= 8) wedge_mask(P0, P1, tq - 64 * cur - 4 * hi); CS = C2; } } while (0)
#define NSA2_BODY(idx_, A0, A1, RMA, CSA, SLA, B0, B1, RMB, CSB, SLB) do { const int i_ = (idx_); \
        if (i_ + 2 < n_) NSA_WAITV(2); else NSA_WAITV(0); \
        NSA_BAR(); \
        if (i_ + 3 < n_) { ISSUE(i_ + 3, (i_ + 3) & 3); } \
        { const float mn_ = fmaxf(m, RMA); if (__any(mn_ > m + 8.0f)) rescale_o(o, m, l, mn_, wsf, r32, hi); } \
        const float off_ = SLA ? -m : -INFINITY; \
        exp_qk<true>(A0, A1, B0, B1, L, (i_ + 1) & 3, qf, r32, hi, CSA, off_, l, pw);        \
        SLB = false; CSB = C2; \
        if (i_ + 1 < n_) { NSA2_X(i_ + 1, B0, B1, CSB, SLB); } \
        { const float a_ = pv_max<true>(o, L, i_ & 3, pw, lane, hi, B0, B1); RMB = SLB ? a_ * CSB : -INFINITY; } \
    } while (0)
#define NSA2_LOOP(NTILES) do { const int n_ = (NTILES); \
        ISSUE(0, 0); if (n_ > 1) { ISSUE(1, 1); } if (n_ > 2) { ISSUE(2, 2); } \
        if (n_ > 2) NSA_WAITV(4); else if (n_ > 1) NSA_WAITV(2); else NSA_WAITV(0); \
        NSA_BAR(); \
        bf16x8 qf[4]; _Pragma("unroll") for (int d0_ = 0; d0_ < 4; ++d0_) qf[d0_] = qr[d0_ * 64]; \
        qkt(pa0, pa1, L, 0, qr, r32, hi); NSA2_X(0, pa0, pa1, csa, sla); rma = sla ? rowmax_raw(pa0, pa1, lane) * csa : -INFINITY; \
        for (int idx = 0; idx < n_; idx += 2) { \
            NSA2_BODY(idx, pa0, pa1, rma, csa, sla, pb0, pb1, rmb, csb, slb); \
            if (idx + 1 < n_) NSA2_BODY(idx + 1, pb0, pb1, rmb, csb, slb, pa0, pa1, rma, csa, sla); } \
        NSA_BAR(); } while (0)

#define NSA_LOOP(NTILES, NDMA, ISSUE, COMPUTE) do { const int n_ = (NTILES); \
        ISSUE(0, 0); if (n_ > 1) { ISSUE(1, 1); } \
        for (int idx = 0; idx < n_; ++idx) { \
            if (idx + 1 < n_) { if (NDMA == 2) NSA_WAITV(2); else NSA_WAITV(1); } else { NSA_WAITV(0); } \
            NSA_BAR(); \
            if (idx + 2 < n_) { ISSUE(idx + 2, (idx + 2) & 3); } \
            COMPUTE(idx, idx & 3); } \
        NSA_BAR(); } while (0)

template <int VAR>
__device__ __forceinline__ void attn_unit(const Frame& F, int b, int g, int cur, bf16* Y, bool FILL_TB) {
    LAS unsigned char* L = F.lds;
    int lane_ = F.lane; asm volatile("" : "+v"(lane_));
    const int lane = lane_, wid = F.wave, r32 = lane & 31, hi = lane >> 5, tid = F.tid;
    const bf16* Z = (const bf16*)(F.ws + WS_Z);
    const int qi = r32 >> 2, hp = r32 & 3, head = g * 4 + hp;
    const int tq = cur * 64 + wid * 8 + qi;
    const size_t zrow = (size_t)(b * SEQ + tq) * ZP;
    LAS float* tb = (LAS float*)(L + TBOFF);
    if (FILL_TB) for (int i = tid; i < 4 * 384; i += NTHR) { const int hpp = i / 384, dd = i % 384 - 64; tb[i] = (dd >= 0 && dd < 128) ? (F.in[15][T5B[dd & 127] * 8 + g * 4 + hpp] - F.in[15][31 * 8 + g * 4 + hpp]) * LOG2E : 0.f; }
    const LAS float* tbh = tb + hp * 384 + 64;
    LAS bf16x8* qr = (LAS bf16x8*)(L + (wid == 0 ? QOFF0 : TAB_OFF + (wid - 1) * 4096)) + lane;
#pragma unroll
    for (int d0 = 0; d0 < 4; ++d0) qr[d0 * 64] = *(const bf16x8*)(Z + zrow + ZC_QA + head * 64 + d0 * 16 + hi * 8);
#define NSA_GATE(br) sigmoidf_(bf2f(Z[zrow + ZC_GA + head * 3 + (br)]))
    LAS float* wsf = (LAS float*)(L + WSFOFF) + wid * 64;
    LAS unsigned long long* msk = (LAS unsigned long long*)(L + MSKOFF);
    LAS unsigned long long* uni = (LAS unsigned long long*)(L + UNIOFF);
    LAS int* jl = (LAS int*)(L + JLOFF);
    LAS bf16* oa = (LAS bf16*)(L + OACCOFF) + wid * 2048;
    LAS float* sc = (LAS float*)oa;
    f32x16 p0, p1, o[2]; u32x4 pw[4];
    NSA_BAR();

    {
        const bf16* KCb = (const bf16*)(F.ws + WS_KC) + (size_t)((b * 2 + g) * 256) * 64;
        const bf16* VCb = (const bf16*)(F.ws + WS_VC) + (size_t)((b * 2 + g) * 256) * 64;
        const int nT = (4 * cur + 2) / 64 + 1;
        float m = -1e30f, l = 0.f;
#define B1_COMP1(T, s) do { qkt(p0, p1, L, s, qr, r32, hi); \
            if (cur >= 16 * (T) + 19) softmax_fast<false>(p0, p1, m, l, o, pw, wsf, r32, hi, true); \
            else { score_tile(p0, p1, tq - 31 - 16 * 64 * (T), -16, 1 << 30, true, true, tbh, hi); softmax_step<false>(p0, p1, m, l, o, pw, wsf, r32, hi); } } while (0)
        for (int T = 0; T < nT; ++T) { dma_k(L, T, wid, lane, KCb + (size_t)T * 64 * 64, 64); dma_v(L, T, wid, lane, VCb + (size_t)T * 64 * 64, 64); }
        NSA_WAITV(0); NSA_BAR();
        for (int T = 0; T < nT; ++T) B1_COMP1(T, T);
        const float lt = l + xchg_f<32>(l, lane); const float inv_l = lt > 0.f ? 1.0f / lt : 0.f;
        o[0] = (f32x16){}; o[1] = (f32x16){};
        float carry = 0.f;
#define B1_COMP2(T, s) do { qkt(p0, p1, L, s, qr, r32, hi); \
            if (cur >= 16 * (T) + 19) { _Pragma("unroll") for (int r = 0; r < 16; ++r) { p0[r] *= C2; p1[r] *= C2; } } \
            else score_tile(p0, p1, tq - 31 - 16 * 64 * (T), -16, 1 << 30, true, true, tbh, hi); \
            float ps8[9]; \
            _Pragma("unroll") for (int i = 0; i < 9; ++i) ps8[i] = 0.f; \
            ps8[0] = (hi == 0) ? carry : 0.f; \
            _Pragma("unroll") for (int r = 0; r < 16; ++r) { p0[r] = __builtin_amdgcn_exp2f(p0[r] - m) * inv_l; p1[r] = __builtin_amdgcn_exp2f(p1[r] - m) * inv_l; } \
            _Pragma("unroll") for (int sub = 0; sub < 2; ++sub) _Pragma("unroll") for (int n = 0; n < 4; ++n) { \
                const float q0 = sub ? p1[4 * n] : p0[4 * n], q1 = sub ? p1[4 * n + 1] : p0[4 * n + 1], q2 = sub ? p1[4 * n + 2] : p0[4 * n + 2], q3 = sub ? p1[4 * n + 3] : p0[4 * n + 3]; \
                const float a = (q0 + q1) + (q2 + 0.5f * q3), bq = 0.5f * q3, bsw = xhalf(bq, hi); \
                if (hi == 1) ps8[sub * 4 + n] += a + bsw; else { ps8[sub * 4 + n] += a; ps8[sub * 4 + n + 1] += bsw; } } \
            carry = ps8[8]; \
            _Pragma("unroll") for (int i = 0; i < 8; ++i) { float v = ps8[i]; v += dpp_xor1(v); v += dpp_xor2(v); if (hp == 0) sc[qi * 64 + 16 * (T) + 2 * i + hi] = v; } \
            _Pragma("unroll") for (int k = 0; k < 2; ++k) { pw[k] = (u32x4){pk2(p0[8 * k], p0[8 * k + 1]), pk2(p0[8 * k + 2], p0[8 * k + 3]), pk2(p0[8 * k + 4], p0[8 * k + 5]), pk2(p0[8 * k + 6], p0[8 * k + 7])}; \
                pw[2 + k] = (u32x4){pk2(p1[8 * k], p1[8 * k + 1]), pk2(p1[8 * k + 2], p1[8 * k + 3]), pk2(p1[8 * k + 4], p1[8 * k + 5]), pk2(p1[8 * k + 6], p1[8 * k + 7])}; } \
            pv(o, L, s, pw, lane, hi); } while (0)
        for (int T = 0; T < nT; ++T) B1_COMP2(T, T);
        NSA_BAR();
    }
    unsigned long long mymask; int nsel;
    {
        LDS_WAIT();
        f32x4 va = {0.f, 0.f, 0.f, 0.f}, vb = va;
        if (cur >= 16) { va = *(const LAS f32x4*)(sc + (lane >> 3) * 64 + (lane & 7) * 8); vb = *(const LAS f32x4*)(sc + (lane >> 3) * 64 + (lane & 7) * 8 + 4); }
        branch_merge<true>(oa, o, 0.5f, NSA_GATE(0), wsf, r32, hi, lane);
        if (cur >= 16) {
            {
                const int q = lane >> 3, ch = lane & 7;
                unsigned bits[8]; unsigned vmask = 0u;
#pragma unroll
                for (int j = 0; j < 8; ++j) { const int blk = ch * 8 + j; const bool valid = blk <= cur; const bool forced = (blk == 0) || (blk == cur) || (blk == cur - 1);
                    const float v = (j < 4 ? va[j & 3] : vb[j & 3]) + (forced ? 1000.f : 0.f);
                    bits[j] = valid ? (__float_as_uint(v) & 0xfffff000u) : 0u; vmask |= valid ? (1u << j) : 0u; }
#define SUM8(x) do { x += __builtin_amdgcn_mov_dpp(x, 0xB1, 0xF, 0xF, true); x += __builtin_amdgcn_mov_dpp(x, 0x4E, 0xF, 0xF, true); x += __builtin_amdgcn_mov_dpp(x, 0x141, 0xF, 0xF, true); } while (0)
                unsigned T = 0u;
#pragma unroll
                for (int bt = 30; bt >= 12; --bt) { const unsigned cand = T | (1u << bt); int cnt = 0;
#pragma unroll
                    for (int j = 0; j < 8; ++j) cnt += (bits[j] >= cand) ? 1 : 0;
                    SUM8(cnt); T = (cnt >= 16) ? cand : T; }
                int ngt = 0, eqc = 0; unsigned gtm = 0u, eqm = 0u;
#pragma unroll
                for (int j = 0; j < 8; ++j) { const bool g_ = bits[j] > T, e_ = (bits[j] == T) && ((vmask >> j) & 1u); gtm |= g_ ? (1u << j) : 0u; eqm |= e_ ? (1u << j) : 0u; ngt += g_ ? 1 : 0; eqc += e_ ? 1 : 0; }
                SUM8(ngt);
                int pre = eqc;
                { int t = __builtin_amdgcn_mov_dpp(pre, 0x111, 0xF, 0xF, true); if (ch >= 1) pre += t; t = __builtin_amdgcn_mov_dpp(pre, 0x112, 0xF, 0xF, true); if (ch >= 2) pre += t; t = __builtin_amdgcn_mov_dpp(pre, 0x114, 0xF, 0xF, true); if (ch >= 4) pre += t; }
                int run = pre - eqc; const int need = 16 - ngt; unsigned m8 = gtm;
#pragma unroll
                for (int j = 0; j < 8; ++j) { const bool e_ = (eqm >> j) & 1u; if (e_ && run < need) m8 |= 1u << j; run += e_ ? 1 : 0; }
                ((LAS unsigned char*)msk)[(wid * 8 + q) * 8 + ch] = (unsigned char)m8;
#undef SUM8
            }
        } else {
            if (lane < 8) msk[wid * 8 + lane] = (2ull << cur) - 1ull;
        }
        LDS_WAIT();
        mymask = msk[wid * 8 + qi];
        unsigned long long u = mymask;
#pragma unroll
        for (int o_ = 4; o_ < 32; o_ <<= 1) { const unsigned lo = __shfl_xor((unsigned)u, o_), hh = __shfl_xor((unsigned)(u >> 32), o_); u |= ((unsigned long long)hh << 32) | lo; }
        if (lane == 0) uni[wid] = u;
        NSA_BAR();
        unsigned long long umask = 0ull;
#pragma unroll
        for (int w = 0; w < 8; ++w) umask |= uni[w];
        umask = ((unsigned long long)__builtin_amdgcn_readfirstlane((unsigned)(umask >> 32)) << 32) | (unsigned)__builtin_amdgcn_readfirstlane((unsigned)umask);
        nsel = __builtin_popcountll(umask);
        if (wid == 0 && ((umask >> lane) & 1ull)) jl[__builtin_popcountll(umask & ((1ull << lane) - 1ull))] = lane;
        NSA_BAR();
    }
    {
        const bf16* Kb = Z + (size_t)(b * SEQ) * ZP + ZC_KS + g * 64; const bf16* Vb = Z + (size_t)(b * SEQ) * ZP + ZC_VS + g * 64;
        float m = -1e30f, l = 0.f; o[0] = (f32x16){}; o[1] = (f32x16){};
f32x16 pa0, pa1, pb0, pb1; float rma, rmb = 0.f, csa, csb = 0.f; bool sla, slb = false;
#define ISSUE(i_, s) do { const int jj_ = __builtin_amdgcn_readfirstlane(jl[i_]); dma_k(L, s, wid, lane, Kb + (size_t)(64 * jj_) * ZP, ZP); dma_v(L, s, wid, lane, Vb + (size_t)(64 * jj_) * ZP, ZP); } while (0)
#define TILEJ(i_) __builtin_amdgcn_readfirstlane(jl[i_])
#define TSEL(j_) (((mymask >> (j_)) & 1ull) != 0ull)
#define WEDGE false
        NSA2_LOOP(nsel);
#undef ISSUE
#undef TILEJ
#undef TSEL
#undef WEDGE
        branch_merge<false>(oa, o, l, NSA_GATE(1), wsf, r32, hi, lane);
    }
    {
        const bf16* Kb = Z + (size_t)(b * SEQ) * ZP + ZC_KW + g * 64; const bf16* Vb = Z + (size_t)(b * SEQ) * ZP + ZC_VW + g * 64;
        float m = -1e30f, l = 0.f; o[0] = (f32x16){}; o[1] = (f32x16){};
        const int j0 = cur >= 8 ? cur - 8 : 0, nT = cur - j0 + 1;
f32x16 pa0, pa1, pb0, pb1; float rma, rmb = 0.f, csa, csb = 0.f; bool sla, slb = false;
#define ISSUE(T, s) do { dma_k(L, s, wid, lane, Kb + (size_t)(64 * (j0 + (T))) * ZP, ZP); dma_v(L, s, wid, lane, Vb + (size_t)(64 * (j0 + (T))) * ZP, ZP); } while (0)
#define TILEJ(i_) (j0 + (i_))
#define TSEL(j_) true
#define WEDGE true
        NSA2_LOOP(nT);
#undef ISSUE
#undef TILEJ
#undef TSEL
#undef WEDGE
        branch_merge<false>(oa, o, l, NSA_GATE(2), wsf, r32, hi, lane);
    }
#pragma unroll
    for (int r = 0; r < 16; ++r) { const int row = crow(r, hi), q_ = row >> 2, hp_ = row & 3;
        bf16* dst = Y + (size_t)(b * SEQ + cur * 64 + wid * 8 + q_) * 1024 + 512 + (g * 4 + hp_) * 64 + r32;
        dst[0] = oa[(2 * r) * 64 + lane]; dst[32] = oa[(2 * r + 1) * 64 + lane]; }
#undef B1_COMP1
#undef B1_COMP2
#undef NSA_GATE
}
template <int VAR>
__device__ __forceinline__ void p4_attention(Frame& F, bf16* Y) {
    for (int v = F.vcu; v < 256; v += F.G) {
        const int bg = v >> 5, s = v & 31;
#pragma unroll 1
        for (int u2 = 0; u2 < 2; ++u2) attn_unit<VAR>(F, bg >> 1, bg & 1, u2 ? s : 63 - s, Y, u2 == 0);
    }
}
}

__device__ __forceinline__ f32x16 mma32_lds(const LAS bf16* A, int sa, const LAS bf16* Bt, int sb, int ksteps, int r32, int hi, f32x16 acc) {
#pragma unroll
    for (int ks = 0; ks < 8; ++ks) if (ks < ksteps) {
        const bf16x8 a = *(const LAS bf16x8*)(A + r32 * sa + ks * 16 + hi * 8), bq = *(const LAS bf16x8*)(Bt + r32 * sb + ks * 16 + hi * 8);
        acc = __builtin_amdgcn_mfma_f32_32x32x16_bf16(a, bq, acc, 0, 0, 0); }
    return acc;
}
__device__ __forceinline__ void p5_mlstm_c_items(Frame& F) {
    const int tid = F.tid, lane = F.lane, r32 = lane & 31, hi = lane >> 5, wid = F.wave;
    LAS bf16* Qs = (LAS bf16*)F.lds;
    LAS bf16* Qp = Qs + 64 * QS_STRIDE;
    LAS bf16* Ks = Qp + 64 * QS_STRIDE;
    LAS bf16* VT = Ks + 64 * QS_STRIDE;
    LAS bf16* CT = VT + 128 * KT_STRIDE;
    LAS bf16* Wm = CT + 128 * QS_STRIDE;
    LAS float* fu = (LAS float*)(Wm + 64 * KT_STRIDE);
    LAS float* frd = fu + 256; LAS float* fnp = fu + 320;
    LAS float* gtab = (LAS float*)(F.lds + 120 * 1024);
    LAS float* cwl = (LAS float*)(F.lds + 124 * 1024);
    const bf16* Z = (const bf16*)(F.ws + WS_Z);
    ConvRaw rq[2], rk[2]; bf16x8 rvv[2]; u32x4 cpv[4]; unsigned short ogn[16]; float np_n = 0.f;
#define P5_LOAD(item_) do { const int b_ = (item_) >> 8, h_ = ((item_) >> 6) & 3, c_ = (item_) & 63; \
    _Pragma("unroll") for (int rep = 0; rep < 2; ++rep) { const int task = tid + NTHR * rep, l = task >> 4, ch = task & 15, t = c_ * 64 + l; \
        conv8_load(F, b_, t, ZC_QM + h_ * 128 + ch * 8, rq[rep]); conv8_load(F, b_, t, ZC_KM + h_ * 128 + ch * 8, rk[rep]); \
        rvv[rep] = *(const bf16x8*)(Z + (size_t)(b_ * SEQ + t) * ZP + ZC_VM + h_ * 128 + ch * 8); } \
    { const bf16* cp = (const bf16*)(F.ws + WS_CP) + (size_t)(item_) * 16384; \
      _Pragma("unroll") for (int i = 0; i < 4; ++i) { const int q = tid + NTHR * i; cpv[i] = *(const u32x4*)(cp + q * 8); } } \
    { const int lt = wid & 1, et = wid >> 1; \
      _Pragma("unroll") for (int r = 0; r < 16; ++r) ogn[r] = Z[(size_t)(b_ * SEQ + c_ * 64 + lt * 32 + crow(r, hi)) * ZP + ZC_OM + h_ * 128 + et * 32 + r32]; } \
    if (tid >= 64 && tid < 192) np_n = ((const float*)(F.ws + WS_NP))[(size_t)(item_) * 128 + tid - 64]; } while (0)
    int item = F.vcu, kb = 0, cur_h = -1;
    if (item >= 1024) return;
    P5_LOAD(item);
    for (;;) {
    const int b = item >> 8, h = (item >> 6) & 3, c = item & 63;
    if ((kb & 3) == 0 && wid < 4) {
        const int it2 = item + wid * F.G;
        if (it2 < 1024) { const int b2 = it2 >> 8, h2 = (it2 >> 6) & 3, c2 = it2 & 63; const size_t zr = (size_t)(b2 * SEQ + c2 * 64 + lane) * ZP;
            const float ig = bf2f(Z[zr + ZC_IG + h2]) + F.in[9][h2]; float g = logsigmoidf_(bf2f(Z[zr + ZC_FG + h2]) + F.in[9][4 + h2]);
            const float Mp = ((const float*)(F.ws + WS_SC))[2048 + it2];
#pragma unroll
            for (int o = 1; o < 64; o <<= 1) { const float t = __shfl_up(g, o); if (lane >= o) g += t; }
            const float u = ig - g; float pm = u;
#pragma unroll
            for (int o = 1; o < 64; o <<= 1) { const float t = __shfl_up(pm, o); if (lane >= o) pm = fmaxf(pm, t); }
            const float mm = fmaxf(Mp, pm);
            LAS float* gt = gtab + wid * 256;
            gt[lane] = u; gt[64 + lane] = mm; gt[128 + lane] = __expf(Mp - mm); gt[192 + lane] = __expf(-(g + mm)); } }
    if (h != cur_h) {
#pragma unroll
        for (int k = 0; k < 2; ++k) { const int i = tid + NTHR * k, tap = i >> 8, lc = i & 255; cwl[i] = F.in[10][tap * 1024 + (lc < 128 ? h * 128 + lc : 512 + h * 128 + lc - 128)]; }
        cur_h = h; }
    const LAS float* fu = gtab + (kb & 3) * 256; const LAS float* fmm = fu + 64; const LAS float* fiw = fu + 128; const LAS float* ffl = fu + 192;
    if (tid >= 64 && tid < 192) fnp[tid - 64] = np_n;
    __syncthreads();
#pragma unroll
    for (int rep = 0; rep < 2; ++rep) { const int task = tid + NTHR * rep, l = task >> 4, ch = task & 15;
        float qq[8], kk[8];
        conv8_calc_lds(cwl, 256, rq[rep], ch * 8, qq);
        conv8_calc_lds(cwl, 256, rk[rep], 128 + ch * 8, kk);
        const float iw = fiw[l];
        u32x4 wq, wp, wk;
        wq.x = pk2(qq[0], qq[1]); wq.y = pk2(qq[2], qq[3]); wq.z = pk2(qq[4], qq[5]); wq.w = pk2(qq[6], qq[7]);
        wp.x = pk2(qq[0] * iw, qq[1] * iw); wp.y = pk2(qq[2] * iw, qq[3] * iw); wp.z = pk2(qq[4] * iw, qq[5] * iw); wp.w = pk2(qq[6] * iw, qq[7] * iw);
        const float sk = 0.08838834764831845f;
        wk.x = pk2(kk[0] * sk, kk[1] * sk); wk.y = pk2(kk[2] * sk, kk[3] * sk); wk.z = pk2(kk[4] * sk, kk[5] * sk); wk.w = pk2(kk[6] * sk, kk[7] * sk);
        *(LAS u32x4*)(Qs + l * QS_STRIDE + ch * 8) = wq; *(LAS u32x4*)(Qp + l * QS_STRIDE + ch * 8) = wp; *(LAS u32x4*)(Ks + l * QS_STRIDE + ch * 8) = wk;
        const bf16x8 vv = rvv[rep];
#pragma unroll
        for (int j = 0; j < 8; ++j) VT[(ch * 8 + j) * KT_STRIDE + l] = (bf16)vv[j]; }
    {
#pragma unroll
        for (int i = 0; i < 4; ++i) { const int q = tid + NTHR * i, e = q >> 4, d8 = (q & 15) * 8; *(LAS u32x4*)(CT + e * QS_STRIDE + d8) = cpv[i]; } }
    unsigned short og[16];
#pragma unroll
    for (int r = 0; r < 16; ++r) og[r] = ogn[r];
    const int nitem = item + F.G;
    if (nitem < 1024) P5_LOAD(nitem);
    __syncthreads();
    if (wid < 4) {
        const int lt = wid >> 1, st = wid & 1;
        f32x16 acc = {}; acc = mma32_lds(Qs + lt * 32 * QS_STRIDE, QS_STRIDE, Ks + st * 32 * QS_STRIDE, QS_STRIDE, 8, r32, hi, acc);
        const int s = st * 32 + r32; const float us = fu[s];
#pragma unroll
        for (int r = 0; r < 16; ++r) { const int l = lt * 32 + crow(r, hi); const float w = (s <= l) ? __expf(us - fmm[l]) * acc[r] : 0.f; Wm[l * KT_STRIDE + s] = (bf16)f2bf(w); }
    }
    __syncthreads();
    {
        const int l = tid >> 3, part = tid & 7; float dsum = 0.f;
#pragma unroll
        for (int s = 0; s < 8; ++s) dsum += bf2f(Wm[l * KT_STRIDE + part * 8 + s]);
#pragma unroll
        for (int d = 0; d < 16; ++d) dsum += bf2f(Qp[l * QS_STRIDE + part * 16 + d]) * fnp[part * 16 + d];
        dsum += __shfl_xor(dsum, 1); dsum += __shfl_xor(dsum, 2); dsum += __shfl_xor(dsum, 4);
        if (part == 0) frd[l] = 1.0f / fmaxf(fabsf(dsum), ffl[l]);
    }
    f32x16 acc = {};
    {
        const int lt = wid & 1, et = wid >> 1;
        acc = mma32_lds(Wm + lt * 32 * KT_STRIDE, KT_STRIDE, VT + et * 32 * KT_STRIDE, KT_STRIDE, 4, r32, hi, acc);
        acc = mma32_lds(Qp + lt * 32 * QS_STRIDE, QS_STRIDE, CT + et * 32 * QS_STRIDE, QS_STRIDE, 8, r32, hi, acc);
        __syncthreads();
        bf16* Y = (bf16*)(F.ws + WS_YMIX);
        const int e = et * 32 + r32;
#pragma unroll
        for (int r = 0; r < 16; ++r) { const int l = lt * 32 + crow(r, hi); const size_t row = (size_t)(b * SEQ + c * 64 + l);
            Y[row * 1024 + h * 128 + e] = (bf16)f2bf(acc[r] * frd[l] * sigmoidf_(bf2f(og[r]))); }
    }
    __syncthreads();
    if (nitem >= 1024) break;
    item = nitem; ++kb;
    }
#undef P5_LOAD
}

template <int L> __device__ __forceinline__ float rtree(const LAS float* WR, const f32x4 (&h2)[4], int base, int lane) {
    if constexpr (L == 0) { float s = 0.f;
#pragma unroll
        for (int j = 0; j < 4; ++j) { const f32x4 w = *(const LAS f32x4*)(WR + base * 1024 + 4 * lane + 256 * j); s += (h2[j].x * w.x + h2[j].y * w.y) + (h2[j].z * w.z + h2[j].w * w.w); }
        return s;
    } else {
        const float lo = rtree<L - 1>(WR, h2, base, lane), hh = rtree<L - 1>(WR, h2, base + (1 << (L - 1)), lane);
        const bool up = (lane & (1 << L)) != 0;
        return (up ? hh : lo) + __shfl_xor(up ? lo : hh, 1 << L);
    }
}
__device__ __forceinline__ void wave_sum2(float (&v)[2]) {
    const int lane = threadIdx.x & 63;
#define WS2_STEP(M) do { const float a = xchg_f<M>(v[0], lane), b = xchg_f<M>(v[1], lane); v[0] += a; v[1] += b; } while (0)
    WS2_STEP(1); WS2_STEP(2); WS2_STEP(4); WS2_STEP(8); WS2_STEP(16); WS2_STEP(32);
#undef WS2_STEP
}
#define RT_MASK(L) ((L) == 1 ? 1 : (L) == 2 ? 2 : (L) == 3 ? 32 : (L) == 4 ? 4 : 8)
__device__ __forceinline__ int router_expert(int lane) { return (lane & 3) | (((lane >> 5) & 1) << 2) | (((lane >> 2) & 3) << 3); }
template <int L> __device__ __forceinline__ f32x2 rtree2(const LAS float* WR, const f32x4 (&h2)[2][4], int base, int lane) {
    if constexpr (L == 0) { f32x2 a0 = {0.f, 0.f}, a1 = {0.f, 0.f};
#pragma unroll
        for (int j = 0; j < 4; ++j) { const f32x4 w = *(const LAS f32x4*)(WR + base * 1024 + 4 * lane + 256 * j);
            const f32x2 wl = {w.x, w.y}, wh = {w.z, w.w};
            a0 = __builtin_elementwise_fma((f32x2){h2[0][j].x, h2[0][j].y}, wl, a0); a0 = __builtin_elementwise_fma((f32x2){h2[0][j].z, h2[0][j].w}, wh, a0);
            a1 = __builtin_elementwise_fma((f32x2){h2[1][j].x, h2[1][j].y}, wl, a1); a1 = __builtin_elementwise_fma((f32x2){h2[1][j].z, h2[1][j].w}, wh, a1); }
        f32x2 s; s.x = a0.x + a0.y; s.y = a1.x + a1.y;
        return s;
    } else {
        const f32x2 lo = rtree2<L - 1>(WR, h2, base, lane), hh = rtree2<L - 1>(WR, h2, base + (1 << (L - 1)), lane);
        const bool up = (lane & RT_MASK(L)) != 0;
        f32x2 r; r.x = (up ? hh.x : lo.x) + xchg_f<RT_MASK(L)>(up ? lo.x : hh.x, lane); r.y = (up ? hh.y : lo.y) + xchg_f<RT_MASK(L)>(up ? lo.y : hh.y, lane);
        return r;
    }
}
__device__ __forceinline__ void p7_rows(Frame& F) {
    LAS float* WR = (LAS float*)F.lds;
    LAS int* lcnt = (LAS int*)(F.lds + TAB_OFF);
    LAS int* gbase = lcnt + 32;
    LAS int* rinfo = gbase + 32;
    const float* MODF = (const float*)(F.ws + WS_MODF);
    const int lane = F.lane, tid = F.tid;
    {
        f32x4 wv[16];
#pragma unroll
        for (int i = 0; i < 16; ++i) wv[i] = ((const f32x4*)(F.ws + WS_WRT))[tid + NTHR * i];
#pragma unroll
        for (int i = 0; i < 16; ++i) ((LAS f32x4*)WR)[tid + NTHR * i] = wv[i]; }
    for (int rb = F.vcu; rb < M / 64; rb += F.G) {
        const int b = (rb * 64) / SEQ;
        if (tid < 32) lcnt[tid] = 0;
        __syncthreads();
        LAS float* A7 = (LAS float*)(F.lds + TAB_OFF + 4096); LAS float* G2 = A7 + 1024; LAS float* S2 = G2 + 1024;
        for (int c0 = tid; c0 < 1024; c0 += NTHR) { A7[c0] = F.in[5][c0] * MODF[b * 6144 + 2048 + c0]; G2[c0] = F.in[6][c0] * (MODF[b * 6144 + 4096 + c0] + 1.0f); S2[c0] = MODF[b * 6144 + 3072 + c0]; }
        __syncthreads();
        u32x2 yw[2][2][4]; f32x4 xw[2][2][4];
        const int row0 = rb * 64 + F.wave * 8;
#pragma unroll
        for (int r = 0; r < 2; ++r) { const u32x2* yr = (const u32x2*)((const bf16*)(F.ws + WS_Y) + (size_t)(row0 + r) * 1024) + lane; const f32x4* xr = (const f32x4*)(F.in[0] + (size_t)(row0 + r) * 1024) + lane;
#pragma unroll
            for (int j = 0; j < 4; ++j) { yw[0][r][j] = yr[64 * j]; xw[0][r][j] = xr[64 * j]; } }
        const float brt = F.in[18][router_expert(lane)];
#pragma unroll
        for (int ip = 0; ip < 4; ++ip) {
            const int rl0 = F.wave * 8 + 2 * ip, rowp = rb * 64 + rl0;
            if (ip < 3) {
#pragma unroll
                for (int r = 0; r < 2; ++r) { const u32x2* yr = (const u32x2*)((const bf16*)(F.ws + WS_Y) + (size_t)(rowp + 2 + r) * 1024) + lane; const f32x4* xr = (const f32x4*)(F.in[0] + (size_t)(rowp + 2 + r) * 1024) + lane;
#pragma unroll
                    for (int j = 0; j < 4; ++j) { yw[(ip + 1) & 1][r][j] = yr[64 * j]; xw[(ip + 1) & 1][r][j] = xr[64 * j]; } } }
            f32x4 y[2][4], x1[2][4], h2[2][4]; float ss[2] = {0.f, 0.f};
#pragma unroll
            for (int r = 0; r < 2; ++r)
#pragma unroll
                for (int j = 0; j < 4; ++j) { const u32x2 w = yw[ip & 1][r][j]; y[r][j] = (f32x4){bf2f(w.x & 0xffffu), bf2f(w.x >> 16), bf2f(w.y & 0xffffu), bf2f(w.y >> 16)};
                    ss[r] += (y[r][j].x * y[r][j].x + y[r][j].y * y[r][j].y) + (y[r][j].z * y[r][j].z + y[r][j].w * y[r][j].w); }
            wave_sum2(ss);
            float s1[2] = {0.f, 0.f};
#pragma unroll
            for (int r = 0; r < 2; ++r) { const float rs = rsqrtf(ss[r] * (1.0f / 1024.0f) + EPS);
#pragma unroll
                for (int j = 0; j < 4; ++j) { x1[r][j] = xw[ip & 1][r][j] + *(const LAS f32x4*)(A7 + 4 * lane + 256 * j) * (y[r][j] * rs); s1[r] += (x1[r][j].x * x1[r][j].x + x1[r][j].y * x1[r][j].y) + (x1[r][j].z * x1[r][j].z + x1[r][j].w * x1[r][j].w);
                    ((f32x4*)(F.out + (size_t)(rowp + r) * 1024))[lane + 64 * j] = x1[r][j]; } }
            wave_sum2(s1);
#pragma unroll
            for (int r = 0; r < 2; ++r) { const float rs1 = rsqrtf(s1[r] * (1.0f / 1024.0f) + EPS);
                unsigned* ho = (unsigned*)(F.ws + WS_H + (size_t)(rowp + r) * 1024) + lane;
#pragma unroll
                for (int j = 0; j < 4; ++j) { h2[r][j] = x1[r][j] * rs1 * *(const LAS f32x4*)(G2 + 4 * lane + 256 * j) + *(const LAS f32x4*)(S2 + 4 * lane + 256 * j); ho[64 * j] = pk4_fp8(h2[r][j].x, h2[r][j].y, h2[r][j].z, h2[r][j].w); } }
            f32x2 lg = rtree2<5>(WR, h2, 0, lane);
            lg.x += __shfl_xor(lg.x, 16); lg.y += __shfl_xor(lg.y, 16);
            lg.x += brt; lg.y += brt;
            const int e = router_expert(lane);
            float tvv[2][4]; int tee[2][4]; float cand0 = lg.x, cand1 = lg.y;
#define TOPK_STEP(MASK) do { const float ov0 = xchg_f<MASK>(v0, lane), ov1 = xchg_f<MASK>(v1, lane); const int oi0 = xchg_i<MASK>(i0, lane), oi1 = xchg_i<MASK>(i1, lane); \
                    if (ov0 > v0 || (ov0 == v0 && oi0 < i0)) { v0 = ov0; i0 = oi0; } if (ov1 > v1 || (ov1 == v1 && oi1 < i1)) { v1 = ov1; i1 = oi1; } } while (0)
#pragma unroll
            for (int k = 0; k < 4; ++k) { float v0 = cand0, v1 = cand1; int i0 = e, i1 = e;
                TOPK_STEP(1); TOPK_STEP(2); TOPK_STEP(32); TOPK_STEP(4); TOPK_STEP(8);
                tvv[0][k] = v0; tee[0][k] = i0; tvv[1][k] = v1; tee[1][k] = i1; if (e == i0) cand0 = -INFINITY; if (e == i1) cand1 = -INFINITY; }
#undef TOPK_STEP
#pragma unroll
            for (int r = 0; r < 2; ++r) { int te[4]; float tv[4];
#pragma unroll
                for (int k = 0; k < 4; ++k) { te[k] = tee[r][k]; tv[k] = tvv[r][k]; }
                const float e1 = __expf(tv[1] - tv[0]), e2 = __expf(tv[2] - tv[0]), e3 = __expf(tv[3] - tv[0]); const float inv = 1.0f / (1.0f + e1 + e2 + e3);
                if (lane < 4) { const int ek = lane == 0 ? te[0] : lane == 1 ? te[1] : lane == 2 ? te[2] : te[3]; const float gk = (lane == 0 ? 1.0f : lane == 1 ? e1 : lane == 2 ? e2 : e3) * inv;
                    const int lr = __hip_atomic_fetch_add(&lcnt[ek], 1, __ATOMIC_RELAXED, __HIP_MEMORY_SCOPE_WORKGROUP); const int rl = rl0 + r;
                    rinfo[(rl * 4 + lane) * 3 + 0] = ek; rinfo[(rl * 4 + lane) * 3 + 1] = lr; rinfo[(rl * 4 + lane) * 3 + 2] = __float_as_int(gk); } }
        }
        __syncthreads();
        if (tid < 32) gbase[tid] = (int)__hip_atomic_fetch_add(F.ctl + CW_CNT + 64 * tid, (unsigned)lcnt[tid], RLX_AGENT);
        __syncthreads();
        if (tid < 256) { const int rl = tid >> 2, k = tid & 3, row = rb * 64 + rl; const int ek = rinfo[tid * 3], rank = gbase[ek] + rinfo[tid * 3 + 1];
            ((int*)(F.ws + WS_TOKE))[row * 4 + k] = ek; ((int*)(F.ws + WS_TOKR))[row * 4 + k] = rank; ((int*)(F.ws + WS_TOKG))[row * 4 + k] = rinfo[tid * 3 + 2];
            ((int*)(F.ws + WS_ROWTOK))[(size_t)ek * ECAP + rank] = row; }
        __syncthreads();
    }
}

struct MoeTabs { LAS int* cnt; LAS int* tbase; LAS int* tile_e; LAS int* tile_r0; LAS int* idx; };
__device__ __forceinline__ MoeTabs moe_tabs(const Frame& F) { MoeTabs t; t.cnt = (LAS int*)(F.lds + TAB_OFF); t.tbase = t.cnt + 32; t.tile_e = t.tbase + 40; t.tile_r0 = t.tile_e + MAXT; t.idx = t.tile_r0 + MAXT; return t; }
__device__ __forceinline__ int moe_build_tabs(const Frame& F, const MoeTabs& T) {
    if (F.tid < 32) T.cnt[F.tid] = (int)__hip_atomic_load(F.ctl + CW_CNT + 64 * F.tid, RLX_AGENT);
    __syncthreads();
    if (F.tid < 32) { int s0 = 0, tot = 0;
#pragma unroll
        for (int e = 0; e < 32; ++e) { const int n = (T.cnt[e] + 255) >> 8; s0 += (e < F.tid) ? n : 0; tot += n; }
        T.tbase[F.tid] = s0; if (F.tid == 0) T.tbase[32] = tot;
        const int n = (T.cnt[F.tid] + 255) >> 8; for (int t = 0; t < n; ++t) { T.tile_e[s0 + t] = F.tid; T.tile_r0[s0 + t] = t * 256; } }
    __syncthreads();
    return T.tbase[32];
}
constexpr int MAXU = 12;
struct MoeUpSched {
    int NT, G, c; LAS const int* tile_e; LAS const int* idx;
    __device__ __forceinline__ bool next(int i, pg8::Unit& u) const { const int L = i * G + c; if (L >= NT * 8 || i >= MAXU) return false; u.pm = L >> 3; u.pn = L & 7; u.e = tile_e[u.pm]; u.ui = i; return true; }
    __device__ __forceinline__ unsigned arow(const pg8::Unit& u, int r) const { return (unsigned)idx[u.ui * 256 + r]; }
    __device__ __forceinline__ size_t boff(const pg8::Unit& u) const { return ((size_t)u.e * 2048 + (size_t)u.pn * 256) * 1024; }
};
struct MoeDownSched {
    int NT, G, c; LAS const int* tile_e;
    __device__ __forceinline__ bool next(int i, pg8::Unit& u) const { const int L = i * G + c; if (L >= NT * 4) return false; u.pm = L >> 2; u.pn = L & 3; u.e = tile_e[u.pm]; u.ui = i; return true; }
    __device__ __forceinline__ unsigned arow(const pg8::Unit& u, int r) const { return (unsigned)(u.pm * 256 + r); }
    __device__ __forceinline__ size_t boff(const pg8::Unit& u) const { return ((size_t)u.e * 1024 + (size_t)u.pn * 256) * 1024; }
};

__device__ __forceinline__ void p11_final(Frame& F, float* dstp) {
    const MoeTabs T = moe_tabs(F); (void)moe_build_tabs(F, T);
    const float* MODF = (const float*)(F.ws + WS_MODF); const int lane = F.lane;
    const unsigned char* YB = F.ws + WS_YB;
    for (int rb = F.vcu; rb < M / 64; rb += F.G) {
        const int b = (rb * 64) / SEQ;
        LAS float* A9 = (LAS float*)(F.lds + TAB_OFF + 16384);
        __syncthreads();
        for (int c0 = F.tid; c0 < 1024; c0 += NTHR) A9[c0] = F.in[7][c0] * MODF[b * 6144 + 5120 + c0];
        __syncthreads();
        const int row0 = rb * 64 + F.wave * 8;
        unsigned myoff = 0u; float mygate = 0.f;
        if (lane < 32) { const int e = ((const int*)(F.ws + WS_TOKE))[row0 * 4 + lane], r = ((const int*)(F.ws + WS_TOKR))[row0 * 4 + lane]; mygate = ((const float*)(F.ws + WS_TOKG))[row0 * 4 + lane];
            myoff = (unsigned)(T.tbase[e] * 256 + r) * 1024u; mygate *= 1.0f / YB_SCALE; }
        u32x4 yw[3][4]; f32x4 xw[3][4];
#define P10_ISSUE(i_, s_) do { \
            _Pragma("unroll") for (int k = 0; k < 4; ++k) { const unsigned off = (unsigned)__builtin_amdgcn_readlane((int)myoff, (i_) * 4 + k); yw[s_][k] = ((const u32x4*)(YB + off))[lane]; } \
            { const f32x4* xr = (const f32x4*)(F.out + (size_t)(row0 + (i_)) * 1024) + 4 * lane; _Pragma("unroll") for (int q = 0; q < 4; ++q) xw[s_][q] = xr[q]; } } while (0)
        P10_ISSUE(0, 0); P10_ISSUE(1, 1);
#pragma unroll
        for (int i = 0; i < 8; ++i) {
            const int row = row0 + i, sl = i % 3;
            if (i + 2 < 8) P10_ISSUE(i + 2, (i + 2) % 3);
            float gk[4];
#pragma unroll
            for (int k = 0; k < 4; ++k) gk[k] = __int_as_float(__builtin_amdgcn_readlane(__float_as_int(mygate), i * 4 + k));
            f32x4 y[4];
#pragma unroll
            for (int j = 0; j < 4; ++j) y[j] = (f32x4){0.f, 0.f, 0.f, 0.f};
#pragma unroll
            for (int k = 0; k < 4; ++k)
#pragma unroll
                for (int q = 0; q < 4; ++q) { const int w = (int)yw[sl][k][q];
                    const f32x2 lo = __builtin_amdgcn_cvt_pk_f32_fp8(w, false), hh = __builtin_amdgcn_cvt_pk_f32_fp8(w, true);
                    y[q] += (f32x4){lo.x, lo.y, hh.x, hh.y} * gk[k]; }
            float ss = 0.f;
#pragma unroll
            for (int j = 0; j < 4; ++j) ss += (y[j].x * y[j].x + y[j].y * y[j].y) + (y[j].z * y[j].z + y[j].w * y[j].w);
            const float rs = rsqrtf(wave_sum(ss) * (1.0f / 1024.0f) + EPS);
            f32x4* orow = (f32x4*)(dstp + (size_t)row * 1024) + 4 * lane; const LAS f32x4* a9 = (const LAS f32x4*)(A9 + 16 * lane);
#pragma unroll
            for (int q = 0; q < 4; ++q) orow[q] = xw[sl][q] + a9[q] * (y[q] * rs);
        }
#undef P10_ISSUE
    }
}

#ifndef MLSTM_FUSED
#define MLSTM_FUSED 0
#endif
__device__ __forceinline__ void mlstm_fused(Frame& F, int b, int h, int eh) {
    const int tid = F.tid, lane = F.lane, r32 = lane & 31, hi = lane >> 5, wid = F.wave;
    LAS bf16* Qs = (LAS bf16*)F.lds;
    LAS bf16* Qp = Qs + 64 * QS_STRIDE;
    LAS bf16* Ks = Qp + 64 * QS_STRIDE;
    LAS bf16* KT = Ks + 64 * QS_STRIDE;
    LAS bf16* VT = KT + 128 * KT_STRIDE;
    LAS bf16* VwT = VT + 64 * KT_STRIDE;
    LAS bf16* CT = VwT + 64 * KT_STRIDE;
    LAS bf16* Wm = CT + 64 * QS_STRIDE;
    LAS float* fu = (LAS float*)(Wm + 64 * KT_STRIDE);
    LAS float* fmm = fu + 64; LAS float* fiw = fu + 128; LAS float* ffl = fu + 192; LAS float* frd = fu + 256; LAS float* fwx = fu + 320; LAS float* fnp = fu + 384; LAS float* ms = fu + 512;
    const bf16* Z = (const bf16*)(F.ws + WS_Z);
    bf16* Y = (bf16*)(F.ws + WS_YMIX);
    const int e0 = eh * 64;
    for (int i = tid; i < 64 * QS_STRIDE; i += NTHR) CT[i] = 0;
    if (tid < 128) fnp[tid] = 0.f;
    if (tid == 0) ms[0] = -INFINITY;
    f32x16 st = {};
    ConvRaw rq[2], rk[2]; bf16x8 rv; unsigned short og[16]; unsigned short gi_raw = 0, gf_raw = 0;
#define MF_PREFETCH(c_) do { \
        _Pragma("unroll") for (int rep = 0; rep < 2; ++rep) { const int task = tid + NTHR * rep, l = task >> 4, ch = task & 15, t = (c_) * 64 + l; \
            conv8_load(F, b, t, ZC_QM + h * 128 + ch * 8, rq[rep]); conv8_load(F, b, t, ZC_KM + h * 128 + ch * 8, rk[rep]); } \
        { const int l = tid >> 3, chv = tid & 7; rv = *(const bf16x8*)(Z + (size_t)(b * SEQ + (c_) * 64 + l) * ZP + ZC_VM + h * 128 + e0 + chv * 8); } \
        if (wid < 4) { _Pragma("unroll") for (int r = 0; r < 16; ++r) { const int l = (wid & 1) * 32 + crow(r, hi); og[r] = Z[(size_t)(b * SEQ + (c_) * 64 + l) * ZP + ZC_OM + h * 128 + e0 + (wid >> 1) * 32 + r32]; } } \
        if (wid == 0) { const size_t zr_ = (size_t)(b * SEQ + (c_) * 64 + lane) * ZP; gi_raw = Z[zr_ + ZC_IG + h]; gf_raw = Z[zr_ + ZC_FG + h]; } } while (0)
    MF_PREFETCH(0);
    __syncthreads();
    for (int c = 0; c < 64; ++c) {
        if (wid == 0) {
            const float ig = bf2f(gi_raw) + F.in[9][h]; float g = logsigmoidf_(bf2f(gf_raw) + F.in[9][4 + h]);
#pragma unroll
            for (int o = 1; o < 64; o <<= 1) { const float t = __shfl_up(g, o); if (lane >= o) g += t; }
            const float u = ig - g; float pm = u;
#pragma unroll
            for (int o = 1; o < 64; o <<= 1) { const float t = __shfl_up(pm, o); if (lane >= o) pm = fmaxf(pm, t); }
            const float G = __shfl(g, 63), wl = G - g + ig, ml = wave_max(wl);
            const float m_old = ms[0], mm = fmaxf(m_old, pm), m_new = fmaxf(G + m_old, ml);
            fu[lane] = u; fmm[lane] = mm; fiw[lane] = __expf(m_old - mm); ffl[lane] = __expf(-(g + mm)); fwx[lane] = __expf(wl - m_new);
            if (lane == 0) { ms[1] = __expf(G + m_old - m_new); ms[2] = m_new; }
        }
        __syncthreads();
#pragma unroll
        for (int rep = 0; rep < 2; ++rep) { const int task = tid + NTHR * rep, l = task >> 4, ch = task & 15;
            float qq[8], kk[8];
            conv8_calc(F, rq[rep], h * 128 + ch * 8, qq); conv8_calc(F, rk[rep], 512 + h * 128 + ch * 8, kk);
            const float iw = fiw[l], sk = 0.08838834764831845f;
            u32x4 wq, wp, wk;
            wq.x = pk2(qq[0], qq[1]); wq.y = pk2(qq[2], qq[3]); wq.z = pk2(qq[4], qq[5]); wq.w = pk2(qq[6], qq[7]);
            wp.x = pk2(qq[0] * iw, qq[1] * iw); wp.y = pk2(qq[2] * iw, qq[3] * iw); wp.z = pk2(qq[4] * iw, qq[5] * iw); wp.w = pk2(qq[6] * iw, qq[7] * iw);
            wk.x = pk2(kk[0] * sk, kk[1] * sk); wk.y = pk2(kk[2] * sk, kk[3] * sk); wk.z = pk2(kk[4] * sk, kk[5] * sk); wk.w = pk2(kk[6] * sk, kk[7] * sk);
            *(LAS u32x4*)(Qs + l * QS_STRIDE + ch * 8) = wq; *(LAS u32x4*)(Qp + l * QS_STRIDE + ch * 8) = wp; *(LAS u32x4*)(Ks + l * QS_STRIDE + ch * 8) = wk;
#pragma unroll
            for (int j = 0; j < 8; ++j) KT[(ch * 8 + j) * KT_STRIDE + l] = (bf16)f2bf(kk[j] * sk); }
        { const int l = tid >> 3, chv = tid & 7; const float we = fwx[l];
#pragma unroll
            for (int j = 0; j < 8; ++j) { VT[(chv * 8 + j) * KT_STRIDE + l] = (bf16)rv[j]; VwT[(chv * 8 + j) * KT_STRIDE + l] = (bf16)f2bf(bf2f((unsigned short)rv[j]) * we); } }
        unsigned short ogc[16];
#pragma unroll
        for (int r = 0; r < 16; ++r) ogc[r] = og[r];
        if (c + 1 < 64) MF_PREFETCH(c + 1);
        __syncthreads();
        if (wid < 4) {
            const int lt = wid >> 1, stl = wid & 1;
            f32x16 acc = {}; acc = mma32_lds(Qs + lt * 32 * QS_STRIDE, QS_STRIDE, Ks + stl * 32 * QS_STRIDE, QS_STRIDE, 8, r32, hi, acc);
            const int s_ = stl * 32 + r32; const float us = fu[s_];
#pragma unroll
            for (int r = 0; r < 16; ++r) { const int l = lt * 32 + crow(r, hi); const float w = (s_ <= l) ? __expf(us - fmm[l]) * acc[r] : 0.f; Wm[l * KT_STRIDE + s_] = (bf16)f2bf(w); }
        }
        __syncthreads();
        if (tid < 64) { float dsum = 0.f;
#pragma unroll 8
            for (int s_ = 0; s_ < 64; ++s_) dsum += bf2f(Wm[tid * KT_STRIDE + s_]);
#pragma unroll 8
            for (int d = 0; d < 128; ++d) dsum += bf2f(Qp[tid * QS_STRIDE + d]) * fnp[d];
            frd[tid] = 1.0f / fmaxf(fabsf(dsum), ffl[tid]); }
        f32x16 num = {};
        if (wid < 4) { const int lt = wid & 1, et = wid >> 1;
            num = mma32_lds(Wm + lt * 32 * KT_STRIDE, KT_STRIDE, VT + et * 32 * KT_STRIDE, KT_STRIDE, 4, r32, hi, num);
            num = mma32_lds(Qp + lt * 32 * QS_STRIDE, QS_STRIDE, CT + et * 32 * QS_STRIDE, QS_STRIDE, 8, r32, hi, num); }
        { const float a = ms[1];
#pragma unroll
            for (int r = 0; r < 16; ++r) st[r] *= a;
            st = mma32_lds(VwT + (wid & 1) * 32 * KT_STRIDE, KT_STRIDE, KT + (wid >> 1) * 32 * KT_STRIDE, KT_STRIDE, 4, r32, hi, st); }
        __syncthreads();
        if (wid < 4) { const int lt = wid & 1, et = wid >> 1, e = e0 + et * 32 + r32;
#pragma unroll
            for (int r = 0; r < 16; ++r) { const int l = lt * 32 + crow(r, hi); const size_t row = (size_t)(b * SEQ + c * 64 + l);
                Y[row * 1024 + h * 128 + e] = (bf16)f2bf(num[r] * frd[l] * sigmoidf_(bf2f(ogc[r]))); } }
#pragma unroll
        for (int r = 0; r < 16; ++r) CT[((wid & 1) * 32 + crow(r, hi)) * QS_STRIDE + (wid >> 1) * 32 + r32] = (bf16)f2bf(st[r]);
        if (tid >= 256 && tid < 384) { const int d = tid - 256; float s_ = 0.f;
#pragma unroll 8
            for (int l = 0; l < 64; ++l) s_ += fwx[l] * bf2f(KT[d * KT_STRIDE + l]);
            fnp[d] = ms[1] * fnp[d] + s_; }
        __syncthreads();
        if (tid == 0) ms[0] = ms[2];
    }
    __syncthreads();
#undef MF_PREFETCH
}

__device__ __forceinline__ void ph2_zgemm(Frame& F) {
    unsigned char* ws = F.ws;
    pg8::StaticSched S; S.init(M, ZP, 1024, F.G, (int)blockIdx.x);
    pg8::EpiBf16 E{(bf16*)(ws + WS_Z), ZP, nullptr, 0};
    pg8::gemm_phase<false>(F.lds, (const bf16*)(ws + WS_H), (const bf16*)(ws + WS_WIN), 1024, S, E);
}
__device__ __forceinline__ void ph3_local(Frame& F) {
    for (int wi = F.vcu; wi < 256; wi += F.G) p3_compress_item(F, wi);
#if !MLSTM_FUSED
    p3_mlstm_a_items(F);
#endif
}
#ifndef ATT_PROBE
#define ATT_PROBE -1
#endif
constexpr int CW_AQ = 20480;
__device__ __forceinline__ void ph4_scan_attn(Frame& F) {
#if MLSTM_FUSED
    if (F.vcu < 32) mlstm_fused(F, F.vcu >> 3, (F.vcu >> 1) & 3, F.vcu & 1);
    volatile LAS unsigned* qslot = (volatile LAS unsigned*)(F.lds + LDSCTL_OFF + 512);
    for (;;) {
        __syncthreads();
        if (F.tid == 0) qslot[0] = __hip_atomic_fetch_add(F.ctl + CW_AQ, 1u, RLX_AGENT);
        __syncthreads();
        const int q = (int)qslot[0];
        if (q >= 512) break;
        const int cur = 63 - (q >> 3), bg = q & 7;
        nsa::attn_unit<0>(F, bg >> 1, bg & 1, cur, (bf16*)(F.ws + WS_YMIX), true);
    }
#else
    p4_scan(F); __syncthreads();
    if (ATT_PROBE >= 0) { nsa::p4_attention<(ATT_PROBE < 0 ? 0 : ATT_PROBE)>(F, (bf16*)(F.ws + WS_ACT)); __syncthreads(); }
    nsa::p4_attention<0>(F, (bf16*)(F.ws + WS_YMIX));
#endif
}
__device__ __forceinline__ void ph5_mlstm_out(Frame& F) {
#if !MLSTM_FUSED
    p5_mlstm_c_items(F);
#endif
}
__device__ __forceinline__ void ph6_wout(Frame& F) {
    unsigned char* ws = F.ws;
    pg8::StaticSched S; S.init(M, 1024, 1024, F.G, (int)blockIdx.x);
    pg8::EpiBf16 E{(bf16*)(ws + WS_Y), 1024, nullptr, 0};
    pg8::gemm_phase<false>(F.lds, (const bf16*)(ws + WS_YMIX), (const bf16*)(ws + WS_WOUT), 1024, S, E);
}
__device__ __forceinline__ void ph8_up(Frame& F) {
    unsigned char* ws = F.ws;
    const MoeTabs T = moe_tabs(F); const int NT = moe_build_tabs(F, T);
    const int* rowtok = (const int*)(ws + WS_ROWTOK);
    for (int i = 0; i < MAXU; ++i) { const int L = i * F.G + F.vcu; if (L >= NT * 8) break; const int t = L >> 3, e = T.tile_e[t], r0 = T.tile_r0[t];
        for (int r = F.tid; r < 256; r += NTHR) { const int gi = r0 + r; T.idx[i * 256 + r] = gi < T.cnt[e] ? rowtok[(size_t)e * ECAP + gi] : 0; } }
    __syncthreads();
    MoeUpSched S{NT, F.G, F.vcu, T.tile_e, T.idx};
    pg8::EpiSwiglu E{(unsigned char*)(ws + WS_ACT), F.in[20]};
    pg8::gemm_phase<true>(F.lds, (const bf16*)(ws + WS_H), (const bf16*)(ws + WS_WUP), 512, S, E);
}
__device__ __forceinline__ void ph9_down(Frame& F) {
    unsigned char* ws = F.ws;
    const MoeTabs T = moe_tabs(F); const int NT = moe_build_tabs(F, T);
    MoeDownSched S{NT, F.G, F.vcu, T.tile_e};
    pg8::EpiFp8 E{ws + WS_YB, 1024, F.in[22], 1024, YB_SCALE};
    pg8::gemm_phase<true>(F.lds, (const bf16*)(ws + WS_ACT), (const bf16*)(ws + WS_WDN), 512, S, E);
}

constexpr int N_PHASES = 11;
struct Args { const float* in[23]; float* out; unsigned char* ws; int ph_lo, ph_hi; };
__global__ void __launch_bounds__(NTHR, 2) hybrid_fwd(Args args) {
    extern __shared__ __attribute__((aligned(16))) unsigned char lds_raw[];
    Frame F;
    F.lds = (LAS unsigned char*)lds_raw;
    F.tid = threadIdx.x; F.lane = F.tid & 63; F.wave = __builtin_amdgcn_readfirstlane(F.tid >> 6);
    F.G = gridDim.x; { const int bx = blockIdx.x; F.vcu = (F.G % 8 == 0) ? (bx % 8) * (F.G / 8) + bx / 8 : bx; }
    F.ws = args.ws; F.ctl = (unsigned*)(args.ws + WS_CTL); F.out = args.out;
    F.in = (const float* const __attribute__((address_space(4)))*)__builtin_amdgcn_kernarg_segment_ptr();
    for (int u = F.tid; u < (LDS_BYTES - LDSCTL_OFF) / 4; u += NTHR) ((LAS unsigned*)(F.lds + LDSCTL_OFF))[u] = 0u;
    __syncthreads();
    volatile LAS unsigned* MISC = (volatile LAS unsigned*)(F.lds + MISC_OFF);
    XcdBarrier bar; bar.bar = F.ctl + CW_BAR; bar.x = 0; bar.st = nullptr;
    if (!MK_PER_PHASE) bar = xcd_barrier_post(F.ctl + CW_BAR, MISC + 8);
    const int lo = args.ph_lo, hi = args.ph_hi;
#ifndef PH_MASK
#define PH_MASK 0x7ff
#endif
#define IN(k) (((PH_MASK >> (k)) & 1) && lo <= (k) && (k) < hi)
#define SEAM(k) do { if (IN(k) && IN((k) + 1)) xcd_barrier(bar); } while (0)
#ifndef PH_TWICE
#define PH_TWICE 0
#endif
#define RUNPH(k, call) do { if (IN(k)) { call; if ((PH_TWICE >> (k)) & 1) { xcd_barrier(bar); call; } } } while (0)
    RUNPH(0, p0_prologue(F)); SEAM(0);
    RUNPH(1, p1_rows(F)); SEAM(1);
    RUNPH(2, ph2_zgemm(F)); SEAM(2);
    RUNPH(3, ph3_local(F)); SEAM(3);
    RUNPH(4, ph4_scan_attn(F));
#if !MLSTM_FUSED
    SEAM(4);
#endif
    RUNPH(5, ph5_mlstm_out(F)); SEAM(5);
    RUNPH(6, ph6_wout(F)); SEAM(6);
    RUNPH(7, p7_rows(F)); SEAM(7);
    RUNPH(8, ph8_up(F)); SEAM(8);
    RUNPH(9, ph9_down(F)); SEAM(9);
#ifdef P10_TWICE
    if (IN(10)) { p11_final(F, (float*)(F.ws + WS_DC)); xcd_barrier(bar); }
#endif
    RUNPH(10, p11_final(F, F.out));
#ifdef EXTRA_BARS
#pragma unroll 1
    for (int eb = 0; eb < EXTRA_BARS; ++eb) xcd_barrier(bar);
#endif
#undef RUNPH
#undef IN
#undef SEAM
}

extern "C" void kernel_launch(void* const* d_in, const int* in_sizes, int n_in, void* d_out, int out_size, void* d_ws, size_t ws_size, hipStream_t stream) {
    static int grid = 0;
    if (grid == 0) {
        if (n_in != 23 || out_size != M * D || ws_size < WS_END) { fprintf(stderr, "kernel_launch: unexpected shapes (n_in %d out %d ws %zu)\n", n_in, out_size, ws_size); grid = -1; return; }
        int dev = 0, cus = 0;
        if (hipGetDevice(&dev) != hipSuccess || hipDeviceGetAttribute(&cus, hipDeviceAttributeMultiprocessorCount, dev) != hipSuccess) { grid = -1; return; }
        if (hipFuncSetAttribute((const void*)hybrid_fwd, hipFuncAttributeMaxDynamicSharedMemorySize, LDS_BYTES) != hipSuccess) { fprintf(stderr, "kernel_launch: hipFuncSetAttribute failed\n"); grid = -1; return; }
        int per_cu = 0;
        if (hipOccupancyMaxActiveBlocksPerMultiprocessor(&per_cu, (const void*)hybrid_fwd, NTHR, LDS_BYTES) != hipSuccess || per_cu < 1) fprintf(stderr, "kernel_launch: occupancy query reports %d\n", per_cu);
        (void)hipGetLastError();
        grid = cus > 256 ? 256 : cus;
    }
    if (grid < 0) return;
    (void)hipMemsetAsync((char*)d_ws + WS_CTL, 0, CTL_ZERO_BYTES, stream);
    Args a{};
    for (int i = 0; i < 23; ++i) a.in[i] = (const float*)d_in[i];
    a.out = (float*)d_out; a.ws = (unsigned char*)d_ws;
#if MK_PER_PHASE
    for (int p = 0; p < N_PHASES; ++p) { a.ph_lo = p; a.ph_hi = p + 1; hipLaunchKernelGGL(hybrid_fwd, dim3(grid), dim3(NTHR), LDS_BYTES, stream, a); }
#else
    a.ph_lo = 0; a.ph_hi = N_PHASES;
    hipLaunchKernelGGL(hybrid_fwd, dim3(grid), dim3(NTHR), LDS_BYTES, stream, a);
#endif
}
```

```cpp
#include <hip/hip_runtime.h>
#include <cstdio>
#include <cstdint>
#include <cmath>

#define GAS __attribute__((address_space(1)))
#define LAS __attribute__((address_space(3)))
typedef unsigned short bf16;
typedef short bf16x8 __attribute__((ext_vector_type(8)));
typedef short s16x4 __attribute__((ext_vector_type(4)));
typedef float f32x4 __attribute__((ext_vector_type(4)));
typedef float f32x2 __attribute__((ext_vector_type(2)));
typedef float f32x16 __attribute__((ext_vector_type(16)));
typedef unsigned u32x4 __attribute__((ext_vector_type(4)));
typedef unsigned u32x2 __attribute__((ext_vector_type(2)));

#ifndef MK_PER_PHASE
#define MK_PER_PHASE 0
#endif

constexpr int BATCH = 4, SEQ = 4096, D = 1024, M = BATCH * SEQ;
constexpr int D_IN = 3360, ZP = 3584;
constexpr int ZC_QM = 0, ZC_KM = 512, ZC_VM = 1024, ZC_OM = 1536, ZC_QA = 2048, ZC_KC = 2560, ZC_VC = 2688, ZC_KS = 2816, ZC_VS = 2944,
              ZC_KW = 3072, ZC_VW = 3200, ZC_IG = 3328, ZC_FG = 3332, ZC_GA = 3336;
constexpr int NEXP = 32, TOPK = 4, ECAP = 16384, MAXT = 288;
constexpr float EPS = 1e-6f;
constexpr int NWAVES = 8, NTHR = 512;

constexpr size_t MiB = 1u << 20;
constexpr size_t WS_CTL = 0, CTL_ZERO_BYTES = 1 * MiB;
constexpr size_t WS_MODP = 1 * MiB;
constexpr size_t WS_MODF = 2 * MiB;
constexpr size_t WS_CMPB = 2 * MiB + 128 * 1024;
constexpr size_t WS_WCMP = 3 * MiB;
constexpr size_t WS_WIN = 4 * MiB;
constexpr size_t WS_WOUT = 12 * MiB;
constexpr size_t WS_WRT = 14 * MiB;
constexpr size_t WS_WUP = 16 * MiB;
constexpr size_t WS_WDN = 144 * MiB;
constexpr size_t WS_H = 208 * MiB;
constexpr size_t WS_Z = 240 * MiB;
constexpr size_t WS_YMIX = 352 * MiB;
constexpr size_t WS_Y = 384 * MiB;
constexpr size_t WS_DC = 416 * MiB;
constexpr size_t WS_DN = 480 * MiB;
constexpr size_t WS_SC = 481 * MiB;
constexpr size_t WS_KC = 482 * MiB;
constexpr size_t WS_VC = 483 * MiB;
constexpr size_t WS_ACT = 484 * MiB;
constexpr size_t WS_YB = 628 * MiB;
constexpr float YB_SCALE = 8.0f;
constexpr size_t WS_TOKE = 772 * MiB;
constexpr size_t WS_TOKR = 772 * MiB + 256 * 1024;
constexpr size_t WS_TOKG = 772 * MiB + 512 * 1024;
constexpr size_t WS_ROWTOK = 774 * MiB;
constexpr size_t WS_CP = 776 * MiB;
constexpr size_t WS_NP = 840 * MiB;
constexpr size_t WS_END = 841 * MiB;
constexpr int CW_TMO = 0, CW_BAR = 4096, CW_CNT = 16384;

constexpr int RING_BYTES = 131072;
constexpr int LDSCTL_OFF = RING_BYTES, MISC_OFF = LDSCTL_OFF + 320;
constexpr int TAB_OFF = LDSCTL_OFF + 1024;
constexpr int LDS_BYTES = 163840;

#define RLX_AGENT __ATOMIC_RELAXED, __HIP_MEMORY_SCOPE_AGENT
__device__ __forceinline__ float bf2f(unsigned v) { return __uint_as_float(v << 16); }
__device__ __forceinline__ unsigned f2bf(float f) { unsigned u = __float_as_uint(f); return (u + 0x7fffu + ((u >> 16) & 1u)) >> 16; }
__device__ __forceinline__ unsigned pk2(float lo, float hi) { unsigned r; asm volatile("v_cvt_pk_bf16_f32 %0, %1, %2" : "=v"(r) : "v"(lo), "v"(hi)); return r; }
__device__ __forceinline__ unsigned pk4_fp8(float a, float b, float c, float d) { int w = 0; w = __builtin_amdgcn_cvt_pk_fp8_f32(a, b, w, false); w = __builtin_amdgcn_cvt_pk_fp8_f32(c, d, w, true); return (unsigned)w; }
template <int MASK> __device__ __forceinline__ float xchg_f(float x, int lane) {
    if constexpr (MASK == 1) return __int_as_float(__builtin_amdgcn_mov_dpp(__float_as_int(x), 0xB1, 0xF, 0xF, true));
    else if constexpr (MASK == 2) return __int_as_float(__builtin_amdgcn_mov_dpp(__float_as_int(x), 0x4E, 0xF, 0xF, true));
    else if constexpr (MASK == 32) { auto rr = __builtin_amdgcn_permlane32_swap(__float_as_uint(x), __float_as_uint(x), false, false); return __uint_as_float((lane >> 5) ? rr[0] : rr[1]); }
    else return __shfl_xor(x, MASK);
}
template <int MASK> __device__ __forceinline__ int xchg_i(int x, int lane) { return __float_as_int(xchg_f<MASK>(__int_as_float(x), lane)); }
__device__ __forceinline__ float wave_sum(float v) {
    const int lane = threadIdx.x & 63;
    v += xchg_f<1>(v, lane); v += xchg_f<2>(v, lane); v += xchg_f<4>(v, lane); v += xchg_f<8>(v, lane); v += xchg_f<16>(v, lane); v += xchg_f<32>(v, lane);
    return v;
}
__device__ __forceinline__ float wave_max(float v) {
#pragma unroll
    for (int o = 1; o < 64; o <<= 1) v = fmaxf(v, __shfl_xor(v, o));
    return v;
}
__device__ __forceinline__ float sigmoidf_(float x) { return __builtin_amdgcn_rcpf(1.0f + __builtin_amdgcn_exp2f(-1.4426950408889634f * x)); }
__device__ __forceinline__ float siluf_(float x) { return x * sigmoidf_(x); }
__device__ __forceinline__ float logsigmoidf_(float x) { return fminf(x, 0.f) - log1pf(__expf(-fabsf(x))); }
__device__ __forceinline__ int crow(int r, int hi) { return (r & 3) + 8 * (r >> 2) + 4 * hi; }

__device__ __constant__ unsigned char T5B[128] = {0, 1, 2, 3, 4, 5, 6, 7, 8, 9, 10, 11, 12, 13, 14, 15, 16, 16, 16, 17, 17, 18, 18, 18, 19, 19, 19, 20, 20, 20, 20, 21, 21, 21, 21, 22, 22, 22, 22, 22, 23, 23, 23, 23, 23, 23, 24, 24, 24, 24, 24, 24, 25, 25, 25, 25, 25, 25, 25, 26, 26, 26, 26, 26, 26, 26, 26, 27, 27, 27, 27, 27, 27, 27, 27, 27, 27, 28, 28, 28, 28, 28, 28, 28, 28, 28, 28, 29, 29, 29, 29, 29, 29, 29, 29, 29, 29, 29, 29, 30, 30, 30, 30, 30, 30, 30, 30, 30, 30, 30, 30, 30, 30, 31, 31, 31, 31, 31, 31, 31, 31, 31, 31, 31, 31, 31, 31, 31};

namespace pg8 {
typedef int v8i32 __attribute__((ext_vector_type(8)));
typedef int v4i32 __attribute__((ext_vector_type(4)));
constexpr int BM = 256, BK = 64, HALF = 128, HTB = HALF * BK * 2, STAGE_BYTES = 8 * HTB, NXCD = 8, WGM = 8;
__host__ __device__ __forceinline__ int lds_byte(int r, int c) { const int st = (r >> 4) * 2 + (c >> 5), rr = r & 15, cc = c & 31, ob = rr * 64 + cc * 2; return st * 1024 + (ob ^ (((ob >> 9) & 1) << 5)); }
__host__ __device__ __forceinline__ void stage_rc(int b, int& R, int& C) { const int st = b / 1024, sb = b % 1024, swz = sb ^ (((sb >> 9) & 1) << 5); R = (st >> 1) * 16 + swz / 64; C = (st & 1) * 32 + (swz % 64) / 2; }
__host__ __device__ __forceinline__ int perm32(int rho) { const int n = rho >> 4, i = rho & 15; return 8 * (i >> 2) + 4 * n + (i & 3); }

__device__ __forceinline__ void glds16_s(const char* sbase, unsigned voff, unsigned lds_dst) { unsigned keep;
    asm volatile("s_mov_b32 %0, m0\n\ts_mov_b32 m0, %3\n\ts_nop 0\n\tglobal_load_lds_dwordx4 %1, %2\n\ts_mov_b32 m0, %0" : "=&s"(keep) : "v"(voff), "s"(sbase), "s"(lds_dst) : "memory"); }
__device__ __forceinline__ const char* uniform_ptr(const char* p) { const unsigned long long v = (unsigned long long)p;
    return (const char*)(((unsigned long long)(unsigned)__builtin_amdgcn_readfirstlane((int)(v >> 32)) << 32) | (unsigned)__builtin_amdgcn_readfirstlane((int)v)); }
struct Unit { int pm, pn, e, ui; };

struct StaticSched {
    int nM, nN, nwg, G, c, K;
    __device__ void init(int M_, int N_, int K_, int G_, int c_) { nM = M_ / BM; nN = N_ / BM; nwg = nM * nN; G = G_; c = c_; K = K_; }
    __device__ __forceinline__ bool next(int i, Unit& u) const {
        const long L = (long)i * G + c; if (L >= nwg) return false;
        int wgid = (int)L; { const int q = nwg / NXCD, r = nwg % NXCD, xcd = wgid % NXCD, off = wgid / NXCD; wgid = (xcd < r ? xcd * (q + 1) : r * (q + 1) + (xcd - r) * q) + off; }
        const int nig = WGM * nN, gid = wgid / nig, fm = gid * WGM, gsz = (nM - fm) < WGM ? (nM - fm) : WGM;
        u.pm = fm + ((wgid % nig) % gsz); u.pn = (wgid % nig) / gsz; u.e = 0; u.ui = i; return true;
    }
    __device__ __forceinline__ unsigned arow(const Unit& u, int r) const { return (unsigned)(u.pm * BM + r); }
    __device__ __forceinline__ size_t boff(const Unit& u) const { return (size_t)u.pn * BM * K * 2; }
};

struct EpiBf16 {
    bf16* O; int ldc; const float* bias; int bstride;
    __device__ __forceinline__ void operator()(const f32x4 (&acc)[2][2][4][2], const Unit& u, int wr, int wc, int fr, int fq) const {
        const int row0 = u.pm * BM + wr * 64 + fr; const int col0 = u.pn * BM + wc * 32 + 8 * fq;
#pragma unroll
        for (int bj = 0; bj < 2; ++bj) {
            f32x4 bv0 = (f32x4){0.f, 0.f, 0.f, 0.f}, bv1 = bv0;
            if (bias) { bv0 = *(const f32x4*)(bias + (size_t)u.e * bstride + col0 + bj * HALF); bv1 = *(const f32x4*)(bias + (size_t)u.e * bstride + col0 + bj * HALF + 4); }
#pragma unroll
            for (int ai = 0; ai < 2; ++ai)
#pragma unroll
                for (int m = 0; m < 4; ++m) { bf16* rowp = O + (size_t)(row0 + ai * HALF + m * 16) * ldc + col0;
                    const f32x4 v0 = acc[ai][bj][m][0] + bv0, v1 = acc[ai][bj][m][1] + bv1;
                    u32x4 w; w.x = pk2(v0[0], v0[1]); w.y = pk2(v0[2], v0[3]); w.z = pk2(v1[0], v1[1]); w.w = pk2(v1[2], v1[3]);
                    *(u32x4*)(rowp + bj * HALF) = w; } }
    }
};
struct EpiFp8 {
    unsigned char* O; int ldc; const float* bias; int bstride; float scale;
    __device__ __forceinline__ void operator()(const f32x4 (&acc)[2][2][4][2], const Unit& u, int wr, int wc, int fr, int fq) const {
        const int row0 = u.pm * BM + wr * 64 + fr; const int col0 = u.pn * BM + wc * 32 + 8 * fq;
#pragma unroll
        for (int bj = 0; bj < 2; ++bj) {
            const f32x4 bv0 = *(const f32x4*)(bias + (size_t)u.e * bstride + col0 + bj * HALF), bv1 = *(const f32x4*)(bias + (size_t)u.e * bstride + col0 + bj * HALF + 4);
#pragma unroll
            for (int ai = 0; ai < 2; ++ai)
#pragma unroll
                for (int m = 0; m < 4; ++m) { unsigned char* rowp = O + (size_t)(row0 + ai * HALF + m * 16) * ldc + col0;
                    const f32x4 v0 = (acc[ai][bj][m][0] + bv0) * scale, v1 = (acc[ai][bj][m][1] + bv1) * scale;
                    u32x2 w; w.x = pk4_fp8(v0[0], v0[1], v0[2], v0[3]); w.y = pk4_fp8(v1[0], v1[1], v1[2], v1[3]);
                    *(u32x2*)(rowp + bj * HALF) = w; } }
    }
};
struct EpiSwiglu {
    unsigned char* O; const float* bup;
    __device__ __forceinline__ void operator()(const f32x4 (&acc)[2][2][4][2], const Unit& u, int wr, int wc, int fr, int fq) const {
        const int row0 = u.pm * BM + wr * 64 + fr; const int c0 = u.pn * HALF + wc * 32 + 8 * fq;
        const float* bg = bup + (size_t)u.e * 2048 + c0; const float* bl = bg + 1024;
        const f32x4 g0 = *(const f32x4*)bg, g1 = *(const f32x4*)(bg + 4), l0 = *(const f32x4*)bl, l1 = *(const f32x4*)(bl + 4);
#pragma unroll
        for (int ai = 0; ai < 2; ++ai)
#pragma unroll
            for (int m = 0; m < 4; ++m) { unsigned char* rowp = O + (size_t)(row0 + ai * HALF + m * 16) * 1024 + c0;
                float a[8];
#pragma unroll
                for (int n = 0; n < 2; ++n) { const f32x4 gv = acc[ai][0][m][n] + (n ? g1 : g0), lv = acc[ai][1][m][n] + (n ? l1 : l0);
#pragma unroll
                    for (int j2 = 0; j2 < 2; ++j2) {
                        f32x2 gl = {fminf(gv[2 * j2], 7.0f), fminf(gv[2 * j2 + 1], 7.0f)};
                        f32x2 li = {__builtin_amdgcn_fmed3f(lv[2 * j2], -7.0f, 7.0f), __builtin_amdgcn_fmed3f(lv[2 * j2 + 1], -7.0f, 7.0f)};
                        const f32x2 ea = gl * (-1.702f * 1.4426950408889634f);
                        f32x2 d = {__builtin_amdgcn_exp2f(ea.x), __builtin_amdgcn_exp2f(ea.y)}; d = d + 1.0f;
                        const f32x2 r = {__builtin_amdgcn_rcpf(d.x), __builtin_amdgcn_rcpf(d.y)};
                        const f32x2 t = gl * r, o = __builtin_elementwise_fma(t, li, t);
                        a[n * 4 + 2 * j2] = o.x; a[n * 4 + 2 * j2 + 1] = o.y; } }
                u32x2 w; w.x = pk4_fp8(a[0], a[1], a[2], a[3]); w.y = pk4_fp8(a[4], a[5], a[6], a[7]);
                *(u32x2*)rowp = w; }
    }
};

template <bool FP8, class Epi, class Sched>
__device__ __forceinline__ void gemm_phase(LAS unsigned char* lds, const bf16* Abase, const bf16* Bbase, const int K, const Sched& S, const Epi& E) {
    const int tid = threadIdx.x, wid = __builtin_amdgcn_readfirstlane(tid >> 6), lane = tid & 63, wr = wid >> 2, wc = wid & 3, fr = lane & 15, fq = lane >> 4;
    const int nt = K / BK;
    unsigned voffB[2];
#pragma unroll
    for (int i = 0; i < 2; ++i) { int R, C; stage_rc(tid * 16 + i * 8192, R, C); const int Rb = (R & ~31) + perm32(R & 31); voffB[i] = (unsigned)(Rb * K + C) * 2u; }
    const size_t kstep = (size_t)(BK * 2);
    const size_t hstepB = (size_t)HALF * K * 2;
    const unsigned rowB = (unsigned)K * 2u;
    const unsigned ldsb = (unsigned)__builtin_amdgcn_readfirstlane((int)((unsigned)(unsigned long long)lds + (unsigned)wid * 1024u));
    const int aoff = lds_byte(wr * 64 + fr, fq * 8), boff = lds_byte(wc * 32 + fr, fq * 8);
#define PG8_SA(b, h) (((b) * 2 + (h)) * HTB)
#define PG8_SB(b, h) ((4 + (b) * 2 + (h)) * HTB)
#define PG8_STAGE(bufoff, gbase, voff) do { _Pragma("unroll") for (int _i = 0; _i < 2; ++_i) glds16_s(gbase, (voff)[_i], ldsb + (unsigned)((bufoff) + _i * 8192)); } while (0)
#define PG8_LD16(off) (*(const LAS v4i32*)(lds + (off)))
#define PG8_LDA(dst, b, h) do { if constexpr (FP8) { _Pragma("unroll") for (int m = 0; m < 4; ++m) dst##8[m] = __builtin_shufflevector(PG8_LD16(PG8_SA(b, h) + aoff + m * 2048), PG8_LD16(PG8_SA(b, h) + aoff + m * 2048 + 1024), 0, 1, 2, 3, 4, 5, 6, 7); } \
        else { _Pragma("unroll") for (int m = 0; m < 4; ++m) _Pragma("unroll") for (int k = 0; k < 2; ++k) dst##4[m][k] = *(const LAS bf16x8*)(lds + PG8_SA(b, h) + aoff + m * 2048 + k * 1024); } } while (0)
#define PG8_LDB(dst, b, h) do { if constexpr (FP8) { _Pragma("unroll") for (int n = 0; n < 2; ++n) dst##8[n] = __builtin_shufflevector(PG8_LD16(PG8_SB(b, h) + boff + n * 2048), PG8_LD16(PG8_SB(b, h) + boff + n * 2048 + 1024), 0, 1, 2, 3, 4, 5, 6, 7); } \
        else { _Pragma("unroll") for (int n = 0; n < 2; ++n) _Pragma("unroll") for (int k = 0; k < 2; ++k) dst##4[n][k] = *(const LAS bf16x8*)(lds + PG8_SB(b, h) + boff + n * 2048 + k * 1024); } } while (0)
#define PG8_MMA(ai, bj, At, Bt) do { __builtin_amdgcn_s_setprio(1); _Pragma("unroll") for (int m = 0; m < 4; ++m) _Pragma("unroll") for (int n = 0; n < 2; ++n) { \
        if constexpr (FP8) { asm volatile("v_mfma_scale_f32_16x16x128_f8f6f4 %0, %1, %2, %0, %3, %4 op_sel_hi:[0,0,0]" : "+v"(acc[ai][bj][m][n]) : "v"(Bt##8[n]), "v"(At##8[m]), "v"(scl), "v"(scl)); } \
        else { _Pragma("unroll") for (int k = 0; k < 2; ++k) acc[ai][bj][m][n] = __builtin_amdgcn_mfma_f32_16x16x32_bf16(Bt##4[n][k], At##4[m][k], acc[ai][bj][m][n], 0, 0, 0); } } \
        __builtin_amdgcn_s_setprio(0); } while (0)
#define PG8_WAIT_V(n) asm volatile("s_waitcnt vmcnt(" #n ")" ::: "memory")
#define PG8_WAIT_L(n) asm volatile("s_waitcnt lgkmcnt(" #n ")" ::: "memory")
#define PG8_BAR __builtin_amdgcn_s_barrier()
#define PG8_SCHED __builtin_amdgcn_sched_barrier(0)
#define PG8_MKVA(dst, u) do { _Pragma("unroll") for (int _i = 0; _i < 2; ++_i) { int R_, C_; stage_rc(tid * 16 + _i * 8192, R_, C_); _Pragma("unroll") for (int _h = 0; _h < 2; ++_h) dst[_h][_i] = S.arow(u, _h * HALF + R_) * rowB + (unsigned)C_ * 2u; } } while (0)
    Unit cur, nxt; int ui = 0;
    if (!S.next(0, cur)) return;
    f32x4 acc[2][2][4][2];
#pragma unroll
    for (int a = 0; a < 2; ++a)
#pragma unroll
        for (int b = 0; b < 2; ++b)
#pragma unroll
            for (int m = 0; m < 4; ++m)
#pragma unroll
                for (int n = 0; n < 2; ++n) acc[a][b][m][n] = (f32x4){0.f, 0.f, 0.f, 0.f};
    v8i32 At8[4], B08[2], B18[2]; bf16x8 At4[4][2], B04[2][2], B14[2][2];
    const unsigned scl = 0x7c7c7c7cu;
    unsigned vc[2][2];
    PG8_MKVA(vc, cur);
    const char* cA = uniform_ptr((const char*)Abase);
    const char* cB = uniform_ptr((const char*)Bbase + S.boff(cur));
    PG8_STAGE(PG8_SB(0, 0), cB, voffB); PG8_STAGE(PG8_SB(0, 1), cB + hstepB, voffB); PG8_STAGE(PG8_SA(0, 0), cA, vc[0]); PG8_STAGE(PG8_SA(0, 1), cA, vc[1]);
    if (wr == 1) PG8_BAR;
    PG8_WAIT_V(2); PG8_BAR;
    PG8_STAGE(PG8_SB(1, 0), cB + kstep, voffB); PG8_STAGE(PG8_SA(1, 0), cA + kstep, vc[0]); PG8_STAGE(PG8_SB(1, 1), cB + hstepB + kstep, voffB);
    PG8_WAIT_V(6); PG8_BAR;
    for (;;) {
        const bool has_next = S.next(ui + 1, nxt);
        const char* nB = uniform_ptr(has_next ? (const char*)Bbase + S.boff(nxt) : cB);
#pragma unroll 1
        for (int t = 0; t < nt; t += 2) {
            const bool last = (t == nt - 2);
            const char* a1 = cA + (size_t)(t + 1) * kstep;
            const char* a2 = last ? cA : cA + (size_t)(t + 2) * kstep; const char* b2 = last ? nB : cB + (size_t)(t + 2) * kstep;
            const char* a3 = a2 + kstep; const char* b3 = b2 + kstep;
            unsigned v2a[2], v2b[2];
#pragma unroll
            for (int i = 0; i < 2; ++i) { v2a[i] = vc[0][i]; v2b[i] = vc[1][i]; }
            if (last && has_next) {
#pragma unroll
                for (int i = 0; i < 2; ++i) { int R_, C_; stage_rc(tid * 16 + i * 8192, R_, C_); v2a[i] = S.arow(nxt, R_) * rowB + (unsigned)C_ * 2u; v2b[i] = S.arow(nxt, HALF + R_) * rowB + (unsigned)C_ * 2u; } }
            PG8_LDB(B0, 0, 0); PG8_LDB(B1, 0, 1); PG8_SCHED; PG8_LDA(At, 0, 0); PG8_STAGE(PG8_SA(1, 1), a1, vc[1]);
            PG8_WAIT_V(8); PG8_WAIT_L(0); PG8_BAR; PG8_MMA(0, 0, At, B0); PG8_MMA(0, 1, At, B1); PG8_BAR; PG8_SCHED;
            PG8_LDA(At, 0, 1); PG8_STAGE(PG8_SB(0, 0), b2, voffB); PG8_STAGE(PG8_SB(0, 1), b2 + hstepB, voffB); PG8_STAGE(PG8_SA(0, 0), a2, v2a);
            PG8_WAIT_V(8); PG8_WAIT_L(0); PG8_BAR; PG8_MMA(1, 0, At, B0); PG8_MMA(1, 1, At, B1); PG8_BAR; PG8_SCHED;
            PG8_LDB(B0, 1, 0); PG8_LDB(B1, 1, 1); PG8_SCHED; PG8_LDA(At, 1, 0); PG8_STAGE(PG8_SA(0, 1), a2, v2b);
            PG8_WAIT_V(8); PG8_WAIT_L(0); PG8_BAR; PG8_MMA(0, 0, At, B0); PG8_MMA(0, 1, At, B1); PG8_BAR; PG8_SCHED;
            PG8_LDA(At, 1, 1); PG8_STAGE(PG8_SB(1, 0), b3, voffB); PG8_STAGE(PG8_SB(1, 1), b3 + hstepB, voffB); PG8_STAGE(PG8_SA(1, 0), a3, v2a);
            PG8_WAIT_V(8); PG8_WAIT_L(0); PG8_BAR; PG8_MMA(1, 0, At, B0); PG8_MMA(1, 1, At, B1); PG8_BAR; PG8_SCHED;
        }
        if (wr == 0) PG8_BAR;
        if constexpr (FP8) asm volatile("s_nop 15\n\ts_nop 15" ::: "memory");
        E(acc, cur, wr, wc, fr, fq);
        if (!has_next) break;
#pragma unroll
        for (int a = 0; a < 2; ++a)
#pragma unroll
            for (int b = 0; b < 2; ++b)
#pragma unroll
                for (int m = 0; m < 4; ++m)
#pragma unroll
                    for (int n = 0; n < 2; ++n) acc[a][b][m][n] = (f32x4){0.f, 0.f, 0.f, 0.f};
        cur = nxt; cB = nB; ++ui;
        PG8_MKVA(vc, cur);
        if (wr == 1) PG8_BAR;
    }
    PG8_WAIT_V(0);
    PG8_BAR;
#undef PG8_SA
#undef PG8_SB
#undef PG8_STAGE
#undef PG8_LDA
#undef PG8_LD16
#undef PG8_LDB
#undef PG8_MMA
#undef PG8_WAIT_V
#undef PG8_WAIT_L
#undef PG8_BAR
#undef PG8_SCHED
#undef PG8_MKVA
}
}

#define XB_TMO      128
#define XB_XCNT(j)  (256  + 64 * (j))
#define XB_XSUB(j)  (1280 + 64 * (j))
#define XB_XGEN(j)  (2304 + 64 * (j))
#define XB_TOP      3328
#define XB_TOPGEN   3392
#define XCD_BAR_WORDS 3456
#define XB_SPIN_CAP (1u << 18)

__device__ __forceinline__ unsigned xb_ld(unsigned* p)              { return __hip_atomic_load(p, __ATOMIC_RELAXED, __HIP_MEMORY_SCOPE_AGENT); }
__device__ __forceinline__ unsigned xb_add(unsigned* p, unsigned v) { return __hip_atomic_fetch_add(p, v, __ATOMIC_RELAXED, __HIP_MEMORY_SCOPE_AGENT); }
__device__ __forceinline__ unsigned xb_xcc_id() { return (unsigned)__builtin_amdgcn_s_getreg((3 << 11) | 20) & 0xFu; }
#define XB_SPIN(cond, bar) do { unsigned _sp = 0; while (cond) { __builtin_amdgcn_s_sleep(1); \
    if ((++_sp & 255u) == 0u) { if (xb_ld(&(bar)[XB_TMO])) break; if (_sp > XB_SPIN_CAP) { atomicAdd(&(bar)[XB_TMO], 1u); break; } } } } while (0)

struct XcdBarrier {
    unsigned* bar; unsigned x;
    volatile LAS unsigned* st;
};
__device__ __forceinline__ XcdBarrier xcd_barrier_post(unsigned* bar, volatile LAS unsigned* st) {
    XcdBarrier b; b.bar = bar; b.x = xb_xcc_id(); b.st = st;
    if (threadIdx.x == 0) (void)xb_add(&bar[XB_XCNT(b.x)], 1u);
    return b;
}
__device__ __forceinline__ void xcd_barrier_complete(unsigned* bar, unsigned x, unsigned& nloc, unsigned& nx) {
    const unsigned G = gridDim.x * gridDim.y * gridDim.z;
    unsigned sum, cnt, mine, sp = 0u;
    for (;;) {
        sum = 0u; cnt = 0u; mine = 0u;
#pragma unroll
        for (unsigned j = 0; j < 16; ++j) { const unsigned c = xb_ld(&bar[XB_XCNT(j)]); sum += c; cnt += (c > 0u) ? 1u : 0u; mine = (j == x) ? c : mine; }
        if (sum == G) break;
        __builtin_amdgcn_s_sleep(1);
        if ((++sp & 255u) == 0u) { if (xb_ld(&bar[XB_TMO])) break; if (sp > XB_SPIN_CAP) { atomicAdd(&bar[XB_TMO], 1u); break; } }
    }
    nloc = mine > 0u ? mine : 1u; nx = cnt > 0u ? cnt : 1u;
}
__device__ __forceinline__ void xcd_barrier(const XcdBarrier& b) {
    asm volatile("s_waitcnt vmcnt(0)" ::: "memory");
    __syncthreads();
    if (threadIdx.x == 0) {
        unsigned* bar = b.bar;
        __builtin_amdgcn_s_waitcnt(0);
        unsigned nloc = b.st[0], nx = b.st[1];
        if (nloc == 0u) { xcd_barrier_complete(bar, b.x, nloc, nx); b.st[0] = nloc; b.st[1] = nx; }
        const unsigned old = xb_add(&bar[XB_XSUB(b.x)], 1u);
        const unsigned gen = old / nloc;
        if (old + 1u == (gen + 1u) * nloc) {
            __builtin_amdgcn_fence(__ATOMIC_RELEASE, "agent");
            asm volatile("s_waitcnt vmcnt(0)" ::: "memory");
            const unsigned og = xb_add(&bar[XB_TOP], 1u);
            const unsigned tg = og / nx;
            if (og + 1u == (tg + 1u) * nx) xb_add(&bar[XB_TOPGEN], 1u);
            else XB_SPIN(xb_ld(&bar[XB_TOPGEN]) == tg, bar);
            __builtin_amdgcn_fence(__ATOMIC_ACQUIRE, "agent");
            xb_add(&bar[XB_XGEN(b.x)], 1u);
            asm volatile("s_waitcnt vmcnt(0)" ::: "memory");
        } else {
            XB_SPIN(xb_ld(&bar[XB_XGEN(b.x)]) == gen, bar);
            __builtin_amdgcn_fence(__ATOMIC_ACQUIRE, "agent");
            asm volatile("s_waitcnt vmcnt(0)" ::: "memory");
        }
    }
    __syncthreads();
}

struct Frame {
    LAS unsigned char* lds;
    unsigned* ctl;
    unsigned char* ws;
    int tid, lane, wave, vcu, G;
    const float* const __attribute__((address_space(4)))* in;
    float* out;
};
#define LDS_WAIT() asm volatile("s_waitcnt lgkmcnt(0)" ::: "memory")
#define VM_WAIT() asm volatile("s_waitcnt vmcnt(0)" ::: "memory")

__device__ __forceinline__ int map_n(int mode, int n) {
    if (mode == 1) return n < 2048 ? n : (n < 2056 ? 3328 + (n - 2048) : (n < 3336 ? n - 8 : n));
    if (mode == 2) return n < 1024 ? ((n >> 7) * 256 + (n & 127)) : (((n - 1024) >> 7) * 256 + 128 + ((n - 1024) & 127));
    return n;
}
template <bool FP8>
__device__ __forceinline__ void p0_transpose_item(const float* W, int K, int N, void* WTv, int mode, LAS float* scr, int item, int lane) {
    const int nblk = N / 32, kb = item / nblk, nb = item % nblk, k0 = 64 * kb, n0 = 32 * nb;
    float tv_[32];
#pragma unroll
    for (int i = 0; i < 32; ++i) { const int kk = 2 * i + (lane >> 5); tv_[i] = W[(size_t)(k0 + kk) * N + n0 + (lane & 31)]; }
#pragma unroll
    for (int i = 0; i < 32; ++i) { const int kk = 2 * i + (lane >> 5); scr[kk * 33 + (lane & 31)] = tv_[i]; }
    LDS_WAIT(); asm volatile("" ::: "memory");
    const int c = lane & 7;
#pragma unroll
    for (int j = 0; j < 4; ++j) { const int n = (lane >> 3) + 8 * j; const LAS float* s = scr + (8 * c) * 33 + n;
        if constexpr (FP8) { u32x2 o; o.x = pk4_fp8(64.f * s[0 * 33], 64.f * s[1 * 33], 64.f * s[2 * 33], 64.f * s[3 * 33]); o.y = pk4_fp8(64.f * s[4 * 33], 64.f * s[5 * 33], 64.f * s[6 * 33], 64.f * s[7 * 33]);
            *(u32x2*)((unsigned char*)WTv + (size_t)map_n(mode, n0 + n) * K + k0 + 8 * c) = o; }
        else { u32x4 o; o.x = pk2(s[0 * 33], s[1 * 33]); o.y = pk2(s[2 * 33], s[3 * 33]); o.z = pk2(s[4 * 33], s[5 * 33]); o.w = pk2(s[6 * 33], s[7 * 33]);
            *(u32x4*)((bf16*)WTv + (size_t)map_n(mode, n0 + n) * K + k0 + 8 * c) = o; } }
    LDS_WAIT(); asm volatile("" ::: "memory");
}
__device__ __forceinline__ void p0_prologue(Frame& F) {
    LAS float* scr = (LAS float*)(F.lds + F.wave * 16384);
    const int gw = F.vcu * NWAVES + F.wave, NGW = F.G * NWAVES, lane = F.lane;
    constexpr int I_ADA = 192, I_CMP = 128, I_WRT = 32, I_PAD = 224, I_WIN = 16 * 105, I_WOUT = 16 * 32, I_WUP = 32 * 16 * 64, I_WDN = 32 * 16 * 32;
    unsigned char* ws = F.ws;
    for (int r = F.vcu; r < I_ADA; r += F.G) {
        const int ks = r / 24, jb = r % 24, j0 = jb * 256 + 4 * lane;
        const float* wa = F.in[2]; const float* c = F.in[1];
        f32x4 acc[4], w4[16];
#pragma unroll
        for (int b = 0; b < 4; ++b) acc[b] = (f32x4){0.f, 0.f, 0.f, 0.f};
#pragma unroll
        for (int kk = 0; kk < 16; ++kk) w4[kk] = __builtin_nontemporal_load((const f32x4*)(wa + (size_t)(ks * 128 + F.wave * 16 + kk) * 6144 + j0));
#pragma unroll
        for (int kk = 0; kk < 16; ++kk) {
#pragma unroll
            for (int b = 0; b < 4; ++b) { const float sv = siluf_(c[b * 1024 + ks * 128 + F.wave * 16 + kk]); acc[b] += w4[kk] * sv; } }
        LAS f32x4* red = (LAS f32x4*)F.lds;
#pragma unroll
        for (int b = 0; b < 4; ++b) red[(F.wave * 4 + b) * 64 + lane] = acc[b];
        __syncthreads();
        if (F.tid < 256) { const int b = F.tid >> 6, ln = F.tid & 63; f32x4 sum = red[b * 64 + ln];
#pragma unroll
            for (int w = 1; w < 8; ++w) sum += red[(w * 4 + b) * 64 + ln];
            *(f32x4*)((float*)(ws + WS_MODP) + (size_t)(ks * 4 + b) * 6144 + jb * 256 + 4 * ln) = sum; }
        __syncthreads();
    }
    for (int it = gw; it < I_CMP + I_WRT + I_PAD; it += NGW) {
        int r = it;
        if (r < I_CMP) {
            const int kv = r >> 6, e = r & 63; const float* w = kv ? F.in[12] : F.in[11]; const float* pos = kv ? F.in[14] : F.in[13];
            bf16* wt = (bf16*)(ws + WS_WCMP) + (size_t)(kv * 64 + e) * 2048; float s = 0.f;
            float wv[32], pv_[32];
#pragma unroll
            for (int i = 0; i < 32; ++i) { wv[i] = w[(size_t)(lane + 64 * i) * 64 + e]; pv_[i] = pos[lane + 64 * i]; }
#pragma unroll
            for (int i = 0; i < 32; ++i) { wt[lane + 64 * i] = (bf16)f2bf(wv[i]); s += pv_[i] * wv[i]; }
            s = wave_sum(s); if (lane == 0) ((float*)(ws + WS_CMPB))[kv * 64 + e] = s;
            continue; }
        r -= I_CMP;
        if (r < I_WRT) { const float* wr_ = F.in[17]; float* wt = (float*)(ws + WS_WRT) + (size_t)r * 1024;
            float wv[16];
#pragma unroll
            for (int i = 0; i < 16; ++i) wv[i] = wr_[(size_t)(lane + 64 * i) * 32 + r];
#pragma unroll
            for (int i = 0; i < 16; ++i) wt[lane + 64 * i] = wv[i];
            continue; }
        r -= I_WRT;
        { u32x4* p = (u32x4*)((bf16*)(ws + WS_WIN) + (size_t)(D_IN + r) * 1024); p[lane] = (u32x4){0u, 0u, 0u, 0u}; p[lane + 64] = (u32x4){0u, 0u, 0u, 0u}; }
    }
    constexpr int NT_ITEMS = I_WIN + I_WOUT;
    struct TItem { const float* src; unsigned char* dst; int N, mode, fp8, k0, n0; };
#define P0_DECODE(d, rr) do { int r_ = (rr); int item_; \
        if (r_ < I_WIN) { d.src = F.in[8]; d.dst = ws + WS_WIN; d.N = D_IN; d.mode = 1; d.fp8 = 0; item_ = r_; } \
        else { r_ -= I_WIN; d.src = F.in[16]; d.dst = ws + WS_WOUT; d.N = 1024; d.mode = 0; d.fp8 = 0; item_ = r_; } \
        const int nblk_ = d.N / 32; d.k0 = 64 * (item_ / nblk_); d.n0 = 32 * (item_ % nblk_); } while (0)
#define P0_LOAD(d, tv) do { _Pragma("unroll") for (int i = 0; i < 32; ++i) tv[i] = d.src[(size_t)(d.k0 + 2 * i + (lane >> 5)) * d.N + d.n0 + (lane & 31)]; } while (0)
    int itx = gw;
    if (itx < NT_ITEMS) {
        TItem d0, d1; float ta[32], tb[32];
        P0_DECODE(d0, itx); P0_LOAD(d0, ta);
        for (;;) {
            const int nx = itx + NGW; const bool has = nx < NT_ITEMS;
            if (has) { P0_DECODE(d1, nx); P0_LOAD(d1, tb); }
#pragma unroll
            for (int i = 0; i < 32; ++i) scr[(2 * i + (lane >> 5)) * 33 + (lane & 31)] = ta[i];
            LDS_WAIT(); asm volatile("" ::: "memory");
            const int c = lane & 7;
#pragma unroll
            for (int j = 0; j < 4; ++j) { const int n = (lane >> 3) + 8 * j; const LAS float* sp = scr + (8 * c) * 33 + n; const size_t orow = (size_t)map_n(d0.mode, d0.n0 + n) * 1024 + d0.k0 + 8 * c;
                if (d0.fp8) { u32x2 o; o.x = pk4_fp8(64.f * sp[0 * 33], 64.f * sp[1 * 33], 64.f * sp[2 * 33], 64.f * sp[3 * 33]); o.y = pk4_fp8(64.f * sp[4 * 33], 64.f * sp[5 * 33], 64.f * sp[6 * 33], 64.f * sp[7 * 33]);
                    *(u32x2*)(d0.dst + orow) = o; }
                else { u32x4 o; o.x = pk2(sp[0 * 33], sp[1 * 33]); o.y = pk2(sp[2 * 33], sp[3 * 33]); o.z = pk2(sp[4 * 33], sp[5 * 33]); o.w = pk2(sp[6 * 33], sp[7 * 33]);
                    *(u32x4*)(d0.dst + orow * 2) = o; } }
            LDS_WAIT(); asm volatile("" ::: "memory");
            if (!has) break;
            itx = nx; d0 = d1;
#pragma unroll
            for (int i = 0; i < 32; ++i) ta[i] = tb[i];
        }
    }
#undef P0_DECODE
#undef P0_LOAD
    {
        constexpr int NH = 2 * (32 * 8 * 32 + 32 * 8 * 16);
        LAS unsigned char* scr8 = (LAS unsigned char*)scr;
        struct HItem { const float* src; unsigned char* dst; int N, mode, k0, n0, half; };
#define P8_DECODE(d, hh) do { int it_ = (hh) >> 1; d.half = (hh) & 1; \
            if (it_ < 32 * 256) { const int e_ = it_ >> 8, q_ = it_ & 255; d.src = F.in[19] + (size_t)e_ * 1024 * 2048; d.dst = ws + WS_WUP + (size_t)e_ * 2048 * 1024; d.N = 2048; d.mode = 2; d.k0 = 128 * (q_ >> 5); d.n0 = 64 * (q_ & 31); } \
            else { it_ -= 32 * 256; const int e_ = it_ >> 7, q_ = it_ & 127; d.src = F.in[21] + (size_t)e_ * 1024 * 1024; d.dst = ws + WS_WDN + (size_t)e_ * 1024 * 1024; d.N = 1024; d.mode = 0; d.k0 = 128 * (q_ >> 4); d.n0 = 64 * (q_ & 15); } } while (0)
#define P8_LOAD(d, tv) do { _Pragma("unroll") for (int i = 0; i < 16; ++i) tv[i] = __builtin_nontemporal_load((const f32x4*)(d.src + (size_t)(d.k0 + 64 * d.half + 16 * (i >> 2) + 4 * (lane >> 4) + (i & 3)) * d.N + d.n0 + 4 * (lane & 15))); } while (0)
        int item = gw;
        if (item < NH / 2) {
            HItem d0, d1; f32x4 ta[16], tb[16];
            int hcur = 2 * item; P8_DECODE(d0, hcur); P8_LOAD(d0, ta);
            for (;;) {
                const bool has = (hcur & 1) == 0 || (item + NGW) < NH / 2;
                const int hn = (hcur & 1) == 0 ? hcur + 1 : 2 * (item + NGW);
                if (has) { P8_DECODE(d1, hn); P8_LOAD(d1, tb); }
#pragma unroll
                for (int g = 0; g < 4; ++g) {
                    const unsigned r0 = pk4_fp8(64.f * ta[4 * g][0], 64.f * ta[4 * g][1], 64.f * ta[4 * g][2], 64.f * ta[4 * g][3]);
                    const unsigned r1 = pk4_fp8(64.f * ta[4 * g + 1][0], 64.f * ta[4 * g + 1][1], 64.f * ta[4 * g + 1][2], 64.f * ta[4 * g + 1][3]);
                    const unsigned r2 = pk4_fp8(64.f * ta[4 * g + 2][0], 64.f * ta[4 * g + 2][1], 64.f * ta[4 * g + 2][2], 64.f * ta[4 * g + 2][3]);
                    const unsigned r3 = pk4_fp8(64.f * ta[4 * g + 3][0], 64.f * ta[4 * g + 3][1], 64.f * ta[4 * g + 3][2], 64.f * ta[4 * g + 3][3]);
                    const unsigned t01l = __builtin_amdgcn_perm(r1, r0, 0x05010400u), t01h = __builtin_amdgcn_perm(r1, r0, 0x07030602u), t23l = __builtin_amdgcn_perm(r3, r2, 0x05010400u), t23h = __builtin_amdgcn_perm(r3, r2, 0x07030602u);
                    const unsigned o0 = __builtin_amdgcn_perm(t23l, t01l, 0x05040100u), o1 = __builtin_amdgcn_perm(t23l, t01l, 0x07060302u), o2 = __builtin_amdgcn_perm(t23h, t01h, 0x05040100u), o3 = __builtin_amdgcn_perm(t23h, t01h, 0x07060302u);
                    LAS unsigned char* wp = scr8 + (4 * (lane & 15)) * 132 + 64 * d0.half + 16 * g + 4 * (lane >> 4);
                    *(LAS unsigned*)(wp) = o0; *(LAS unsigned*)(wp + 132) = o1; *(LAS unsigned*)(wp + 264) = o2; *(LAS unsigned*)(wp + 396) = o3; }
                if (d0.half == 1) {
                    LDS_WAIT(); asm volatile("" ::: "memory");
#pragma unroll
                    for (int i = 0; i < 8; ++i) { const int n = (lane >> 3) + 8 * i, ch = lane & 7; const LAS unsigned* rp = (const LAS unsigned*)(scr8 + n * 132 + ch * 16);
                        u32x4 o; o.x = rp[0]; o.y = rp[1]; o.z = rp[2]; o.w = rp[3];
                        __builtin_nontemporal_store(o, (u32x4*)(d0.dst + (size_t)map_n(d0.mode, d0.n0 + n) * 1024 + d0.k0 + ch * 16)); }
                    LDS_WAIT(); asm volatile("" ::: "memory");
                }
                if (!has) break;
                if (hcur & 1) item += NGW;
                hcur = hn; d0 = d1;
#pragma unroll
                for (int i = 0; i < 16; ++i) ta[i] = tb[i];
            }
        }
#undef P8_DECODE
#undef P8_LOAD
    }
}

__device__ __forceinline__ float mod_val(const Frame& F, int b, int j) {
    const float* mp = (const float*)(F.ws + WS_MODP); float s = F.in[3][j];
#pragma unroll
    for (int ks = 0; ks < 8; ++ks) s += mp[(size_t)(ks * 4 + b) * 6144 + j];
    return s;
}
__device__ __forceinline__ void p1_rows(Frame& F) {
    LAS float* A1 = (LAS float*)F.lds; LAS float* B1 = A1 + 1024;
    bf16* H = (bf16*)(F.ws + WS_H);
    for (int rb = F.vcu; rb < M / 64; rb += F.G) {
        const int b = (rb * 64) / SEQ;
        f32x4 v[8][4];
#pragma unroll
        for (int i = 0; i < 8; ++i) { const f32x4* xr = (const f32x4*)(F.in[0] + (size_t)(rb * 64 + F.wave * 8 + i) * 1024) + F.lane;
#pragma unroll
            for (int j = 0; j < 4; ++j) v[i][j] = __builtin_nontemporal_load(xr + 64 * j); }
        for (int col = F.tid; col < 1024; col += NTHR) { A1[col] = F.in[4][col] * (1.0f + mod_val(F, b, 1024 + col)); B1[col] = mod_val(F, b, col); }
        if (rb < 96 && F.tid < 256) { const int idx = rb * 256 + F.tid; ((float*)(F.ws + WS_MODF))[idx] = mod_val(F, idx / 6144, idx % 6144); }
        __syncthreads();
#pragma unroll
        for (int i = 0; i < 8; ++i) {
            const int row = rb * 64 + F.wave * 8 + i;
            float ss = 0.f;
#pragma unroll
            for (int j = 0; j < 4; ++j) ss += (v[i][j].x * v[i][j].x + v[i][j].y * v[i][j].y) + (v[i][j].z * v[i][j].z + v[i][j].w * v[i][j].w);
            const float rs = rsqrtf(wave_sum(ss) * (1.0f / 1024.0f) + EPS);
            u32x2* o8 = (u32x2*)(H + (size_t)row * 1024) + F.lane;
#pragma unroll
            for (int j = 0; j < 4; ++j) { const int c0 = 4 * F.lane + 256 * j;
                const f32x4 a = *(const LAS f32x4*)(A1 + c0), bb = *(const LAS f32x4*)(B1 + c0);
                const f32x4 y = v[i][j] * rs * a + bb; u32x2 w; w.x = pk2(y.x, y.y); w.y = pk2(y.z, y.w); o8[64 * j] = w; }
        }
        __syncthreads();
    }
}

__device__ __forceinline__ void p3_compress_item(Frame& F, int wi) {
    const int lane = F.lane, r32 = lane & 31, hi = lane >> 5;
    const int nt = wi & 1, kv = (wi >> 1) & 1, it = (wi >> 2) & 7, g = (wi >> 5) & 1, b = wi >> 6;
    const bf16* Z = (const bf16*)(F.ws + WS_Z);
    const int i = it * 32 + r32; const bool ok = i < 255; const int ic = ok ? i : 0;
    const bf16* zrow0 = Z + (size_t)(b * SEQ + 16 * ic) * ZP + (kv ? ZC_VC : ZC_KC) + g * 64 + hi * 8;
    const bf16* wrow = (const bf16*)(F.ws + WS_WCMP) + (size_t)(kv * 64 + nt * 32 + r32) * 2048 + hi * 8;
    f32x16 acc = {};
    bf16x8 av[16], bv[16];
#pragma unroll
    for (int k = 0; k < 16; ++k) { const int ks = F.wave * 16 + k, l = ks >> 2, dq = ks & 3; av[k] = *(const bf16x8*)(zrow0 + (size_t)l * ZP + dq * 16); bv[k] = *(const bf16x8*)(wrow + ks * 16); }
#pragma unroll
    for (int k = 0; k < 16; ++k) { bf16x8 a = av[k]; if (!ok) a = (bf16x8){0, 0, 0, 0, 0, 0, 0, 0}; acc = __builtin_amdgcn_mfma_f32_32x32x16_bf16(a, bv[k], acc, 0, 0, 0); }
    LAS float* part = (LAS float*)F.lds;
#pragma unroll
    for (int r = 0; r < 16; ++r) part[(F.wave * 16 + r) * 64 + lane] = acc[r];
    __syncthreads();
    bf16* dst = (bf16*)(F.ws + (kv ? WS_VC : WS_KC)) + (size_t)((b * 2 + g) * 256) * 64;
#pragma unroll
    for (int k = 0; k < 2; ++k) { const int o = F.tid + NTHR * k, r = o >> 6, ln = o & 63; float v = 0.f;
#pragma unroll
        for (int w = 0; w < 8; ++w) v += part[(w * 16 + r) * 64 + ln];
        const int irow = it * 32 + crow(r, ln >> 5), e = nt * 32 + (ln & 31);
        dst[(size_t)irow * 64 + e] = (bf16)f2bf(irow < 255 ? v + ((const float*)(F.ws + WS_CMPB))[kv * 64 + e] : 0.f); }
    __syncthreads();
}
__device__ __forceinline__ void chunk_gates(const Frame& F, int b, int h, int c, float& ig, float& g) {
    const bf16* Z = (const bf16*)(F.ws + WS_Z); const size_t row = (size_t)(b * SEQ + c * 64 + F.lane) * ZP;
    ig = bf2f(Z[row + ZC_IG + h]) + F.in[9][h];
    const float fp = bf2f(Z[row + ZC_FG + h]) + F.in[9][4 + h];
    float v = logsigmoidf_(fp);
#pragma unroll
    for (int o = 1; o < 64; o <<= 1) { const float t = __shfl_up(v, o); if (F.lane >= o) v += t; }
    g = v;
}
__device__ __forceinline__ void conv8(const Frame& F, int b, int t, int zc, int cc, float (&o)[8]) {
    const bf16* Z = (const bf16*)(F.ws + WS_Z); const float* cw = F.in[10];
#pragma unroll
    for (int j = 0; j < 8; ++j) o[j] = 0.f;
#pragma unroll
    for (int jj = 0; jj < 4; ++jj) { const int tt = t - 3 + jj;
        if (tt >= 0) { const bf16x8 v = *(const bf16x8*)(Z + (size_t)(b * SEQ + tt) * ZP + zc);
            const f32x4 w0 = *(const f32x4*)(cw + jj * 1024 + cc), w1 = *(const f32x4*)(cw + jj * 1024 + cc + 4);
#pragma unroll
            for (int j = 0; j < 4; ++j) { o[j] += w0[j] * bf2f((unsigned short)v[j]); o[4 + j] += w1[j] * bf2f((unsigned short)v[4 + j]); } } }
#pragma unroll
    for (int j = 0; j < 8; ++j) o[j] = siluf_(o[j]);
}
struct ConvRaw { bf16x8 v[4]; };
__device__ __forceinline__ void conv8_load(const Frame& F, int b, int t, int zc, ConvRaw& r) {
    const bf16* Z = (const bf16*)(F.ws + WS_Z);
#pragma unroll
    for (int jj = 0; jj < 4; ++jj) { const int tt = t - 3 + jj; r.v[jj] = (bf16x8){0, 0, 0, 0, 0, 0, 0, 0}; if (tt >= 0) r.v[jj] = *(const bf16x8*)(Z + (size_t)(b * SEQ + tt) * ZP + zc); }
}
__device__ __forceinline__ void conv8_calc(const Frame& F, const ConvRaw& r, int cc, float (&o)[8]) {
    const float* cw = F.in[10];
#pragma unroll
    for (int j = 0; j < 8; ++j) o[j] = 0.f;
#pragma unroll
    for (int jj = 0; jj < 4; ++jj) { const f32x4 w0 = *(const f32x4*)(cw + jj * 1024 + cc), w1 = *(const f32x4*)(cw + jj * 1024 + cc + 4);
#pragma unroll
        for (int j = 0; j < 4; ++j) { o[j] += w0[j] * bf2f((unsigned short)r.v[jj][j]); o[4 + j] += w1[j] * bf2f((unsigned short)r.v[jj][4 + j]); } }
#pragma unroll
    for (int j = 0; j < 8; ++j) o[j] = siluf_(o[j]);
}
constexpr int KT_STRIDE = 72, QS_STRIDE = 136;
__device__ __forceinline__ void conv8_calc_lds(const LAS float* cwl, int nch, const ConvRaw& r, int lc, float (&o)[8]) {
#pragma unroll
    for (int j = 0; j < 8; ++j) o[j] = 0.f;
#pragma unroll
    for (int jj = 0; jj < 4; ++jj) { const f32x4 w0 = *(const LAS f32x4*)(cwl + jj * nch + lc), w1 = *(const LAS f32x4*)(cwl + jj * nch + lc + 4);
#pragma unroll
        for (int j = 0; j < 4; ++j) { o[j] += w0[j] * bf2f((unsigned short)r.v[jj][j]); o[4 + j] += w1[j] * bf2f((unsigned short)r.v[jj][4 + j]); } }
#pragma unroll
    for (int j = 0; j < 8; ++j) o[j] = siluf_(o[j]);
}
__device__ __forceinline__ void p3_mlstm_a_items(Frame& F) {
    const int tid = F.tid, lane = F.lane, r32 = lane & 31, hi = lane >> 5;
    LAS bf16* kT = (LAS bf16*)F.lds; LAS bf16* vwT = kT + 128 * KT_STRIDE; LAS float* wexA = (LAS float*)(F.lds + 2 * 128 * KT_STRIDE * 2);
    LAS float* cwl = wexA + 256;
    const bf16* Z = (const bf16*)(F.ws + WS_Z);
    float* SCG = (float*)(F.ws + WS_SC); float* SCM = SCG + 1024;
    int cur_h = -1;
    for (int base = F.vcu; base < 1024; base += 4 * F.G) {
        __syncthreads();
        if (F.wave < 4) { const int item = base + F.wave * F.G;
            if (item < 1024) { const int b = item >> 8, h = (item >> 6) & 3, c = item & 63;
                float ig, g; chunk_gates(F, b, h, c, ig, g);
                const float G = __shfl(g, 63), wl = G - g + ig, ml = wave_max(wl);
                wexA[F.wave * 64 + lane] = __expf(wl - ml);
                if (lane == 0) { SCG[item] = G; SCM[item] = ml; } } }
        for (int kb = 0; kb < 4; ++kb) {
            const int item = base + kb * F.G; if (item >= 1024) break;
            const int b = item >> 8, h = (item >> 6) & 3, c = item & 63;
            ConvRaw rk[2]; bf16x8 rvv[2];
#pragma unroll
            for (int rep = 0; rep < 2; ++rep) { const int task = tid + NTHR * rep, l = task >> 4, ch = task & 15, t = c * 64 + l;
                conv8_load(F, b, t, ZC_KM + h * 128 + ch * 8, rk[rep]); rvv[rep] = *(const bf16x8*)(Z + (size_t)(b * SEQ + t) * ZP + ZC_VM + h * 128 + ch * 8); }
            if (h != cur_h) { __syncthreads(); cwl[tid] = F.in[10][(tid >> 7) * 1024 + 512 + h * 128 + (tid & 127)]; cur_h = h; }
            __syncthreads();
            const LAS float* wex = wexA + kb * 64;
#pragma unroll
            for (int rep = 0; rep < 2; ++rep) { const int task = tid + NTHR * rep, l = task >> 4, ch = task & 15;
                float kk[8]; conv8_calc_lds(cwl, 128, rk[rep], ch * 8, kk);
                const bf16x8 vv = rvv[rep]; const float we = wex[l];
#pragma unroll
                for (int j = 0; j < 8; ++j) { kT[(ch * 8 + j) * KT_STRIDE + l] = (bf16)f2bf(kk[j] * 0.08838834764831845f); vwT[(ch * 8 + j) * KT_STRIDE + l] = (bf16)f2bf(bf2f((unsigned short)vv[j]) * we); } }
            __syncthreads();
            {
                const int et = F.wave >> 1; bf16* DC = (bf16*)(F.ws + WS_DC) + (size_t)item * 16384;
#pragma unroll
                for (int dt2 = 0; dt2 < 2; ++dt2) { const int dt = 2 * (F.wave & 1) + dt2; f32x16 acc = {};
#pragma unroll
                    for (int ks = 0; ks < 4; ++ks) { const bf16x8 a = *(const LAS bf16x8*)(vwT + (et * 32 + r32) * KT_STRIDE + ks * 16 + hi * 8), bq = *(const LAS bf16x8*)(kT + (dt * 32 + r32) * KT_STRIDE + ks * 16 + hi * 8);
                        acc = __builtin_amdgcn_mfma_f32_32x32x16_bf16(a, bq, acc, 0, 0, 0); }
#pragma unroll
                    for (int r = 0; r < 16; ++r) DC[(size_t)(et * 32 + crow(r, hi)) * 128 + dt * 32 + r32] = (bf16)f2bf(acc[r]); }
                { const int d = tid >> 2, part = tid & 3; float s = 0.f;
#pragma unroll
                    for (int l = 0; l < 16; ++l) s += wex[part * 16 + l] * bf2f(kT[d * KT_STRIDE + part * 16 + l]);
                    s += __shfl_xor(s, 1); s += __shfl_xor(s, 2);
                    if (part == 0) ((float*)(F.ws + WS_DN))[(size_t)item * 128 + d] = s; }
            }
        }
    }
    __syncthreads();
}

__device__ __forceinline__ void p4_scan(Frame& F) {
    const float* SCG = (const float*)(F.ws + WS_SC); const float* SCM = SCG + 1024; float* MP = (float*)(F.ws + WS_SC) + 2048;
    for (int it = F.vcu; it < 256; it += F.G) {
        const int bh = it >> 4, idx = (it & 15) * 512 + F.tid; const bool wmp = ((it & 15) == 0) && F.tid == 0;
        const unsigned* __restrict__ src = (const unsigned*)(F.ws + WS_DC) + idx; unsigned* __restrict__ dst = (unsigned*)(F.ws + WS_CP) + idx;
        float m = -INFINITY, s0 = 0.f, s1 = 0.f;
        for (int cb = 0; cb < 4; ++cb) {
            unsigned v[16];
#pragma unroll
            for (int i = 0; i < 16; ++i) v[i] = __builtin_nontemporal_load(src + (size_t)(bh * 64 + cb * 16 + i) * 8192);
#pragma unroll
            for (int i = 0; i < 16; ++i) { const int ci = bh * 64 + cb * 16 + i; const float G = SCG[ci], ml = SCM[ci];
                const float mn = fmaxf(G + m, ml), a = __expf(G + m - mn), bc = __expf(ml - mn);
                dst[(size_t)ci * 8192] = pk2(s0, s1); if (wmp) MP[ci] = m;
                s0 = a * s0 + bc * bf2f(v[i] & 0xffffu); s1 = a * s1 + bc * bf2f(v[i] >> 16); m = mn; }
        }
        if (F.tid < 8) { const int flat = it * 8 + F.tid, bhn = flat >> 7, d = flat & 127;
            const float* __restrict__ sn = (const float*)(F.ws + WS_DN) + d; float* __restrict__ dn = (float*)(F.ws + WS_NP) + d;
            float mN = -INFINITY, st = 0.f;
            for (int cb = 0; cb < 4; ++cb) { float v[16];
#pragma unroll
                for (int i = 0; i < 16; ++i) v[i] = sn[(size_t)(bhn * 64 + cb * 16 + i) * 128];
#pragma unroll
                for (int i = 0; i < 16; ++i) { const int ci = bhn * 64 + cb * 16 + i; const float G = SCG[ci], ml = SCM[ci];
                    const float mn = fmaxf(G + mN, ml), a = __expf(G + mN - mn), bc = __expf(ml - mn);
                    dn[(size_t)ci * 128] = st; st = a * st + bc * v[i]; mN = mn; } } }
    }
}

namespace nsa {
constexpr int KOFF = 0, VOFF = 32768, TBOFF = 65536, WSFOFF = 71680, MSKOFF = 73728, UNIOFF = 74240, JLOFF = 74304, OACCOFF = 74752, QOFF0 = 123904;
constexpr float LOG2E = 1.4426950408889634f, C2 = 0.125f * LOG2E;
typedef short v4i16_t __attribute__((ext_vector_type(4)));
#define NSA_WAITV(n) asm volatile("s_waitcnt vmcnt(" #n ")" ::: "memory")
#define NSA_BAR() do { asm volatile("s_waitcnt lgkmcnt(0)" ::: "memory"); __builtin_amdgcn_s_barrier(); asm volatile("" ::: "memory"); } while (0)

__device__ __forceinline__ void dma_k(LAS unsigned char* L, int buf, int wid, int lane, const bf16* Kt, size_t P) {
    __builtin_amdgcn_global_load_lds((const unsigned*)(Kt + (size_t)lane * P + wid * 8), (LAS unsigned*)(L + KOFF + buf * 8192 + wid * 1024), 16, 0, 0);
}
__device__ __forceinline__ void dma_v(LAS unsigned char* L, int buf, int wid, int lane, const bf16* Vt, size_t P) {
    __builtin_amdgcn_global_load_lds((const unsigned*)(Vt + (size_t)(16 * (wid & 3) + (lane >> 2)) * P + (wid >> 2) * 32 + (lane & 3) * 8), (LAS unsigned*)(L + VOFF + buf * 8192 + wid * 1024), 16, 0, 0);
}
__device__ __forceinline__ void qkt(f32x16& p0, f32x16& p1, const LAS unsigned char* L, int buf, const LAS bf16x8* qr, int r32, int hi) {
    const LAS unsigned char* kb = L + KOFF + buf * 8192 + hi * 1024 + r32 * 16;
    p0 = (f32x16){}; p1 = (f32x16){};
#pragma unroll
    for (int d0 = 0; d0 < 4; ++d0) {
        const bf16x8 b0 = *(const LAS bf16x8*)(kb + d0 * 2048), b1 = *(const LAS bf16x8*)(kb + d0 * 2048 + 512), q = qr[d0 * 64];
        p0 = __builtin_amdgcn_mfma_f32_32x32x16_bf16(b0, q, p0, 0, 0, 0);
        p1 = __builtin_amdgcn_mfma_f32_32x32x16_bf16(b1, q, p1, 0, 0, 0); }
}
__device__ __forceinline__ s16x4 vtr(const LAS unsigned char* p) { return __builtin_bit_cast(s16x4, __builtin_amdgcn_ds_read_tr16_b64_v4i16((LAS v4i16_t*)p)); }
__device__ __forceinline__ void pv(f32x16 (&o)[2], const LAS unsigned char* L, int buf, const u32x4 (&pw)[4], int lane, int hi) {
    const LAS unsigned char* vp = L + VOFF + buf * 8192 + ((lane >> 4) & 1) * 32 + (lane & 3) * 8 + (4 * hi + ((lane & 15) >> 2)) * 64;
#pragma unroll
    for (int dh = 0; dh < 2; ++dh)
#pragma unroll
        for (int ks = 0; ks < 4; ++ks) {
            const s16x4 lo = vtr(vp + dh * 4096 + ks * 1024), hh = vtr(vp + dh * 4096 + ks * 1024 + 512);
            const bf16x8 vf = (bf16x8){lo[0], lo[1], lo[2], lo[3], hh[0], hh[1], hh[2], hh[3]};
            o[dh] = __builtin_amdgcn_mfma_f32_32x32x16_bf16(__builtin_bit_cast(bf16x8, pw[ks]), vf, o[dh], 0, 0, 0); }
}
__device__ __forceinline__ float xhalf(float x, int hi) {
    auto rr = __builtin_amdgcn_permlane32_swap(__float_as_uint(x), __float_as_uint(x), false, false); return __uint_as_float(hi ? rr[0] : rr[1]); }
__device__ __forceinline__ float dpp_xor1(float x) { return __int_as_float(__builtin_amdgcn_mov_dpp(__float_as_int(x), 0xB1, 0xF, 0xF, true)); }
__device__ __forceinline__ float dpp_xor2(float x) { return __int_as_float(__builtin_amdgcn_mov_dpp(__float_as_int(x), 0x4E, 0xF, 0xF, true)); }
__device__ __forceinline__ void score_tile(f32x16& p0, f32x16& p1, int dist0, int step, int dmax, bool laneok, bool usebias, const LAS float* tbh, int hi) {
    const int dbase = dist0 + step * 4 * hi;
#pragma unroll
    for (int r = 0; r < 16; ++r) {
        const int kk = (r & 3) + 8 * (r >> 2); const int da = dbase + step * kk, db = da + step * 32;
        float sa = p0[r] * C2, sb = p1[r] * C2;
        if (usebias) { sa += tbh[min(max(da, 0), 127)]; sb += tbh[min(max(db, 0), 127)]; }
        p0[r] = (laneok && da >= 0 && da < dmax) ? sa : -INFINITY;
        p1[r] = (laneok && db >= 0 && db < dmax) ? sb : -INFINITY; }
}
template <bool DIAG>
__device__ __forceinline__ void near_scores(f32x16& p0, f32x16& p1, const LAS float* tbD, int D0) {
#pragma unroll
    for (int r = 0; r < 16; ++r) { const int kk = (r & 3) + 8 * (r >> 2);
        float sa = __builtin_fmaf(p0[r], C2, tbD[-kk]), sb = __builtin_fmaf(p1[r], C2, tbD[-kk - 32]);
        if (DIAG) { sa = (kk <= D0) ? sa : -INFINITY; sb = (kk + 32 <= D0) ? sb : -INFINITY; }
        p0[r] = sa; p1[r] = sb; }
}
__device__ __forceinline__ void wedge_mask(f32x16& p0, f32x16& p1, int D) {
#pragma unroll
    for (int r = 0; r < 16; ++r) { const int kk = (r & 3) + 8 * (r >> 2); p0[r] = (kk > D) ? p0[r] : -INFINITY; p1[r] = (kk + 32 > D) ? p1[r] : -INFINITY; }
}
__device__ __forceinline__ float rowmax32(const f32x16& p0, const f32x16& p1) {
    float a = fmaxf(p0[0], p1[0]);
#pragma unroll
    for (int r = 1; r < 16; ++r) a = fmaxf(a, fmaxf(p0[r], p1[r]));
    return fmaxf(a, xchg_f<32>(a, threadIdx.x & 63));
}
template <bool HAS_O>
__device__ __forceinline__ void softmax_step(f32x16& p0, f32x16& p1, float& m, float& l, f32x16 (&o)[2], u32x4 (&pw)[4], LAS float* wsf, int r32, int hi, bool sel = true) {
    const float rm = sel ? rowmax32(p0, p1) : -INFINITY, mn = fmaxf(m, rm);
    if (__any(mn > m + 8.0f)) {
        const float alpha = __builtin_amdgcn_exp2f(m - mn); l *= alpha; m = mn;
        if (HAS_O) { if (hi == 0) wsf[r32] = alpha; LDS_WAIT();
#pragma unroll
            for (int r = 0; r < 16; ++r) { const float f = wsf[crow(r, hi)]; o[0][r] *= f; o[1][r] *= f; }
            LDS_WAIT(); }
    }
    const float off = sel ? -m : -INFINITY;
    float s0 = 0.f, s1 = 0.f;
#pragma unroll
    for (int r = 0; r < 16; ++r) { p0[r] = __builtin_amdgcn_exp2f(p0[r] + off); p1[r] = __builtin_amdgcn_exp2f(p1[r] + off); s0 += p0[r]; s1 += p1[r]; }
    l += s0 + s1;
#pragma unroll
    for (int k = 0; k < 2; ++k) { pw[k] = (u32x4){pk2(p0[8 * k], p0[8 * k + 1]), pk2(p0[8 * k + 2], p0[8 * k + 3]), pk2(p0[8 * k + 4], p0[8 * k + 5]), pk2(p0[8 * k + 6], p0[8 * k + 7])};
        pw[2 + k] = (u32x4){pk2(p1[8 * k], p1[8 * k + 1]), pk2(p1[8 * k + 2], p1[8 * k + 3]), pk2(p1[8 * k + 4], p1[8 * k + 5]), pk2(p1[8 * k + 6], p1[8 * k + 7])}; }
}
template <bool HAS_O = true>
__device__ __forceinline__ void softmax_fast(f32x16& p0, f32x16& p1, float& m, float& l, f32x16 (&o)[2], u32x4 (&pw)[4], LAS float* wsf, int r32, int hi, bool sel) {
    float a = fmaxf(fmaxf(p0[0], p0[1]), p1[0]), bq = fmaxf(fmaxf(p0[2], p0[3]), p1[1]); a = fmaxf(fmaxf(a, p1[2]), p1[3]);
#pragma unroll
    for (int r = 4; r < 16; r += 4) { a = fmaxf(fmaxf(a, p0[r]), p0[r + 1]); bq = fmaxf(fmaxf(bq, p0[r + 2]), p0[r + 3]); a = fmaxf(fmaxf(a, p1[r]), p1[r + 1]); bq = fmaxf(fmaxf(bq, p1[r + 2]), p1[r + 3]); }
    a = fmaxf(a, bq); a = fmaxf(a, xchg_f<32>(a, threadIdx.x & 63));
    const float rm = sel ? a * C2 : -INFINITY, mn = fmaxf(m, rm);
    if (__any(mn > m + 8.0f)) {
        const float alpha = __builtin_amdgcn_exp2f(m - mn); l *= alpha; m = mn;
        if (HAS_O) { if (hi == 0) wsf[r32] = alpha; LDS_WAIT();
#pragma unroll
            for (int r = 0; r < 16; ++r) { const float f = wsf[crow(r, hi)]; o[0][r] *= f; o[1][r] *= f; }
            LDS_WAIT(); }
    }
    const float off = sel ? -m : -INFINITY;
    float s0 = 0.f, s1 = 0.f;
#pragma unroll
    for (int r = 0; r < 16; ++r) { p0[r] = __builtin_amdgcn_exp2f(__builtin_fmaf(p0[r], C2, off)); p1[r] = __builtin_amdgcn_exp2f(__builtin_fmaf(p1[r], C2, off)); s0 += p0[r]; s1 += p1[r]; }
    l += s0 + s1;
#pragma unroll
    for (int k = 0; k < 2; ++k) { pw[k] = (u32x4){pk2(p0[8 * k], p0[8 * k + 1]), pk2(p0[8 * k + 2], p0[8 * k + 3]), pk2(p0[8 * k + 4], p0[8 * k + 5]), pk2(p0[8 * k + 6], p0[8 * k + 7])};
        pw[2 + k] = (u32x4){pk2(p1[8 * k], p1[8 * k + 1]), pk2(p1[8 * k + 2], p1[8 * k + 3]), pk2(p1[8 * k + 4], p1[8 * k + 5]), pk2(p1[8 * k + 6], p1[8 * k + 7])}; }
}
template <bool FIRST>
__device__ __forceinline__ void branch_merge(LAS bf16* oa, const f32x16 (&o)[2], float l, float gate, LAS float* wsf, int r32, int hi, int lane) {
    const float lt = l + xchg_f<32>(l, lane); const float f = lt > 0.f ? gate / lt : 0.f;
    LDS_WAIT(); if (hi == 0) wsf[r32] = f; LDS_WAIT();
#pragma unroll
    for (int r = 0; r < 16; ++r) { const float ff = wsf[crow(r, hi)];
        float a0 = o[0][r] * ff, a1 = o[1][r] * ff;
        if (!FIRST) { a0 += bf2f(oa[(2 * r) * 64 + lane]); a1 += bf2f(oa[(2 * r + 1) * 64 + lane]); }
        oa[(2 * r) * 64 + lane] = (bf16)f2bf(a0); oa[(2 * r + 1) * 64 + lane] = (bf16)f2bf(a1); }
    LDS_WAIT();
}

__device__ __forceinline__ float rowmax_raw(const f32x16& p0, const f32x16& p1, int lane) {
    float a = fmaxf(fmaxf(p0[0], p0[1]), p1[0]), bq = fmaxf(fmaxf(p0[2], p0[3]), p1[1]); a = fmaxf(fmaxf(a, p1[2]), p1[3]);
#pragma unroll
    for (int r = 4; r < 16; r += 4) { a = fmaxf(fmaxf(a, p0[r]), p0[r + 1]); bq = fmaxf(fmaxf(bq, p0[r + 2]), p0[r + 3]); a = fmaxf(fmaxf(a, p1[r]), p1[r + 1]); bq = fmaxf(fmaxf(bq, p1[r + 2]), p1[r + 3]); }
    a = fmaxf(a, bq); return fmaxf(a, xchg_f<32>(a, lane));
}
__device__ __forceinline__ void rescale_o(f32x16 (&o)[2], float& m, float& l, float mn, LAS float* wsf, int r32, int hi) {
    const float alpha = __builtin_amdgcn_exp2f(m - mn); l *= alpha; m = mn;
    if (hi == 0) wsf[r32] = alpha; LDS_WAIT();
#pragma unroll
    for (int r = 0; r < 16; ++r) { const float f = wsf[crow(r, hi)]; float t0 = o[0][r], t1 = o[1][r];
        asm volatile("v_mul_f32 %0, %0, %1" : "+v"(t0) : "v"(f)); asm volatile("v_mul_f32 %0, %0, %1" : "+v"(t1) : "v"(f)); o[0][r] = t0; o[1][r] = t1; }
    LDS_WAIT();
}
template <bool QK>
__device__ __forceinline__ void exp_qk(f32x16& a0, f32x16& a1, f32x16& n0, f32x16& n1, const LAS unsigned char* L, int nbuf, const bf16x8 (&qf)[4], int r32, int hi, float cs, float off, float& l, u32x4 (&pw)[4]) {
    const LAS unsigned char* kb = L + KOFF + nbuf * 8192 + hi * 1024 + r32 * 16;
    float s0 = 0.f, s1 = 0.f;
    if (QK) { n0 = (f32x16){}; n1 = (f32x16){}; }
#pragma unroll
    for (int d0 = 0; d0 < 4; ++d0) {
        if (QK) { const bf16x8 b0 = *(const LAS bf16x8*)(kb + d0 * 2048), b1 = *(const LAS bf16x8*)(kb + d0 * 2048 + 512), q = qf[d0];
            n0 = __builtin_amdgcn_mfma_f32_32x32x16_bf16(b0, q, n0, 0, 0, 0);
            n1 = __builtin_amdgcn_mfma_f32_32x32x16_bf16(b1, q, n1, 0, 0, 0); }
#pragma unroll
        for (int r = 4 * d0; r < 4 * d0 + 4; ++r) { a0[r] = __builtin_amdgcn_exp2f(__builtin_fmaf(a0[r], cs, off)); a1[r] = __builtin_amdgcn_exp2f(__builtin_fmaf(a1[r], cs, off)); s0 += a0[r]; s1 += a1[r]; }
    }
    l += s0 + s1;
#pragma unroll
    for (int k = 0; k < 2; ++k) { pw[k] = (u32x4){pk2(a0[8 * k], a0[8 * k + 1]), pk2(a0[8 * k + 2], a0[8 * k + 3]), pk2(a0[8 * k + 4], a0[8 * k + 5]), pk2(a0[8 * k + 6], a0[8 * k + 7])};
        pw[2 + k] = (u32x4){pk2(a1[8 * k], a1[8 * k + 1]), pk2(a1[8 * k + 2], a1[8 * k + 3]), pk2(a1[8 * k + 4], a1[8 * k + 5]), pk2(a1[8 * k + 6], a1[8 * k + 7])}; }
}
template <bool MX>
__device__ __forceinline__ float pv_max(f32x16 (&o)[2], const LAS unsigned char* L, int buf, const u32x4 (&pw)[4], int lane, int hi, const f32x16& n0, const f32x16& n1) {
    const LAS unsigned char* vp = L + VOFF + buf * 8192 + ((lane >> 4) & 1) * 32 + (lane & 3) * 8 + (4 * hi + ((lane & 15) >> 2)) * 64;
    float a = -INFINITY, bq = -INFINITY;
#pragma unroll
    for (int dh = 0; dh < 2; ++dh)
#pragma unroll
        for (int ks = 0; ks < 4; ++ks) {
            const s16x4 lo = vtr(vp + dh * 4096 + ks * 1024), hh = vtr(vp + dh * 4096 + ks * 1024 + 512);
            const bf16x8 vf = (bf16x8){lo[0], lo[1], lo[2], lo[3], hh[0], hh[1], hh[2], hh[3]};
            o[dh] = __builtin_amdgcn_mfma_f32_32x32x16_bf16(__builtin_bit_cast(bf16x8, pw[ks]), vf, o[dh], 0, 0, 0);
            if (MX) { const int t = 2 * (dh * 4 + ks); a = fmaxf(fmaxf(a, n0[t]), n0[t + 1]); bq = fmaxf(fmaxf(bq, n1[t]), n1[t + 1]); } }
    if (!MX) return 0.f;
    a = fmaxf(a, bq); return fmaxf(a, xchg_f<32>(a, lane));
}
#define NSA2_X(i_, P0, P1, CS, SL) do { const int j_ = TILEJ(i_); SL = TSEL(j_); const int d_ = cur - j_; \
        if (d_ < 3) { const int D0 = tq - 64 * j_ - 4 * hi; if (d_ == 0) near_scores<true>(P0, P1, tbh + D0, D0); else near_scores<false>(P0, P1, tbh + D0, D0); CS = 1.0f; } \
        else { if (WEDGE && d_ >= 8) wedge_mask(P0, P1, tq - 64 * cur - 4 * hi); CS = C2; } } while (0)
#define NSA2_BODY(idx_, A0, A1, RMA, CSA, SLA, B0, B1, RMB, CSB, SLB) do { const int i_ = (idx_); \
        if (i_ + 2 < n_) NSA_WAITV(2); else NSA_WAITV(0); \
        NSA_BAR(); \
        if (i_ + 3 < n_) { ISSUE(i_ + 3, (i_ + 3) & 3); } \
        { const float mn_ = fmaxf(m, RMA); if (__any(mn_ > m + 8.0f)) rescale_o(o, m, l, mn_, wsf, r32, hi); } \
        const float off_ = SLA ? -m : -INFINITY; \
        exp_qk<true>(A0, A1, B0, B1, L, (i_ + 1) & 3, qf, r32, hi, CSA, off_, l, pw);        \
        SLB = false; CSB = C2; \
        if (i_ + 1 < n_) { NSA2_X(i_ + 1, B0, B1, CSB, SLB); } \
        { const float a_ = pv_max<true>(o, L, i_ & 3, pw, lane, hi, B0, B1); RMB = SLB ? a_ * CSB : -INFINITY; } \
    } while (0)
#define NSA2_LOOP(NTILES) do { const int n_ = (NTILES); \
        ISSUE(0, 0); if (n_ > 1) { ISSUE(1, 1); } if (n_ > 2) { ISSUE(2, 2); } \
        if (n_ > 2) NSA_WAITV(4); else if (n_ > 1) NSA_WAITV(2); else NSA_WAITV(0); \
        NSA_BAR(); \
        bf16x8 qf[4]; _Pragma("unroll") for (int d0_ = 0; d0_ < 4; ++d0_) qf[d0_] = qr[d0_ * 64]; \
        qkt(pa0, pa1, L, 0, qr, r32, hi); NSA2_X(0, pa0, pa1, csa, sla); rma = sla ? rowmax_raw(pa0, pa1, lane) * csa : -INFINITY; \
        for (int idx = 0; idx < n_; idx += 2) { \
            NSA2_BODY(idx, pa0, pa1, rma, csa, sla, pb0, pb1, rmb, csb, slb); \
            if (idx + 1 < n_) NSA2_BODY(idx + 1, pb0, pb1, rmb, csb, slb, pa0, pa1, rma, csa, sla); } \
        NSA_BAR(); } while (0)

#define NSA_LOOP(NTILES, NDMA, ISSUE, COMPUTE) do { const int n_ = (NTILES); \
        ISSUE(0, 0); if (n_ > 1) { ISSUE(1, 1); } \
        for (int idx = 0; idx < n_; ++idx) { \
            if (idx + 1 < n_) { if (NDMA == 2) NSA_WAITV(2); else NSA_WAITV(1); } else { NSA_WAITV(0); } \
            NSA_BAR(); \
            if (idx + 2 < n_) { ISSUE(idx + 2, (idx + 2) & 3); } \
            COMPUTE(idx, idx & 3); } \
        NSA_BAR(); } while (0)

template <int VAR>
__device__ __forceinline__ void attn_unit(const Frame& F, int b, int g, int cur, bf16* Y, bool FILL_TB) {
    LAS unsigned char* L = F.lds;
    int lane_ = F.lane; asm volatile("" : "+v"(lane_));
    const int lane = lane_, wid = F.wave, r32 = lane & 31, hi = lane >> 5, tid = F.tid;
    const bf16* Z = (const bf16*)(F.ws + WS_Z);
    const int qi = r32 >> 2, hp = r32 & 3, head = g * 4 + hp;
    const int tq = cur * 64 + wid * 8 + qi;
    const size_t zrow = (size_t)(b * SEQ + tq) * ZP;
    LAS float* tb = (LAS float*)(L + TBOFF);
    if (FILL_TB) for (int i = tid; i < 4 * 384; i += NTHR) { const int hpp = i / 384, dd = i % 384 - 64; tb[i] = (dd >= 0 && dd < 128) ? (F.in[15][T5B[dd & 127] * 8 + g * 4 + hpp] - F.in[15][31 * 8 + g * 4 + hpp]) * LOG2E : 0.f; }
    const LAS float* tbh = tb + hp * 384 + 64;
    LAS bf16x8* qr = (LAS bf16x8*)(L + (wid == 0 ? QOFF0 : TAB_OFF + (wid - 1) * 4096)) + lane;
#pragma unroll
    for (int d0 = 0; d0 < 4; ++d0) qr[d0 * 64] = *(const bf16x8*)(Z + zrow + ZC_QA + head * 64 + d0 * 16 + hi * 8);
#define NSA_GATE(br) sigmoidf_(bf2f(Z[zrow + ZC_GA + head * 3 + (br)]))
    LAS float* wsf = (LAS float*)(L + WSFOFF) + wid * 64;
    LAS unsigned long long* msk = (LAS unsigned long long*)(L + MSKOFF);
    LAS unsigned long long* uni = (LAS unsigned long long*)(L + UNIOFF);
    LAS int* jl = (LAS int*)(L + JLOFF);
    LAS bf16* oa = (LAS bf16*)(L + OACCOFF) + wid * 2048;
    LAS float* sc = (LAS float*)oa;
    f32x16 p0, p1, o[2]; u32x4 pw[4];
    NSA_BAR();

    {
        const bf16* KCb = (const bf16*)(F.ws + WS_KC) + (size_t)((b * 2 + g) * 256) * 64;
        const bf16* VCb = (const bf16*)(F.ws + WS_VC) + (size_t)((b * 2 + g) * 256) * 64;
        const int nT = (4 * cur + 2) / 64 + 1;
        float m = -1e30f, l = 0.f;
#define B1_COMP1(T, s) do { qkt(p0, p1, L, s, qr, r32, hi); \
            if (cur >= 16 * (T) + 19) softmax_fast<false>(p0, p1, m, l, o, pw, wsf, r32, hi, true); \
            else { score_tile(p0, p1, tq - 31 - 16 * 64 * (T), -16, 1 << 30, true, true, tbh, hi); softmax_step<false>(p0, p1, m, l, o, pw, wsf, r32, hi); } } while (0)
        for (int T = 0; T < nT; ++T) { dma_k(L, T, wid, lane, KCb + (size_t)T * 64 * 64, 64); dma_v(L, T, wid, lane, VCb + (size_t)T * 64 * 64, 64); }
        NSA_WAITV(0); NSA_BAR();
        for (int T = 0; T < nT; ++T) B1_COMP1(T, T);
        const float lt = l + xchg_f<32>(l, lane); const float inv_l = lt > 0.f ? 1.0f / lt : 0.f;
        o[0] = (f32x16){}; o[1] = (f32x16){};
        float carry = 0.f;
#define B1_COMP2(T, s) do { qkt(p0, p1, L, s, qr, r32, hi); \
            if (cur >= 16 * (T) + 19) { _Pragma("unroll") for (int r = 0; r < 16; ++r) { p0[r] *= C2; p1[r] *= C2; } } \
            else score_tile(p0, p1, tq - 31 - 16 * 64 * (T), -16, 1 << 30, true, true, tbh, hi); \
            float ps8[9]; \
            _Pragma("unroll") for (int i = 0; i < 9; ++i) ps8[i] = 0.f; \
            ps8[0] = (hi == 0) ? carry : 0.f; \
            _Pragma("unroll") for (int r = 0; r < 16; ++r) { p0[r] = __builtin_amdgcn_exp2f(p0[r] - m) * inv_l; p1[r] = __builtin_amdgcn_exp2f(p1[r] - m) * inv_l; } \
            _Pragma("unroll") for (int sub = 0; sub < 2; ++sub) _Pragma("unroll") for (int n = 0; n < 4; ++n) { \
                const float q0 = sub ? p1[4 * n] : p0[4 * n], q1 = sub ? p1[4 * n + 1] : p0[4 * n + 1], q2 = sub ? p1[4 * n + 2] : p0[4 * n + 2], q3 = sub ? p1[4 * n + 3] : p0[4 * n + 3]; \
                const float a = (q0 + q1) + (q2 + 0.5f * q3), bq = 0.5f * q3, bsw = xhalf(bq, hi); \
                if (hi == 1) ps8[sub * 4 + n] += a + bsw; else { ps8[sub * 4 + n] += a; ps8[sub * 4 + n + 1] += bsw; } } \
            carry = ps8[8]; \
            _Pragma("unroll") for (int i = 0; i < 8; ++i) { float v = ps8[i]; v += dpp_xor1(v); v += dpp_xor2(v); if (hp == 0) sc[qi * 64 + 16 * (T) + 2 * i + hi] = v; } \
            _Pragma("unroll") for (int k = 0; k < 2; ++k) { pw[k] = (u32x4){pk2(p0[8 * k], p0[8 * k + 1]), pk2(p0[8 * k + 2], p0[8 * k + 3]), pk2(p0[8 * k + 4], p0[8 * k + 5]), pk2(p0[8 * k + 6], p0[8 * k + 7])}; \
                pw[2 + k] = (u32x4){pk2(p1[8 * k], p1[8 * k + 1]), pk2(p1[8 * k + 2], p1[8 * k + 3]), pk2(p1[8 * k + 4], p1[8 * k + 5]), pk2(p1[8 * k + 6], p1[8 * k + 7])}; } \
            pv(o, L, s, pw, lane, hi); } while (0)
        for (int T = 0; T < nT; ++T) B1_COMP2(T, T);
        NSA_BAR();
    }
    unsigned long long mymask; int nsel;
    {
        LDS_WAIT();
        f32x4 va = {0.f, 0.f, 0.f, 0.f}, vb = va;
        if (cur >= 16) { va = *(const LAS f32x4*)(sc + (lane >> 3) * 64 + (lane & 7) * 8); vb = *(const LAS f32x4*)(sc + (lane >> 3) * 64 + (lane & 7) * 8 + 4); }
        branch_merge<true>(oa, o, 0.5f, NSA_GATE(0), wsf, r32, hi, lane);
        if (cur >= 16) {
            {
                const int q = lane >> 3, ch = lane & 7;
                unsigned bits[8]; unsigned vmask = 0u;
#pragma unroll
                for (int j = 0; j < 8; ++j) { const int blk = ch * 8 + j; const bool valid = blk <= cur; const bool forced = (blk == 0) || (blk == cur) || (blk == cur - 1);
                    const float v = (j < 4 ? va[j & 3] : vb[j & 3]) + (forced ? 1000.f : 0.f);
                    bits[j] = valid ? (__float_as_uint(v) & 0xfffff000u) : 0u; vmask |= valid ? (1u << j) : 0u; }
#define SUM8(x) do { x += __builtin_amdgcn_mov_dpp(x, 0xB1, 0xF, 0xF, true); x += __builtin_amdgcn_mov_dpp(x, 0x4E, 0xF, 0xF, true); x += __builtin_amdgcn_mov_dpp(x, 0x141, 0xF, 0xF, true); } while (0)
                unsigned T = 0u;
#pragma unroll
                for (int bt = 30; bt >= 12; --bt) { const unsigned cand = T | (1u << bt); int cnt = 0;
#pragma unroll
                    for (int j = 0; j < 8; ++j) cnt += (bits[j] >= cand) ? 1 : 0;
                    SUM8(cnt); T = (cnt >= 16) ? cand : T; }
                int ngt = 0, eqc = 0; unsigned gtm = 0u, eqm = 0u;
#pragma unroll
                for (int j = 0; j < 8; ++j) { const bool g_ = bits[j] > T, e_ = (bits[j] == T) && ((vmask >> j) & 1u); gtm |= g_ ? (1u << j) : 0u; eqm |= e_ ? (1u << j) : 0u; ngt += g_ ? 1 : 0; eqc += e_ ? 1 : 0; }
                SUM8(ngt);
                int pre = eqc;
                { int t = __builtin_amdgcn_mov_dpp(pre, 0x111, 0xF, 0xF, true); if (ch >= 1) pre += t; t = __builtin_amdgcn_mov_dpp(pre, 0x112, 0xF, 0xF, true); if (ch >= 2) pre += t; t = __builtin_amdgcn_mov_dpp(pre, 0x114, 0xF, 0xF, true); if (ch >= 4) pre += t; }
                int run = pre - eqc; const int need = 16 - ngt; unsigned m8 = gtm;
#pragma unroll
                for (int j = 0; j < 8; ++j) { const bool e_ = (eqm >> j) & 1u; if (e_ && run < need) m8 |= 1u << j; run += e_ ? 1 : 0; }
                ((LAS unsigned char*)msk)[(wid * 8 + q) * 8 + ch] = (unsigned char)m8;
#undef SUM8
            }
        } else {
            if (lane < 8) msk[wid * 8 + lane] = (2ull << cur) - 1ull;
        }
        LDS_WAIT();
        mymask = msk[wid * 8 + qi];
        unsigned long long u = mymask;
#pragma unroll
        for (int o_ = 4; o_ < 32; o_ <<= 1) { const unsigned lo = __shfl_xor((unsigned)u, o_), hh = __shfl_xor((unsigned)(u >> 32), o_); u |= ((unsigned long long)hh << 32) | lo; }
        if (lane == 0) uni[wid] = u;
        NSA_BAR();
        unsigned long long umask = 0ull;
#pragma unroll
        for (int w = 0; w < 8; ++w) umask |= uni[w];
        umask = ((unsigned long long)__builtin_amdgcn_readfirstlane((unsigned)(umask >> 32)) << 32) | (unsigned)__builtin_amdgcn_readfirstlane((unsigned)umask);
        nsel = __builtin_popcountll(umask);
        if (wid == 0 && ((umask >> lane) & 1ull)) jl[__builtin_popcountll(umask & ((1ull << lane) - 1ull))] = lane;
        NSA_BAR();
    }
    {
        const bf16* Kb = Z + (size_t)(b * SEQ) * ZP + ZC_KS + g * 64; const bf16* Vb = Z + (size_t)(b * SEQ) * ZP + ZC_VS + g * 64;
        float m = -1e30f, l = 0.f; o[0] = (f32x16){}; o[1] = (f32x16){};
f32x16 pa0, pa1, pb0, pb1; float rma, rmb = 0.f, csa, csb = 0.f; bool sla, slb = false;
#define ISSUE(i_, s) do { const int jj_ = __builtin_amdgcn_readfirstlane(jl[i_]); dma_k(L, s, wid, lane, Kb + (size_t)(64 * jj_) * ZP, ZP); dma_v(L, s, wid, lane, Vb + (size_t)(64 * jj_) * ZP, ZP); } while (0)
#define TILEJ(i_) __builtin_amdgcn_readfirstlane(jl[i_])
#define TSEL(j_) (((mymask >> (j_)) & 1ull) != 0ull)
#define WEDGE false
        NSA2_LOOP(nsel);
#undef ISSUE
#undef TILEJ
#undef TSEL
#undef WEDGE
        branch_merge<false>(oa, o, l, NSA_GATE(1), wsf, r32, hi, lane);
    }
    {
        const bf16* Kb = Z + (size_t)(b * SEQ) * ZP + ZC_KW + g * 64; const bf16* Vb = Z + (size_t)(b * SEQ) * ZP + ZC_VW + g * 64;
        float m = -1e30f, l = 0.f; o[0] = (f32x16){}; o[1] = (f32x16){};
        const int j0 = cur >= 8 ? cur - 8 : 0, nT = cur - j0 + 1;
f32x16 pa0, pa1, pb0, pb1; float rma, rmb = 0.f, csa, csb = 0.f; bool sla, slb = false;
#define ISSUE(T, s) do { dma_k(L, s, wid, lane, Kb + (size_t)(64 * (j0 + (T))) * ZP, ZP); dma_v(L, s, wid, lane, Vb + (size_t)(64 * (j0 + (T))) * ZP, ZP); } while (0)
#define TILEJ(i_) (j0 + (i_))
#define TSEL(j_) true
#define WEDGE true
        NSA2_LOOP(nT);
#undef ISSUE
#undef TILEJ
#undef TSEL
#undef WEDGE
        branch_merge<false>(oa, o, l, NSA_GATE(2), wsf, r32, hi, lane);
    }
#pragma unroll
    for (int r = 0; r < 16; ++r) { const int row = crow(r, hi), q_ = row >> 2, hp_ = row & 3;
        bf16* dst = Y + (size_t)(b * SEQ + cur * 64 + wid * 8 + q_) * 1024 + 512 + (g * 4 + hp_) * 64 + r32;
        dst[0] = oa[(2 * r) * 64 + lane]; dst[32] = oa[(2 * r + 1) * 64 + lane]; }
#undef B1_COMP1
#undef B1_COMP2
#undef NSA_GATE
}
template <int VAR>
__device__ __forceinline__ void p4_attention(Frame& F, bf16* Y) {
    for (int v = F.vcu; v < 256; v += F.G) {
        const int bg = v >> 5, s = v & 31;
#pragma unroll 1
        for (int u2 = 0; u2 < 2; ++u2) attn_unit<VAR>(F, bg >> 1, bg & 1, u2 ? s : 63 - s, Y, u2 == 0);
    }
}
}

__device__ __forceinline__ f32x16 mma32_lds(const LAS bf16* A, int sa, const LAS bf16* Bt, int sb, int ksteps, int r32, int hi, f32x16 acc) {
#pragma unroll
    for (int ks = 0; ks < 8; ++ks) if (ks < ksteps) {
        const bf16x8 a = *(const LAS bf16x8*)(A + r32 * sa + ks * 16 + hi * 8), bq = *(const LAS bf16x8*)(Bt + r32 * sb + ks * 16 + hi * 8);
        acc = __builtin_amdgcn_mfma_f32_32x32x16_bf16(a, bq, acc, 0, 0, 0); }
    return acc;
}
__device__ __forceinline__ void p5_mlstm_c_items(Frame& F) {
    const int tid = F.tid, lane = F.lane, r32 = lane & 31, hi = lane >> 5, wid = F.wave;
    LAS bf16* Qs = (LAS bf16*)F.lds;
    LAS bf16* Qp = Qs + 64 * QS_STRIDE;
    LAS bf16* Ks = Qp + 64 * QS_STRIDE;
    LAS bf16* VT = Ks + 64 * QS_STRIDE;
    LAS bf16* CT = VT + 128 * KT_STRIDE;
    LAS bf16* Wm = CT + 128 * QS_STRIDE;
    LAS float* fu = (LAS float*)(Wm + 64 * KT_STRIDE);
    LAS float* frd = fu + 256; LAS float* fnp = fu + 320;
    LAS float* gtab = (LAS float*)(F.lds + 120 * 1024);
    LAS float* cwl = (LAS float*)(F.lds + 124 * 1024);
    const bf16* Z = (const bf16*)(F.ws + WS_Z);
    ConvRaw rq[2], rk[2]; bf16x8 rvv[2]; u32x4 cpv[4]; unsigned short ogn[16]; float np_n = 0.f;
#define P5_LOAD(item_) do { const int b_ = (item_) >> 8, h_ = ((item_) >> 6) & 3, c_ = (item_) & 63; \
    _Pragma("unroll") for (int rep = 0; rep < 2; ++rep) { const int task = tid + NTHR * rep, l = task >> 4, ch = task & 15, t = c_ * 64 + l; \
        conv8_load(F, b_, t, ZC_QM + h_ * 128 + ch * 8, rq[rep]); conv8_load(F, b_, t, ZC_KM + h_ * 128 + ch * 8, rk[rep]); \
        rvv[rep] = *(const bf16x8*)(Z + (size_t)(b_ * SEQ + t) * ZP + ZC_VM + h_ * 128 + ch * 8); } \
    { const bf16* cp = (const bf16*)(F.ws + WS_CP) + (size_t)(item_) * 16384; \
      _Pragma("unroll") for (int i = 0; i < 4; ++i) { const int q = tid + NTHR * i; cpv[i] = *(const u32x4*)(cp + q * 8); } } \
    { const int lt = wid & 1, et = wid >> 1; \
      _Pragma("unroll") for (int r = 0; r < 16; ++r) ogn[r] = Z[(size_t)(b_ * SEQ + c_ * 64 + lt * 32 + crow(r, hi)) * ZP + ZC_OM + h_ * 128 + et * 32 + r32]; } \
    if (tid >= 64 && tid < 192) np_n = ((const float*)(F.ws + WS_NP))[(size_t)(item_) * 128 + tid - 64]; } while (0)
    int item = F.vcu, kb = 0, cur_h = -1;
    if (item >= 1024) return;
    P5_LOAD(item);
    for (;;) {
    const int b = item >> 8, h = (item >> 6) & 3, c = item & 63;
    if ((kb & 3) == 0 && wid < 4) {
        const int it2 = item + wid * F.G;
        if (it2 < 1024) { const int b2 = it2 >> 8, h2 = (it2 >> 6) & 3, c2 = it2 & 63; const size_t zr = (size_t)(b2 * SEQ + c2 * 64 + lane) * ZP;
            const float ig = bf2f(Z[zr + ZC_IG + h2]) + F.in[9][h2]; float g = logsigmoidf_(bf2f(Z[zr + ZC_FG + h2]) + F.in[9][4 + h2]);
            const float Mp = ((const float*)(F.ws + WS_SC))[2048 + it2];
#pragma unroll
            for (int o = 1; o < 64; o <<= 1) { const float t = __shfl_up(g, o); if (lane >= o) g += t; }
            const float u = ig - g; float pm = u;
#pragma unroll
            for (int o = 1; o < 64; o <<= 1) { const float t = __shfl_up(pm, o); if (lane >= o) pm = fmaxf(pm, t); }
            const float mm = fmaxf(Mp, pm);
            LAS float* gt = gtab + wid * 256;
            gt[lane] = u; gt[64 + lane] = mm; gt[128 + lane] = __expf(Mp - mm); gt[192 + lane] = __expf(-(g + mm)); } }
    if (h != cur_h) {
#pragma unroll
        for (int k = 0; k < 2; ++k) { const int i = tid + NTHR * k, tap = i >> 8, lc = i & 255; cwl[i] = F.in[10][tap * 1024 + (lc < 128 ? h * 128 + lc : 512 + h * 128 + lc - 128)]; }
        cur_h = h; }
    const LAS float* fu = gtab + (kb & 3) * 256; const LAS float* fmm = fu + 64; const LAS float* fiw = fu + 128; const LAS float* ffl = fu + 192;
    if (tid >= 64 && tid < 192) fnp[tid - 64] = np_n;
    __syncthreads();
#pragma unroll
    for (int rep = 0; rep < 2; ++rep) { const int task = tid + NTHR * rep, l = task >> 4, ch = task & 15;
        float qq[8], kk[8];
        conv8_calc_lds(cwl, 256, rq[rep], ch * 8, qq);
        conv8_calc_lds(cwl, 256, rk[rep], 128 + ch * 8, kk);
        const float iw = fiw[l];
        u32x4 wq, wp, wk;
        wq.x = pk2(qq[0], qq[1]); wq.y = pk2(qq[2], qq[3]); wq.z = pk2(qq[4], qq[5]); wq.w = pk2(qq[6], qq[7]);
        wp.x = pk2(qq[0] * iw, qq[1] * iw); wp.y = pk2(qq[2] * iw, qq[3] * iw); wp.z = pk2(qq[4] * iw, qq[5] * iw); wp.w = pk2(qq[6] * iw, qq[7] * iw);
        const float sk = 0.08838834764831845f;
        wk.x = pk2(kk[0] * sk, kk[1] * sk); wk.y = pk2(kk[2] * sk, kk[3] * sk); wk.z = pk2(kk[4] * sk, kk[5] * sk); wk.w = pk2(kk[6] * sk, kk[7] * sk);
        *(LAS u32x4*)(Qs + l * QS_STRIDE + ch * 8) = wq; *(LAS u32x4*)(Qp + l * QS_STRIDE + ch * 8) = wp; *(LAS u32x4*)(Ks + l * QS_STRIDE + ch * 8) = wk;
        const bf16x8 vv = rvv[rep];
#pragma unroll
        for (int j = 0; j < 8; ++j) VT[(ch * 8 + j) * KT_STRIDE + l] = (bf16)vv[j]; }
    {
#pragma unroll
        for (int i = 0; i < 4; ++i) { const int q = tid + NTHR * i, e = q >> 4, d8 = (q & 15) * 8; *(LAS u32x4*)(CT + e * QS_STRIDE + d8) = cpv[i]; } }
    unsigned short og[16];
#pragma unroll
    for (int r = 0; r < 16; ++r) og[r] = ogn[r];
    const int nitem = item + F.G;
    if (nitem < 1024) P5_LOAD(nitem);
    __syncthreads();
    if (wid < 4) {
        const int lt = wid >> 1, st = wid & 1;
        f32x16 acc = {}; acc = mma32_lds(Qs + lt * 32 * QS_STRIDE, QS_STRIDE, Ks + st * 32 * QS_STRIDE, QS_STRIDE, 8, r32, hi, acc);
        const int s = st * 32 + r32; const float us = fu[s];
#pragma unroll
        for (int r = 0; r < 16; ++r) { const int l = lt * 32 + crow(r, hi); const float w = (s <= l) ? __expf(us - fmm[l]) * acc[r] : 0.f; Wm[l * KT_STRIDE + s] = (bf16)f2bf(w); }
    }
    __syncthreads();
    {
        const int l = tid >> 3, part = tid & 7; float dsum = 0.f;
#pragma unroll
        for (int s = 0; s < 8; ++s) dsum += bf2f(Wm[l * KT_STRIDE + part * 8 + s]);
#pragma unroll
        for (int d = 0; d < 16; ++d) dsum += bf2f(Qp[l * QS_STRIDE + part * 16 + d]) * fnp[part * 16 + d];
        dsum += __shfl_xor(dsum, 1); dsum += __shfl_xor(dsum, 2); dsum += __shfl_xor(dsum, 4);
        if (part == 0) frd[l] = 1.0f / fmaxf(fabsf(dsum), ffl[l]);
    }
    f32x16 acc = {};
    {
        const int lt = wid & 1, et = wid >> 1;
        acc = mma32_lds(Wm + lt * 32 * KT_STRIDE, KT_STRIDE, VT + et * 32 * KT_STRIDE, KT_STRIDE, 4, r32, hi, acc);
        acc = mma32_lds(Qp + lt * 32 * QS_STRIDE, QS_STRIDE, CT + et * 32 * QS_STRIDE, QS_STRIDE, 8, r32, hi, acc);
        __syncthreads();
        bf16* Y = (bf16*)(F.ws + WS_YMIX);
        const int e = et * 32 + r32;
#pragma unroll
        for (int r = 0; r < 16; ++r) { const int l = lt * 32 + crow(r, hi); const size_t row = (size_t)(b * SEQ + c * 64 + l);
            Y[row * 1024 + h * 128 + e] = (bf16)f2bf(acc[r] * frd[l] * sigmoidf_(bf2f(og[r]))); }
    }
    __syncthreads();
    if (nitem >= 1024) break;
    item = nitem; ++kb;
    }
#undef P5_LOAD
}

template <int L> __device__ __forceinline__ float rtree(const LAS float* WR, const f32x4 (&h2)[4], int base, int lane) {
    if constexpr (L == 0) { float s = 0.f;
#pragma unroll
        for (int j = 0; j < 4; ++j) { const f32x4 w = *(const LAS f32x4*)(WR + base * 1024 + 4 * lane + 256 * j); s += (h2[j].x * w.x + h2[j].y * w.y) + (h2[j].z * w.z + h2[j].w * w.w); }
        return s;
    } else {
        const float lo = rtree<L - 1>(WR, h2, base, lane), hh = rtree<L - 1>(WR, h2, base + (1 << (L - 1)), lane);
        const bool up = (lane & (1 << L)) != 0;
        return (up ? hh : lo) + __shfl_xor(up ? lo : hh, 1 << L);
    }
}
__device__ __forceinline__ void wave_sum2(float (&v)[2]) {
    const int lane = threadIdx.x & 63;
#define WS2_STEP(M) do { const float a = xchg_f<M>(v[0], lane), b = xchg_f<M>(v[1], lane); v[0] += a; v[1] += b; } while (0)
    WS2_STEP(1); WS2_STEP(2); WS2_STEP(4); WS2_STEP(8); WS2_STEP(16); WS2_STEP(32);
#undef WS2_STEP
}
#define RT_MASK(L) ((L) == 1 ? 1 : (L) == 2 ? 2 : (L) == 3 ? 32 : (L) == 4 ? 4 : 8)
__device__ __forceinline__ int router_expert(int lane) { return (lane & 3) | (((lane >> 5) & 1) << 2) | (((lane >> 2) & 3) << 3); }
template <int L> __device__ __forceinline__ f32x2 rtree2(const LAS float* WR, const f32x4 (&h2)[2][4], int base, int lane) {
    if constexpr (L == 0) { f32x2 a0 = {0.f, 0.f}, a1 = {0.f, 0.f};
#pragma unroll
        for (int j = 0; j < 4; ++j) { const f32x4 w = *(const LAS f32x4*)(WR + base * 1024 + 4 * lane + 256 * j);
            const f32x2 wl = {w.x, w.y}, wh = {w.z, w.w};
            a0 = __builtin_elementwise_fma((f32x2){h2[0][j].x, h2[0][j].y}, wl, a0); a0 = __builtin_elementwise_fma((f32x2){h2[0][j].z, h2[0][j].w}, wh, a0);
            a1 = __builtin_elementwise_fma((f32x2){h2[1][j].x, h2[1][j].y}, wl, a1); a1 = __builtin_elementwise_fma((f32x2){h2[1][j].z, h2[1][j].w}, wh, a1); }
        f32x2 s; s.x = a0.x + a0.y; s.y = a1.x + a1.y;
        return s;
    } else {
        const f32x2 lo = rtree2<L - 1>(WR, h2, base, lane), hh = rtree2<L - 1>(WR, h2, base + (1 << (L - 1)), lane);
        const bool up = (lane & RT_MASK(L)) != 0;
        f32x2 r; r.x = (up ? hh.x : lo.x) + xchg_f<RT_MASK(L)>(up ? lo.x : hh.x, lane); r.y = (up ? hh.y : lo.y) + xchg_f<RT_MASK(L)>(up ? lo.y : hh.y, lane);
        return r;
    }
}
__device__ __forceinline__ void p7_rows(Frame& F) {
    LAS float* WR = (LAS float*)F.lds;
    LAS int* lcnt = (LAS int*)(F.lds + TAB_OFF);
    LAS int* gbase = lcnt + 32;
    LAS int* rinfo = gbase + 32;
    const float* MODF = (const float*)(F.ws + WS_MODF);
    const int lane = F.lane, tid = F.tid;
    {
        f32x4 wv[16];
#pragma unroll
        for (int i = 0; i < 16; ++i) wv[i] = ((const f32x4*)(F.ws + WS_WRT))[tid + NTHR * i];
#pragma unroll
        for (int i = 0; i < 16; ++i) ((LAS f32x4*)WR)[tid + NTHR * i] = wv[i]; }
    for (int rb = F.vcu; rb < M / 64; rb += F.G) {
        const int b = (rb * 64) / SEQ;
        if (tid < 32) lcnt[tid] = 0;
        __syncthreads();
        LAS float* A7 = (LAS float*)(F.lds + TAB_OFF + 4096); LAS float* G2 = A7 + 1024; LAS float* S2 = G2 + 1024;
        for (int c0 = tid; c0 < 1024; c0 += NTHR) { A7[c0] = F.in[5][c0] * MODF[b * 6144 + 2048 + c0]; G2[c0] = F.in[6][c0] * (MODF[b * 6144 + 4096 + c0] + 1.0f); S2[c0] = MODF[b * 6144 + 3072 + c0]; }
        __syncthreads();
        u32x2 yw[2][2][4]; f32x4 xw[2][2][4];
        const int row0 = rb * 64 + F.wave * 8;
#pragma unroll
        for (int r = 0; r < 2; ++r) { const u32x2* yr = (const u32x2*)((const bf16*)(F.ws + WS_Y) + (size_t)(row0 + r) * 1024) + lane; const f32x4* xr = (const f32x4*)(F.in[0] + (size_t)(row0 + r) * 1024) + lane;
#pragma unroll
            for (int j = 0; j < 4; ++j) { yw[0][r][j] = yr[64 * j]; xw[0][r][j] = xr[64 * j]; } }
        const float brt = F.in[18][router_expert(lane)];
#pragma unroll
        for (int ip = 0; ip < 4; ++ip) {
            const int rl0 = F.wave * 8 + 2 * ip, rowp = rb * 64 + rl0;
            if (ip < 3) {
#pragma unroll
                for (int r = 0; r < 2; ++r) { const u32x2* yr = (const u32x2*)((const bf16*)(F.ws + WS_Y) + (size_t)(rowp + 2 + r) * 1024) + lane; const f32x4* xr = (const f32x4*)(F.in[0] + (size_t)(rowp + 2 + r) * 1024) + lane;
#pragma unroll
                    for (int j = 0; j < 4; ++j) { yw[(ip + 1) & 1][r][j] = yr[64 * j]; xw[(ip + 1) & 1][r][j] = xr[64 * j]; } } }
            f32x4 y[2][4], x1[2][4], h2[2][4]; float ss[2] = {0.f, 0.f};
#pragma unroll
            for (int r = 0; r < 2; ++r)
#pragma unroll
                for (int j = 0; j < 4; ++j) { const u32x2 w = yw[ip & 1][r][j]; y[r][j] = (f32x4){bf2f(w.x & 0xffffu), bf2f(w.x >> 16), bf2f(w.y & 0xffffu), bf2f(w.y >> 16)};
                    ss[r] += (y[r][j].x * y[r][j].x + y[r][j].y * y[r][j].y) + (y[r][j].z * y[r][j].z + y[r][j].w * y[r][j].w); }
            wave_sum2(ss);
            float s1[2] = {0.f, 0.f};
#pragma unroll
            for (int r = 0; r < 2; ++r) { const float rs = rsqrtf(ss[r] * (1.0f / 1024.0f) + EPS);
#pragma unroll
                for (int j = 0; j < 4; ++j) { x1[r][j] = xw[ip & 1][r][j] + *(const LAS f32x4*)(A7 + 4 * lane + 256 * j) * (y[r][j] * rs); s1[r] += (x1[r][j].x * x1[r][j].x + x1[r][j].y * x1[r][j].y) + (x1[r][j].z * x1[r][j].z + x1[r][j].w * x1[r][j].w);
                    { u32x2 w; w.x = pk2(x1[r][j].x, x1[r][j].y); w.y = pk2(x1[r][j].z, x1[r][j].w); ((u32x2*)((bf16*)(F.ws + WS_YMIX) + (size_t)(rowp + r) * 1024))[lane + 64 * j] = w; } } }
            wave_sum2(s1);
#pragma unroll
            for (int r = 0; r < 2; ++r) { const float rs1 = rsqrtf(s1[r] * (1.0f / 1024.0f) + EPS);
                unsigned* ho = (unsigned*)(F.ws + WS_H + (size_t)(rowp + r) * 1024) + lane;
#pragma unroll
                for (int j = 0; j < 4; ++j) { h2[r][j] = x1[r][j] * rs1 * *(const LAS f32x4*)(G2 + 4 * lane + 256 * j) + *(const LAS f32x4*)(S2 + 4 * lane + 256 * j); ho[64 * j] = pk4_fp8(h2[r][j].x, h2[r][j].y, h2[r][j].z, h2[r][j].w); } }
            f32x2 lg = rtree2<5>(WR, h2, 0, lane);
            lg.x += __shfl_xor(lg.x, 16); lg.y += __shfl_xor(lg.y, 16);
            lg.x += brt; lg.y += brt;
            const int e = router_expert(lane);
            float tvv[2][4]; int tee[2][4]; float cand0 = lg.x, cand1 = lg.y;
#define TOPK_STEP(MASK) do { const float ov0 = xchg_f<MASK>(v0, lane), ov1 = xchg_f<MASK>(v1, lane); const int oi0 = xchg_i<MASK>(i0, lane), oi1 = xchg_i<MASK>(i1, lane); \
                    if (ov0 > v0 || (ov0 == v0 && oi0 < i0)) { v0 = ov0; i0 = oi0; } if (ov1 > v1 || (ov1 == v1 && oi1 < i1)) { v1 = ov1; i1 = oi1; } } while (0)
#pragma unroll
            for (int k = 0; k < 4; ++k) { float v0 = cand0, v1 = cand1; int i0 = e, i1 = e;
                TOPK_STEP(1); TOPK_STEP(2); TOPK_STEP(32); TOPK_STEP(4); TOPK_STEP(8);
                tvv[0][k] = v0; tee[0][k] = i0; tvv[1][k] = v1; tee[1][k] = i1; if (e == i0) cand0 = -INFINITY; if (e == i1) cand1 = -INFINITY; }
#undef TOPK_STEP
#pragma unroll
            for (int r = 0; r < 2; ++r) { int te[4]; float tv[4];
#pragma unroll
                for (int k = 0; k < 4; ++k) { te[k] = tee[r][k]; tv[k] = tvv[r][k]; }
                const float e1 = __expf(tv[1] - tv[0]), e2 = __expf(tv[2] - tv[0]), e3 = __expf(tv[3] - tv[0]); const float inv = 1.0f / (1.0f + e1 + e2 + e3);
                if (lane < 4) { const int ek = lane == 0 ? te[0] : lane == 1 ? te[1] : lane == 2 ? te[2] : te[3]; const float gk = (lane == 0 ? 1.0f : lane == 1 ? e1 : lane == 2 ? e2 : e3) * inv;
                    const int lr = __hip_atomic_fetch_add(&lcnt[ek], 1, __ATOMIC_RELAXED, __HIP_MEMORY_SCOPE_WORKGROUP); const int rl = rl0 + r;
                    rinfo[(rl * 4 + lane) * 3 + 0] = ek; rinfo[(rl * 4 + lane) * 3 + 1] = lr; rinfo[(rl * 4 + lane) * 3 + 2] = __float_as_int(gk); } }
        }
        __syncthreads();
        if (tid < 32) gbase[tid] = (int)__hip_atomic_fetch_add(F.ctl + CW_CNT + 64 * tid, (unsigned)lcnt[tid], RLX_AGENT);
        __syncthreads();
        if (tid < 256) { const int rl = tid >> 2, k = tid & 3, row = rb * 64 + rl; const int ek = rinfo[tid * 3], rank = gbase[ek] + rinfo[tid * 3 + 1];
            ((int*)(F.ws + WS_TOKE))[row * 4 + k] = ek; ((int*)(F.ws + WS_TOKR))[row * 4 + k] = rank; ((int*)(F.ws + WS_TOKG))[row * 4 + k] = rinfo[tid * 3 + 2];
            ((int*)(F.ws + WS_ROWTOK))[(size_t)ek * ECAP + rank] = row; }
        __syncthreads();
    }
}

struct MoeTabs { LAS int* cnt; LAS int* tbase; LAS int* tile_e; LAS int* tile_r0; LAS int* idx; };
__device__ __forceinline__ MoeTabs moe_tabs(const Frame& F) { MoeTabs t; t.cnt = (LAS int*)(F.lds + TAB_OFF); t.tbase = t.cnt + 32; t.tile_e = t.tbase + 40; t.tile_r0 = t.tile_e + MAXT; t.idx = t.tile_r0 + MAXT; return t; }
__device__ __forceinline__ int moe_build_tabs(const Frame& F, const MoeTabs& T) {
    if (F.tid < 32) T.cnt[F.tid] = (int)__hip_atomic_load(F.ctl + CW_CNT + 64 * F.tid, RLX_AGENT);
    __syncthreads();
    if (F.tid < 32) { int s0 = 0, tot = 0;
#pragma unroll
        for (int e = 0; e < 32; ++e) { const int n = (T.cnt[e] + 255) >> 8; s0 += (e < F.tid) ? n : 0; tot += n; }
        T.tbase[F.tid] = s0; if (F.tid == 0) T.tbase[32] = tot;
        const int n = (T.cnt[F.tid] + 255) >> 8; for (int t = 0; t < n; ++t) { T.tile_e[s0 + t] = F.tid; T.tile_r0[s0 + t] = t * 256; } }
    __syncthreads();
    return T.tbase[32];
}
constexpr int MAXU = 12;
struct MoeUpSched {
    int NT, G, c; LAS const int* tile_e; LAS const int* idx;
    __device__ __forceinline__ bool next(int i, pg8::Unit& u) const { const int L = i * G + c; if (L >= NT * 8 || i >= MAXU) return false; u.pm = L >> 3; u.pn = L & 7; u.e = tile_e[u.pm]; u.ui = i; return true; }
    __device__ __forceinline__ unsigned arow(const pg8::Unit& u, int r) const { return (unsigned)idx[u.ui * 256 + r]; }
    __device__ __forceinline__ size_t boff(const pg8::Unit& u) const { return ((size_t)u.e * 2048 + (size_t)u.pn * 256) * 1024; }
};
struct MoeDownSched {
    int NT, G, c; LAS const int* tile_e;
    __device__ __forceinline__ bool next(int i, pg8::Unit& u) const { const int L = i * G + c; if (L >= NT * 4) return false; u.pm = L >> 2; u.pn = L & 3; u.e = tile_e[u.pm]; u.ui = i; return true; }
    __device__ __forceinline__ unsigned arow(const pg8::Unit& u, int r) const { return (unsigned)(u.pm * 256 + r); }
    __device__ __forceinline__ size_t boff(const pg8::Unit& u) const { return ((size_t)u.e * 1024 + (size_t)u.pn * 256) * 1024; }
};

__device__ __forceinline__ void p11_final(Frame& F, float* dstp) {
    const MoeTabs T = moe_tabs(F); (void)moe_build_tabs(F, T);
    const float* MODF = (const float*)(F.ws + WS_MODF); const int lane = F.lane;
    const unsigned char* YB = F.ws + WS_YB;
    for (int rb = F.vcu; rb < M / 64; rb += F.G) {
        const int b = (rb * 64) / SEQ;
        LAS float* A9 = (LAS float*)(F.lds + TAB_OFF + 16384);
        __syncthreads();
        for (int c0 = F.tid; c0 < 1024; c0 += NTHR) A9[c0] = F.in[7][c0] * MODF[b * 6144 + 5120 + c0];
        __syncthreads();
        const int row0 = rb * 64 + F.wave * 8;
        unsigned myoff = 0u; float mygate = 0.f;
        if (lane < 32) { const int e = ((const int*)(F.ws + WS_TOKE))[row0 * 4 + lane], r = ((const int*)(F.ws + WS_TOKR))[row0 * 4 + lane]; mygate = ((const float*)(F.ws + WS_TOKG))[row0 * 4 + lane];
            myoff = (unsigned)(T.tbase[e] * 256 + r) * 1024u; mygate *= 1.0f / YB_SCALE; }
        u32x4 yw[3][4]; u32x4 xw[3][2];
#define P10_ISSUE(i_, s_) do { \
            _Pragma("unroll") for (int k = 0; k < 4; ++k) { const unsigned off = (unsigned)__builtin_amdgcn_readlane((int)myoff, (i_) * 4 + k); yw[s_][k] = ((const u32x4*)(YB + off))[lane]; } \
            { const u32x4* xr = (const u32x4*)((const bf16*)(F.ws + WS_YMIX) + (size_t)(row0 + (i_)) * 1024) + 2 * lane; xw[s_][0] = xr[0]; xw[s_][1] = xr[1]; } } while (0)
        P10_ISSUE(0, 0); P10_ISSUE(1, 1);
#pragma unroll
        for (int i = 0; i < 8; ++i) {
            const int row = row0 + i, sl = i % 3;
            if (i + 2 < 8) P10_ISSUE(i + 2, (i + 2) % 3);
            float gk[4];
#pragma unroll
            for (int k = 0; k < 4; ++k) gk[k] = __int_as_float(__builtin_amdgcn_readlane(__float_as_int(mygate), i * 4 + k));
            f32x4 y[4];
#pragma unroll
            for (int j = 0; j < 4; ++j) y[j] = (f32x4){0.f, 0.f, 0.f, 0.f};
#pragma unroll
            for (int k = 0; k < 4; ++k)
#pragma unroll
                for (int q = 0; q < 4; ++q) { const int w = (int)yw[sl][k][q];
                    const f32x2 lo = __builtin_amdgcn_cvt_pk_f32_fp8(w, false), hh = __builtin_amdgcn_cvt_pk_f32_fp8(w, true);
                    y[q] += (f32x4){lo.x, lo.y, hh.x, hh.y} * gk[k]; }
            float ss = 0.f;
#pragma unroll
            for (int j = 0; j < 4; ++j) ss += (y[j].x * y[j].x + y[j].y * y[j].y) + (y[j].z * y[j].z + y[j].w * y[j].w);
            const float rs = rsqrtf(wave_sum(ss) * (1.0f / 1024.0f) + EPS);
            f32x4* orow = (f32x4*)(dstp + (size_t)row * 1024) + 4 * lane; const LAS f32x4* a9 = (const LAS f32x4*)(A9 + 16 * lane);
#pragma unroll
            for (int q = 0; q < 4; ++q) { const unsigned w0 = xw[sl][q >> 1][2 * (q & 1)], w1 = xw[sl][q >> 1][2 * (q & 1) + 1];
                orow[q] = (f32x4){bf2f(w0 & 0xffffu), bf2f(w0 >> 16), bf2f(w1 & 0xffffu), bf2f(w1 >> 16)} + a9[q] * (y[q] * rs); }
        }
#undef P10_ISSUE
    }
}

#ifndef MLSTM_FUSED
#define MLSTM_FUSED 0
#endif
__device__ __forceinline__ void mlstm_fused(Frame& F, int b, int h, int eh) {
    const int tid = F.tid, lane = F.lane, r32 = lane & 31, hi = lane >> 5, wid = F.wave;
    LAS bf16* Qs = (LAS bf16*)F.lds;
    LAS bf16* Qp = Qs + 64 * QS_STRIDE;
    LAS bf16* Ks = Qp + 64 * QS_STRIDE;
    LAS bf16* KT = Ks + 64 * QS_STRIDE;
    LAS bf16* VT = KT + 128 * KT_STRIDE;
    LAS bf16* VwT = VT + 64 * KT_STRIDE;
    LAS bf16* CT = VwT + 64 * KT_STRIDE;
    LAS bf16* Wm = CT + 64 * QS_STRIDE;
    LAS float* fu = (LAS float*)(Wm + 64 * KT_STRIDE);
    LAS float* fmm = fu + 64; LAS float* fiw = fu + 128; LAS float* ffl = fu + 192; LAS float* frd = fu + 256; LAS float* fwx = fu + 320; LAS float* fnp = fu + 384; LAS float* ms = fu + 512;
    const bf16* Z = (const bf16*)(F.ws + WS_Z);
    bf16* Y = (bf16*)(F.ws + WS_YMIX);
    const int e0 = eh * 64;
    for (int i = tid; i < 64 * QS_STRIDE; i += NTHR) CT[i] = 0;
    if (tid < 128) fnp[tid] = 0.f;
    if (tid == 0) ms[0] = -INFINITY;
    f32x16 st = {};
    ConvRaw rq[2], rk[2]; bf16x8 rv; unsigned short og[16]; unsigned short gi_raw = 0, gf_raw = 0;
#define MF_PREFETCH(c_) do { \
        _Pragma("unroll") for (int rep = 0; rep < 2; ++rep) { const int task = tid + NTHR * rep, l = task >> 4, ch = task & 15, t = (c_) * 64 + l; \
            conv8_load(F, b, t, ZC_QM + h * 128 + ch * 8, rq[rep]); conv8_load(F, b, t, ZC_KM + h * 128 + ch * 8, rk[rep]); } \
        { const int l = tid >> 3, chv = tid & 7; rv = *(const bf16x8*)(Z + (size_t)(b * SEQ + (c_) * 64 + l) * ZP + ZC_VM + h * 128 + e0 + chv * 8); } \
        if (wid < 4) { _Pragma("unroll") for (int r = 0; r < 16; ++r) { const int l = (wid & 1) * 32 + crow(r, hi); og[r] = Z[(size_t)(b * SEQ + (c_) * 64 + l) * ZP + ZC_OM + h * 128 + e0 + (wid >> 1) * 32 + r32]; } } \
        if (wid == 0) { const size_t zr_ = (size_t)(b * SEQ + (c_) * 64 + lane) * ZP; gi_raw = Z[zr_ + ZC_IG + h]; gf_raw = Z[zr_ + ZC_FG + h]; } } while (0)
    MF_PREFETCH(0);
    __syncthreads();
    for (int c = 0; c < 64; ++c) {
        if (wid == 0) {
            const float ig = bf2f(gi_raw) + F.in[9][h]; float g = logsigmoidf_(bf2f(gf_raw) + F.in[9][4 + h]);
#pragma unroll
            for (int o = 1; o < 64; o <<= 1) { const float t = __shfl_up(g, o); if (lane >= o) g += t; }
            const float u = ig - g; float pm = u;
#pragma unroll
            for (int o = 1; o < 64; o <<= 1) { const float t = __shfl_up(pm, o); if (lane >= o) pm = fmaxf(pm, t); }
            const float G = __shfl(g, 63), wl = G - g + ig, ml = wave_max(wl);
            const float m_old = ms[0], mm = fmaxf(m_old, pm), m_new = fmaxf(G + m_old, ml);
            fu[lane] = u; fmm[lane] = mm; fiw[lane] = __expf(m_old - mm); ffl[lane] = __expf(-(g + mm)); fwx[lane] = __expf(wl - m_new);
            if (lane == 0) { ms[1] = __expf(G + m_old - m_new); ms[2] = m_new; }
        }
        __syncthreads();
#pragma unroll
        for (int rep = 0; rep < 2; ++rep) { const int task = tid + NTHR * rep, l = task >> 4, ch = task & 15;
            float qq[8], kk[8];
            conv8_calc(F, rq[rep], h * 128 + ch * 8, qq); conv8_calc(F, rk[rep], 512 + h * 128 + ch * 8, kk);
            const float iw = fiw[l], sk = 0.08838834764831845f;
            u32x4 wq, wp, wk;
            wq.x = pk2(qq[0], qq[1]); wq.y = pk2(qq[2], qq[3]); wq.z = pk2(qq[4], qq[5]); wq.w = pk2(qq[6], qq[7]);
            wp.x = pk2(qq[0] * iw, qq[1] * iw); wp.y = pk2(qq[2] * iw, qq[3] * iw); wp.z = pk2(qq[4] * iw, qq[5] * iw); wp.w = pk2(qq[6] * iw, qq[7] * iw);
            wk.x = pk2(kk[0] * sk, kk[1] * sk); wk.y = pk2(kk[2] * sk, kk[3] * sk); wk.z = pk2(kk[4] * sk, kk[5] * sk); wk.w = pk2(kk[6] * sk, kk[7] * sk);
            *(LAS u32x4*)(Qs + l * QS_STRIDE + ch * 8) = wq; *(LAS u32x4*)(Qp + l * QS_STRIDE + ch * 8) = wp; *(LAS u32x4*)(Ks + l * QS_STRIDE + ch * 8) = wk;
#pragma unroll
            for (int j = 0; j < 8; ++j) KT[(ch * 8 + j) * KT_STRIDE + l] = (bf16)f2bf(kk[j] * sk); }
        { const int l = tid >> 3, chv = tid & 7; const float we = fwx[l];
#pragma unroll
            for (int j = 0; j < 8; ++j) { VT[(chv * 8 + j) * KT_STRIDE + l] = (bf16)rv[j]; VwT[(chv * 8 + j) * KT_STRIDE + l] = (bf16)f2bf(bf2f((unsigned short)rv[j]) * we); } }
        unsigned short ogc[16];
#pragma unroll
        for (int r = 0; r < 16; ++r) ogc[r] = og[r];
        if (c + 1 < 64) MF_PREFETCH(c + 1);
        __syncthreads();
        if (wid < 4) {
            const int lt = wid >> 1, stl = wid & 1;
            f32x16 acc = {}; acc = mma32_lds(Qs + lt * 32 * QS_STRIDE, QS_STRIDE, Ks + stl * 32 * QS_STRIDE, QS_STRIDE, 8, r32, hi, acc);
            const int s_ = stl * 32 + r32; const float us = fu[s_];
#pragma unroll
            for (int r = 0; r < 16; ++r) { const int l = lt * 32 + crow(r, hi); const float w = (s_ <= l) ? __expf(us - fmm[l]) * acc[r] : 0.f; Wm[l * KT_STRIDE + s_] = (bf16)f2bf(w); }
        }
        __syncthreads();
        if (tid < 64) { float dsum = 0.f;
#pragma unroll 8
            for (int s_ = 0; s_ < 64; ++s_) dsum += bf2f(Wm[tid * KT_STRIDE + s_]);
#pragma unroll 8
            for (int d = 0; d < 128; ++d) dsum += bf2f(Qp[tid * QS_STRIDE + d]) * fnp[d];
            frd[tid] = 1.0f / fmaxf(fabsf(dsum), ffl[tid]); }
        f32x16 num = {};
        if (wid < 4) { const int lt = wid & 1, et = wid >> 1;
            num = mma32_lds(Wm + lt * 32 * KT_STRIDE, KT_STRIDE, VT + et * 32 * KT_STRIDE, KT_STRIDE, 4, r32, hi, num);
            num = mma32_lds(Qp + lt * 32 * QS_STRIDE, QS_STRIDE, CT + et * 32 * QS_STRIDE, QS_STRIDE, 8, r32, hi, num); }
        { const float a = ms[1];
#pragma unroll
            for (int r = 0; r < 16; ++r) st[r] *= a;
            st = mma32_lds(VwT + (wid & 1) * 32 * KT_STRIDE, KT_STRIDE, KT + (wid >> 1) * 32 * KT_STRIDE, KT_STRIDE, 4, r32, hi, st); }
        __syncthreads();
        if (wid < 4) { const int lt = wid & 1, et = wid >> 1, e = e0 + et * 32 + r32;
#pragma unroll
            for (int r = 0; r < 16; ++r) { const int l = lt * 32 + crow(r, hi); const size_t row = (size_t)(b * SEQ + c * 64 + l);
                Y[row * 1024 + h * 128 + e] = (bf16)f2bf(num[r] * frd[l] * sigmoidf_(bf2f(ogc[r]))); } }
#pragma unroll
        for (int r = 0; r < 16; ++r) CT[((wid & 1) * 32 + crow(r, hi)) * QS_STRIDE + (wid >> 1) * 32 + r32] = (bf16)f2bf(st[r]);
        if (tid >= 256 && tid < 384) { const int d = tid - 256; float s_ = 0.f;
#pragma unroll 8
            for (int l = 0; l < 64; ++l) s_ += fwx[l] * bf2f(KT[d * KT_STRIDE + l]);
            fnp[d] = ms[1] * fnp[d] + s_; }
        __syncthreads();
        if (tid == 0) ms[0] = ms[2];
    }
    __syncthreads();
#undef MF_PREFETCH
}

__device__ __forceinline__ void ph2_zgemm(Frame& F) {
    unsigned char* ws = F.ws;
    pg8::StaticSched S; S.init(M, ZP, 1024, F.G, (int)blockIdx.x);
    pg8::EpiBf16 E{(bf16*)(ws + WS_Z), ZP, nullptr, 0};
    pg8::gemm_phase<false>(F.lds, (const bf16*)(ws + WS_H), (const bf16*)(ws + WS_WIN), 1024, S, E);
}
__device__ __forceinline__ void ph3_local(Frame& F) {
    for (int wi = F.vcu; wi < 256; wi += F.G) p3_compress_item(F, wi);
#if !MLSTM_FUSED
    p3_mlstm_a_items(F);
#endif
}
#ifndef ATT_PROBE
#define ATT_PROBE -1
#endif
constexpr int CW_AQ = 20480;
__device__ __forceinline__ void ph4_scan_attn(Frame& F) {
#if MLSTM_FUSED
    if (F.vcu < 32) mlstm_fused(F, F.vcu >> 3, (F.vcu >> 1) & 3, F.vcu & 1);
    volatile LAS unsigned* qslot = (volatile LAS unsigned*)(F.lds + LDSCTL_OFF + 512);
    for (;;) {
        __syncthreads();
        if (F.tid == 0) qslot[0] = __hip_atomic_fetch_add(F.ctl + CW_AQ, 1u, RLX_AGENT);
        __syncthreads();
        const int q = (int)qslot[0];
        if (q >= 512) break;
        const int cur = 63 - (q >> 3), bg = q & 7;
        nsa::attn_unit<0>(F, bg >> 1, bg & 1, cur, (bf16*)(F.ws + WS_YMIX), true);
    }
#else
    p4_scan(F); __syncthreads();
    if (ATT_PROBE >= 0) { nsa::p4_attention<(ATT_PROBE < 0 ? 0 : ATT_PROBE)>(F, (bf16*)(F.ws + WS_ACT)); __syncthreads(); }
    nsa::p4_attention<0>(F, (bf16*)(F.ws + WS_YMIX));
#endif
}
__device__ __forceinline__ void ph5_mlstm_out(Frame& F) {
#if !MLSTM_FUSED
    p5_mlstm_c_items(F);
#endif
}
__device__ __forceinline__ void ph6_wout(Frame& F) {
    unsigned char* ws = F.ws;
    pg8::StaticSched S; S.init(M, 1024, 1024, F.G, (int)blockIdx.x);
    pg8::EpiBf16 E{(bf16*)(ws + WS_Y), 1024, nullptr, 0};
    pg8::gemm_phase<false>(F.lds, (const bf16*)(ws + WS_YMIX), (const bf16*)(ws + WS_WOUT), 1024, S, E);
}
__device__ __forceinline__ void ph8_up(Frame& F) {
    unsigned char* ws = F.ws;
    const MoeTabs T = moe_tabs(F); const int NT = moe_build_tabs(F, T);
    const int* rowtok = (const int*)(ws + WS_ROWTOK);
    for (int i = 0; i < MAXU; ++i) { const int L = i * F.G + F.vcu; if (L >= NT * 8) break; const int t = L >> 3, e = T.tile_e[t], r0 = T.tile_r0[t];
        for (int r = F.tid; r < 256; r += NTHR) { const int gi = r0 + r; T.idx[i * 256 + r] = gi < T.cnt[e] ? rowtok[(size_t)e * ECAP + gi] : 0; } }
    __syncthreads();
    MoeUpSched S{NT, F.G, F.vcu, T.tile_e, T.idx};
    pg8::EpiSwiglu E{(unsigned char*)(ws + WS_ACT), F.in[20]};
    pg8::gemm_phase<true>(F.lds, (const bf16*)(ws + WS_H), (const bf16*)(ws + WS_WUP), 512, S, E);
}
__device__ __forceinline__ void ph9_down(Frame& F) {
    unsigned char* ws = F.ws;
    const MoeTabs T = moe_tabs(F); const int NT = moe_build_tabs(F, T);
    MoeDownSched S{NT, F.G, F.vcu, T.tile_e};
    pg8::EpiFp8 E{ws + WS_YB, 1024, F.in[22], 1024, YB_SCALE};
    pg8::gemm_phase<true>(F.lds, (const bf16*)(ws + WS_ACT), (const bf16*)(ws + WS_WDN), 512, S, E);
}

constexpr int N_PHASES = 11;
struct Args { const float* in[23]; float* out; unsigned char* ws; int ph_lo, ph_hi; };
__global__ void __launch_bounds__(NTHR, 2) hybrid_fwd(Args args) {
    extern __shared__ __attribute__((aligned(16))) unsigned char lds_raw[];
    Frame F;
    F.lds = (LAS unsigned char*)lds_raw;
    F.tid = threadIdx.x; F.lane = F.tid & 63; F.wave = __builtin_amdgcn_readfirstlane(F.tid >> 6);
    F.G = gridDim.x; { const int bx = blockIdx.x; F.vcu = (F.G % 8 == 0) ? (bx % 8) * (F.G / 8) + bx / 8 : bx; }
    F.ws = args.ws; F.ctl = (unsigned*)(args.ws + WS_CTL); F.out = args.out;
    F.in = (const float* const __attribute__((address_space(4)))*)__builtin_amdgcn_kernarg_segment_ptr();
    for (int u = F.tid; u < (LDS_BYTES - LDSCTL_OFF) / 4; u += NTHR) ((LAS unsigned*)(F.lds + LDSCTL_OFF))[u] = 0u;
    __syncthreads();
    volatile LAS unsigned* MISC = (volatile LAS unsigned*)(F.lds + MISC_OFF);
    XcdBarrier bar; bar.bar = F.ctl + CW_BAR; bar.x = 0; bar.st = nullptr;
    if (!MK_PER_PHASE) bar = xcd_barrier_post(F.ctl + CW_BAR, MISC + 8);
    const int lo = args.ph_lo, hi = args.ph_hi;
#ifndef PH_MASK
#define PH_MASK 0x7ff
#endif
#define IN(k) (((PH_MASK >> (k)) & 1) && lo <= (k) && (k) < hi)
#define SEAM(k) do { if (IN(k) && IN((k) + 1)) xcd_barrier(bar); } while (0)
#ifndef PH_TWICE
#define PH_TWICE 0
#endif
#define RUNPH(k, call) do { if (IN(k)) { call; if ((PH_TWICE >> (k)) & 1) { xcd_barrier(bar); call; } } } while (0)
    RUNPH(0, p0_prologue(F)); SEAM(0);
    RUNPH(1, p1_rows(F)); SEAM(1);
    RUNPH(2, ph2_zgemm(F)); SEAM(2);
    RUNPH(3, ph3_local(F)); SEAM(3);
    RUNPH(4, ph4_scan_attn(F));
#if !MLSTM_FUSED
    SEAM(4);
#endif
    RUNPH(5, ph5_mlstm_out(F)); SEAM(5);
    RUNPH(6, ph6_wout(F)); SEAM(6);
    RUNPH(7, p7_rows(F)); SEAM(7);
    RUNPH(8, ph8_up(F)); SEAM(8);
    RUNPH(9, ph9_down(F)); SEAM(9);
#ifdef P10_TWICE
    if (IN(10)) { p11_final(F, (float*)(F.ws + WS_DC)); xcd_barrier(bar); }
#endif
    RUNPH(10, p11_final(F, F.out));
#ifdef EXTRA_BARS
#pragma unroll 1
    for (int eb = 0; eb < EXTRA_BARS; ++eb) xcd_barrier(bar);
#endif
#undef RUNPH
#undef IN
#undef SEAM
}

extern "C" void kernel_launch(void* const* d_in, const int* in_sizes, int n_in, void* d_out, int out_size, void* d_ws, size_t ws_size, hipStream_t stream) {
    static int grid = 0;
    if (grid == 0) {
        if (n_in != 23 || out_size != M * D || ws_size < WS_END) { fprintf(stderr, "kernel_launch: unexpected shapes (n_in %d out %d ws %zu)\n", n_in, out_size, ws_size); grid = -1; return; }
        int dev = 0, cus = 0;
        if (hipGetDevice(&dev) != hipSuccess || hipDeviceGetAttribute(&cus, hipDeviceAttributeMultiprocessorCount, dev) != hipSuccess) { grid = -1; return; }
        if (hipFuncSetAttribute((const void*)hybrid_fwd, hipFuncAttributeMaxDynamicSharedMemorySize, LDS_BYTES) != hipSuccess) { fprintf(stderr, "kernel_launch: hipFuncSetAttribute failed\n"); grid = -1; return; }
        int per_cu = 0;
        if (hipOccupancyMaxActiveBlocksPerMultiprocessor(&per_cu, (const void*)hybrid_fwd, NTHR, LDS_BYTES) != hipSuccess || per_cu < 1) fprintf(stderr, "kernel_launch: occupancy query reports %d\n", per_cu);
        (void)hipGetLastError();
        grid = cus > 256 ? 256 : cus;
    }
    if (grid < 0) return;
    (void)hipMemsetAsync((char*)d_ws + WS_CTL, 0, CTL_ZERO_BYTES, stream);
    Args a{};
    for (int i = 0; i < 23; ++i) a.in[i] = (const float*)d_in[i];
    a.out = (float*)d_out; a.ws = (unsigned char*)d_ws;
#if MK_PER_PHASE
    for (int p = 0; p < N_PHASES; ++p) { a.ph_lo = p; a.ph_hi = p + 1; hipLaunchKernelGGL(hybrid_fwd, dim3(grid), dim3(NTHR), LDS_BYTES, stream, a); }
#else
    a.ph_lo = 0; a.ph_hi = N_PHASES;
    hipLaunchKernelGGL(hybrid_fwd, dim3(grid), dim3(NTHR), LDS_BYTES, stream, a);
#endif
}
```

```cpp
#include <hip/hip_runtime.h>
#include <cstdio>
#include <cstdint>
#include <cmath>

#define GAS __attribute__((address_space(1)))
#define LAS __attribute__((address_space(3)))
typedef unsigned short bf16;
typedef short bf16x8 __attribute__((ext_vector_type(8)));
typedef short s16x4 __attribute__((ext_vector_type(4)));
typedef float f32x4 __attribute__((ext_vector_type(4)));
typedef float f32x2 __attribute__((ext_vector_type(2)));
typedef float f32x16 __attribute__((ext_vector_type(16)));
typedef unsigned u32x4 __attribute__((ext_vector_type(4)));
typedef unsigned u32x2 __attribute__((ext_vector_type(2)));

#ifndef MK_PER_PHASE
#define MK_PER_PHASE 0
#endif

constexpr int BATCH = 4, SEQ = 4096, D = 1024, M = BATCH * SEQ;
constexpr int D_IN = 3360, ZP = 3584;
constexpr int ZC_QM = 0, ZC_KM = 512, ZC_VM = 1024, ZC_OM = 1536, ZC_QA = 2048, ZC_KC = 2560, ZC_VC = 2688, ZC_KS = 2816, ZC_VS = 2944,
              ZC_KW = 3072, ZC_VW = 3200, ZC_IG = 3328, ZC_FG = 3332, ZC_GA = 3336;
constexpr int NEXP = 32, TOPK = 4, ECAP = 16384, MAXT = 288;
constexpr float EPS = 1e-6f;
constexpr int NWAVES = 8, NTHR = 512;

constexpr size_t MiB = 1u << 20;
constexpr size_t WS_CTL = 0, CTL_ZERO_BYTES = 1 * MiB;
constexpr size_t WS_MODP = 1 * MiB;
constexpr size_t WS_MODF = 2 * MiB;
constexpr size_t WS_CMPB = 2 * MiB + 128 * 1024;
constexpr size_t WS_WCMP = 3 * MiB;
constexpr size_t WS_WIN = 4 * MiB;
constexpr size_t WS_WOUT = 12 * MiB;
constexpr size_t WS_WRT = 14 * MiB;
constexpr size_t WS_WUP = 16 * MiB;
constexpr size_t WS_WDN = 144 * MiB;
constexpr size_t WS_H = 208 * MiB;
constexpr size_t WS_Z = 240 * MiB;
constexpr size_t WS_YMIX = 352 * MiB;
constexpr size_t WS_Y = 384 * MiB;
constexpr size_t WS_DC = 416 * MiB;
constexpr size_t WS_DN = 480 * MiB;
constexpr size_t WS_SC = 481 * MiB;
constexpr size_t WS_KC = 482 * MiB;
constexpr size_t WS_VC = 483 * MiB;
constexpr size_t WS_ACT = 484 * MiB;
constexpr size_t WS_YB = 628 * MiB;
constexpr float YB_SCALE = 8.0f;
constexpr size_t WS_TOKE = 772 * MiB;
constexpr size_t WS_TOKR = 772 * MiB + 256 * 1024;
constexpr size_t WS_TOKG = 772 * MiB + 512 * 1024;
constexpr size_t WS_ROWTOK = 774 * MiB;
constexpr size_t WS_CP = 776 * MiB;
constexpr size_t WS_NP = 840 * MiB;
constexpr size_t WS_END = 841 * MiB;
constexpr int CW_TMO = 0, CW_BAR = 4096, CW_CNT = 16384;

constexpr int RING_BYTES = 131072;
constexpr int LDSCTL_OFF = RING_BYTES, MISC_OFF = LDSCTL_OFF + 320;
constexpr int TAB_OFF = LDSCTL_OFF + 1024;
constexpr int LDS_BYTES = 163840;

#define RLX_AGENT __ATOMIC_RELAXED, __HIP_MEMORY_SCOPE_AGENT
__device__ __forceinline__ float bf2f(unsigned v) { return __uint_as_float(v << 16); }
__device__ __forceinline__ unsigned f2bf(float f) { unsigned u = __float_as_uint(f); return (u + 0x7fffu + ((u >> 16) & 1u)) >> 16; }
__device__ __forceinline__ unsigned pk2(float lo, float hi) { unsigned r; asm volatile("v_cvt_pk_bf16_f32 %0, %1, %2" : "=v"(r) : "v"(lo), "v"(hi)); return r; }
__device__ __forceinline__ unsigned pk4_fp8(float a, float b, float c, float d) { int w = 0; w = __builtin_amdgcn_cvt_pk_fp8_f32(a, b, w, false); w = __builtin_amdgcn_cvt_pk_fp8_f32(c, d, w, true); return (unsigned)w; }
template <int MASK> __device__ __forceinline__ float xchg_f(float x, int lane) {
    if constexpr (MASK == 1) return __int_as_float(__builtin_amdgcn_mov_dpp(__float_as_int(x), 0xB1, 0xF, 0xF, true));
    else if constexpr (MASK == 2) return __int_as_float(__builtin_amdgcn_mov_dpp(__float_as_int(x), 0x4E, 0xF, 0xF, true));
    else if constexpr (MASK == 32) { auto rr = __builtin_amdgcn_permlane32_swap(__float_as_uint(x), __float_as_uint(x), false, false); return __uint_as_float((lane >> 5) ? rr[0] : rr[1]); }
    else return __shfl_xor(x, MASK);
}
template <int MASK> __device__ __forceinline__ int xchg_i(int x, int lane) { return __float_as_int(xchg_f<MASK>(__int_as_float(x), lane)); }
__device__ __forceinline__ float wave_sum(float v) {
    const int lane = threadIdx.x & 63;
    v += xchg_f<1>(v, lane); v += xchg_f<2>(v, lane); v += xchg_f<4>(v, lane); v += xchg_f<8>(v, lane); v += xchg_f<16>(v, lane); v += xchg_f<32>(v, lane);
    return v;
}
__device__ __forceinline__ float wave_max(float v) {
#pragma unroll
    for (int o = 1; o < 64; o <<= 1) v = fmaxf(v, __shfl_xor(v, o));
    return v;
}
__device__ __forceinline__ float sigmoidf_(float x) { return __builtin_amdgcn_rcpf(1.0f + __builtin_amdgcn_exp2f(-1.4426950408889634f * x)); }
__device__ __forceinline__ float siluf_(float x) { return x * sigmoidf_(x); }
__device__ __forceinline__ float logsigmoidf_(float x) { return fminf(x, 0.f) - log1pf(__expf(-fabsf(x))); }
__device__ __forceinline__ int crow(int r, int hi) { return (r & 3) + 8 * (r >> 2) + 4 * hi; }

__device__ __constant__ unsigned char T5B[128] = {0, 1, 2, 3, 4, 5, 6, 7, 8, 9, 10, 11, 12, 13, 14, 15, 16, 16, 16, 17, 17, 18, 18, 18, 19, 19, 19, 20, 20, 20, 20, 21, 21, 21, 21, 22, 22, 22, 22, 22, 23, 23, 23, 23, 23, 23, 24, 24, 24, 24, 24, 24, 25, 25, 25, 25, 25, 25, 25, 26, 26, 26, 26, 26, 26, 26, 26, 27, 27, 27, 27, 27, 27, 27, 27, 27, 27, 28, 28, 28, 28, 28, 28, 28, 28, 28, 28, 29, 29, 29, 29, 29, 29, 29, 29, 29, 29, 29, 29, 30, 30, 30, 30, 30, 30, 30, 30, 30, 30, 30, 30, 30, 30, 31, 31, 31, 31, 31, 31, 31, 31, 31, 31, 31, 31, 31, 31, 31};

namespace pg8 {
typedef int v8i32 __attribute__((ext_vector_type(8)));
typedef int v4i32 __attribute__((ext_vector_type(4)));
constexpr int BM = 256, BK = 64, HALF = 128, HTB = HALF * BK * 2, STAGE_BYTES = 8 * HTB, NXCD = 8, WGM = 8;
__host__ __device__ __forceinline__ int lds_byte(int r, int c) { const int st = (r >> 4) * 2 + (c >> 5), rr = r & 15, cc = c & 31, ob = rr * 64 + cc * 2; return st * 1024 + (ob ^ (((ob >> 9) & 1) << 5)); }
__host__ __device__ __forceinline__ void stage_rc(int b, int& R, int& C) { const int st = b / 1024, sb = b % 1024, swz = sb ^ (((sb >> 9) & 1) << 5); R = (st >> 1) * 16 + swz / 64; C = (st & 1) * 32 + (swz % 64) / 2; }
__host__ __device__ __forceinline__ int perm32(int rho) { const int n = rho >> 4, i = rho & 15; return 8 * (i >> 2) + 4 * n + (i & 3); }

__device__ __forceinline__ void glds16_s(const char* sbase, unsigned voff, unsigned lds_dst) { unsigned keep;
    asm volatile("s_mov_b32 %0, m0\n\ts_mov_b32 m0, %3\n\ts_nop 0\n\tglobal_load_lds_dwordx4 %1, %2\n\ts_mov_b32 m0, %0" : "=&s"(keep) : "v"(voff), "s"(sbase), "s"(lds_dst) : "memory"); }
__device__ __forceinline__ const char* uniform_ptr(const char* p) { const unsigned long long v = (unsigned long long)p;
    return (const char*)(((unsigned long long)(unsigned)__builtin_amdgcn_readfirstlane((int)(v >> 32)) << 32) | (unsigned)__builtin_amdgcn_readfirstlane((int)v)); }
struct Unit { int pm, pn, e, ui; };

struct StaticSched {
    int nM, nN, nwg, G, c, K;
    __device__ void init(int M_, int N_, int K_, int G_, int c_) { nM = M_ / BM; nN = N_ / BM; nwg = nM * nN; G = G_; c = c_; K = K_; }
    __device__ __forceinline__ bool next(int i, Unit& u) const {
        const long L = (long)i * G + c; if (L >= nwg) return false;
        int wgid = (int)L; { const int q = nwg / NXCD, r = nwg % NXCD, xcd = wgid % NXCD, off = wgid / NXCD; wgid = (xcd < r ? xcd * (q + 1) : r * (q + 1) + (xcd - r) * q) + off; }
        const int nig = WGM * nN, gid = wgid / nig, fm = gid * WGM, gsz = (nM - fm) < WGM ? (nM - fm) : WGM;
        u.pm = fm + ((wgid % nig) % gsz); u.pn = (wgid % nig) / gsz; u.e = 0; u.ui = i; return true;
    }
    __device__ __forceinline__ unsigned arow(const Unit& u, int r) const { return (unsigned)(u.pm * BM + r); }
    __device__ __forceinline__ size_t boff(const Unit& u) const { return (size_t)u.pn * BM * K * 2; }
};

struct EpiBf16 {
    bf16* O; int ldc; const float* bias; int bstride;
    __device__ __forceinline__ void operator()(const f32x4 (&acc)[2][2][4][2], const Unit& u, int wr, int wc, int fr, int fq) const {
        const int row0 = u.pm * BM + wr * 64 + fr; const int col0 = u.pn * BM + wc * 32 + 8 * fq;
#pragma unroll
        for (int bj = 0; bj < 2; ++bj) {
            f32x4 bv0 = (f32x4){0.f, 0.f, 0.f, 0.f}, bv1 = bv0;
            if (bias) { bv0 = *(const f32x4*)(bias + (size_t)u.e * bstride + col0 + bj * HALF); bv1 = *(const f32x4*)(bias + (size_t)u.e * bstride + col0 + bj * HALF + 4); }
#pragma unroll
            for (int ai = 0; ai < 2; ++ai)
#pragma unroll
                for (int m = 0; m < 4; ++m) { bf16* rowp = O + (size_t)(row0 + ai * HALF + m * 16) * ldc + col0;
                    const f32x4 v0 = acc[ai][bj][m][0] + bv0, v1 = acc[ai][bj][m][1] + bv1;
                    u32x4 w; w.x = pk2(v0[0], v0[1]); w.y = pk2(v0[2], v0[3]); w.z = pk2(v1[0], v1[1]); w.w = pk2(v1[2], v1[3]);
                    *(u32x4*)(rowp + bj * HALF) = w; } }
    }
};
struct EpiFp8 {
    unsigned char* O; int ldc; const float* bias; int bstride; float scale;
    __device__ __forceinline__ void operator()(const f32x4 (&acc)[2][2][4][2], const Unit& u, int wr, int wc, int fr, int fq) const {
        const int row0 = u.pm * BM + wr * 64 + fr; const int col0 = u.pn * BM + wc * 32 + 8 * fq;
#pragma unroll
        for (int bj = 0; bj < 2; ++bj) {
            const f32x4 bv0 = *(const f32x4*)(bias + (size_t)u.e * bstride + col0 + bj * HALF), bv1 = *(const f32x4*)(bias + (size_t)u.e * bstride + col0 + bj * HALF + 4);
#pragma unroll
            for (int ai = 0; ai < 2; ++ai)
#pragma unroll
                for (int m = 0; m < 4; ++m) { unsigned char* rowp = O + (size_t)(row0 + ai * HALF + m * 16) * ldc + col0;
                    const f32x4 v0 = (acc[ai][bj][m][0] + bv0) * scale, v1 = (acc[ai][bj][m][1] + bv1) * scale;
                    u32x2 w; w.x = pk4_fp8(v0[0], v0[1], v0[2], v0[3]); w.y = pk4_fp8(v1[0], v1[1], v1[2], v1[3]);
                    *(u32x2*)(rowp + bj * HALF) = w; } }
    }
};
struct EpiSwiglu {
    unsigned char* O; const float* bup;
    __device__ __forceinline__ void operator()(const f32x4 (&acc)[2][2][4][2], const Unit& u, int wr, int wc, int fr, int fq) const {
        const int row0 = u.pm * BM + wr * 64 + fr; const int c0 = u.pn * HALF + wc * 32 + 8 * fq;
        const float* bg = bup + (size_t)u.e * 2048 + c0; const float* bl = bg + 1024;
        const f32x4 g0 = *(const f32x4*)bg, g1 = *(const f32x4*)(bg + 4), l0 = *(const f32x4*)bl, l1 = *(const f32x4*)(bl + 4);
#pragma unroll
        for (int ai = 0; ai < 2; ++ai)
#pragma unroll
            for (int m = 0; m < 4; ++m) { unsigned char* rowp = O + (size_t)(row0 + ai * HALF + m * 16) * 1024 + c0;
                float a[8];
#pragma unroll
                for (int n = 0; n < 2; ++n) { const f32x4 gv = acc[ai][0][m][n] + (n ? g1 : g0), lv = acc[ai][1][m][n] + (n ? l1 : l0);
#pragma unroll
                    for (int j2 = 0; j2 < 2; ++j2) {
                        f32x2 gl = {fminf(gv[2 * j2], 7.0f), fminf(gv[2 * j2 + 1], 7.0f)};
                        f32x2 li = {__builtin_amdgcn_fmed3f(lv[2 * j2], -7.0f, 7.0f), __builtin_amdgcn_fmed3f(lv[2 * j2 + 1], -7.0f, 7.0f)};
                        const f32x2 ea = gl * (-1.702f * 1.4426950408889634f);
                        f32x2 d = {__builtin_amdgcn_exp2f(ea.x), __builtin_amdgcn_exp2f(ea.y)}; d = d + 1.0f;
                        const f32x2 r = {__builtin_amdgcn_rcpf(d.x), __builtin_amdgcn_rcpf(d.y)};
                        const f32x2 t = gl * r, o = __builtin_elementwise_fma(t, li, t);
                        a[n * 4 + 2 * j2] = o.x; a[n * 4 + 2 * j2 + 1] = o.y; } }
                u32x2 w; w.x = pk4_fp8(a[0], a[1], a[2], a[3]); w.y = pk4_fp8(a[4], a[5], a[6], a[7]);
                *(u32x2*)rowp = w; }
    }
};

template <bool FP8, class Epi, class Sched>
__device__ __forceinline__ void gemm_phase(LAS unsigned char* lds, const bf16* Abase, const bf16* Bbase, const int K, const Sched& S, const Epi& E) {
    const int tid = threadIdx.x, wid = __builtin_amdgcn_readfirstlane(tid >> 6), lane = tid & 63, wr = wid >> 2, wc = wid & 3, fr = lane & 15, fq = lane >> 4;
    const int nt = K / BK;
    unsigned voffB[2];
#pragma unroll
    for (int i = 0; i < 2; ++i) { int R, C; stage_rc(tid * 16 + i * 8192, R, C); const int Rb = (R & ~31) + perm32(R & 31); voffB[i] = (unsigned)(Rb * K + C) * 2u; }
    const size_t kstep = (size_t)(BK * 2);
    const size_t hstepB = (size_t)HALF * K * 2;
    const unsigned rowB = (unsigned)K * 2u;
    const unsigned ldsb = (unsigned)__builtin_amdgcn_readfirstlane((int)((unsigned)(unsigned long long)lds + (unsigned)wid * 1024u));
    const int aoff = lds_byte(wr * 64 + fr, fq * 8), boff = lds_byte(wc * 32 + fr, fq * 8);
#define PG8_SA(b, h) (((b) * 2 + (h)) * HTB)
#define PG8_SB(b, h) ((4 + (b) * 2 + (h)) * HTB)
#define PG8_STAGE(bufoff, gbase, voff) do { _Pragma("unroll") for (int _i = 0; _i < 2; ++_i) glds16_s(gbase, (voff)[_i], ldsb + (unsigned)((bufoff) + _i * 8192)); } while (0)
#define PG8_LD16(off) (*(const LAS v4i32*)(lds + (off)))
#define PG8_LDA(dst, b, h) do { if constexpr (FP8) { _Pragma("unroll") for (int m = 0; m < 4; ++m) dst##8[m] = __builtin_shufflevector(PG8_LD16(PG8_SA(b, h) + aoff + m * 2048), PG8_LD16(PG8_SA(b, h) + aoff + m * 2048 + 1024), 0, 1, 2, 3, 4, 5, 6, 7); } \
        else { _Pragma("unroll") for (int m = 0; m < 4; ++m) _Pragma("unroll") for (int k = 0; k < 2; ++k) dst##4[m][k] = *(const LAS bf16x8*)(lds + PG8_SA(b, h) + aoff + m * 2048 + k * 1024); } } while (0)
#define PG8_LDB(dst, b, h) do { if constexpr (FP8) { _Pragma("unroll") for (int n = 0; n < 2; ++n) dst##8[n] = __builtin_shufflevector(PG8_LD16(PG8_SB(b, h) + boff + n * 2048), PG8_LD16(PG8_SB(b, h) + boff + n * 2048 + 1024), 0, 1, 2, 3, 4, 5, 6, 7); } \
        else { _Pragma("unroll") for (int n = 0; n < 2; ++n) _Pragma("unroll") for (int k = 0; k < 2; ++k) dst##4[n][k] = *(const LAS bf16x8*)(lds + PG8_SB(b, h) + boff + n * 2048 + k * 1024); } } while (0)
#define PG8_MMA(ai, bj, At, Bt) do { __builtin_amdgcn_s_setprio(1); _Pragma("unroll") for (int m = 0; m < 4; ++m) _Pragma("unroll") for (int n = 0; n < 2; ++n) { \
        if constexpr (FP8) { asm volatile("v_mfma_scale_f32_16x16x128_f8f6f4 %0, %1, %2, %0, %3, %4 op_sel_hi:[0,0,0]" : "+v"(acc[ai][bj][m][n]) : "v"(Bt##8[n]), "v"(At##8[m]), "v"(scl), "v"(scl)); } \
        else { _Pragma("unroll") for (int k = 0; k < 2; ++k) acc[ai][bj][m][n] = __builtin_amdgcn_mfma_f32_16x16x32_bf16(Bt##4[n][k], At##4[m][k], acc[ai][bj][m][n], 0, 0, 0); } } \
        __builtin_amdgcn_s_setprio(0); } while (0)
#define PG8_WAIT_V(n) asm volatile("s_waitcnt vmcnt(" #n ")" ::: "memory")
#define PG8_WAIT_L(n) asm volatile("s_waitcnt lgkmcnt(" #n ")" ::: "memory")
#define PG8_BAR __builtin_amdgcn_s_barrier()
#define PG8_SCHED __builtin_amdgcn_sched_barrier(0)
#define PG8_MKVA(dst, u) do { _Pragma("unroll") for (int _i = 0; _i < 2; ++_i) { int R_, C_; stage_rc(tid * 16 + _i * 8192, R_, C_); _Pragma("unroll") for (int _h = 0; _h < 2; ++_h) dst[_h][_i] = S.arow(u, _h * HALF + R_) * rowB + (unsigned)C_ * 2u; } } while (0)
    Unit cur, nxt; int ui = 0;
    if (!S.next(0, cur)) return;
    f32x4 acc[2][2][4][2];
#pragma unroll
    for (int a = 0; a < 2; ++a)
#pragma unroll
        for (int b = 0; b < 2; ++b)
#pragma unroll
            for (int m = 0; m < 4; ++m)
#pragma unroll
                for (int n = 0; n < 2; ++n) acc[a][b][m][n] = (f32x4){0.f, 0.f, 0.f, 0.f};
    v8i32 At8[4], B08[2], B18[2]; bf16x8 At4[4][2], B04[2][2], B14[2][2];
    const unsigned scl = 0x7c7c7c7cu;
    unsigned vc[2][2];
    PG8_MKVA(vc, cur);
    const char* cA = uniform_ptr((const char*)Abase);
    const char* cB = uniform_ptr((const char*)Bbase + S.boff(cur));
    PG8_STAGE(PG8_SB(0, 0), cB, voffB); PG8_STAGE(PG8_SB(0, 1), cB + hstepB, voffB); PG8_STAGE(PG8_SA(0, 0), cA, vc[0]); PG8_STAGE(PG8_SA(0, 1), cA, vc[1]);
    if (wr == 1) PG8_BAR;
    PG8_WAIT_V(2); PG8_BAR;
    PG8_STAGE(PG8_SB(1, 0), cB + kstep, voffB); PG8_STAGE(PG8_SA(1, 0), cA + kstep, vc[0]); PG8_STAGE(PG8_SB(1, 1), cB + hstepB + kstep, voffB);
    PG8_WAIT_V(6); PG8_BAR;
    for (;;) {
        const bool has_next = S.next(ui + 1, nxt);
        const char* nB = uniform_ptr(has_next ? (const char*)Bbase + S.boff(nxt) : cB);
#pragma unroll 1
        for (int t = 0; t < nt; t += 2) {
            const bool last = (t == nt - 2);
            const char* a1 = cA + (size_t)(t + 1) * kstep;
            const char* a2 = last ? cA : cA + (size_t)(t + 2) * kstep; const char* b2 = last ? nB : cB + (size_t)(t + 2) * kstep;
            const char* a3 = a2 + kstep; const char* b3 = b2 + kstep;
            unsigned v2a[2], v2b[2];
#pragma unroll
            for (int i = 0; i < 2; ++i) { v2a[i] = vc[0][i]; v2b[i] = vc[1][i]; }
            if (last && has_next) {
#pragma unroll
                for (int i = 0; i < 2; ++i) { int R_, C_; stage_rc(tid * 16 + i * 8192, R_, C_); v2a[i] = S.arow(nxt, R_) * rowB + (unsigned)C_ * 2u; v2b[i] = S.arow(nxt, HALF + R_) * rowB + (unsigned)C_ * 2u; } }
            PG8_LDB(B0, 0, 0); PG8_LDB(B1, 0, 1); PG8_SCHED; PG8_LDA(At, 0, 0); PG8_STAGE(PG8_SA(1, 1), a1, vc[1]);
            PG8_WAIT_V(8); PG8_WAIT_L(0); PG8_BAR; PG8_MMA(0, 0, At, B0); PG8_MMA(0, 1, At, B1); PG8_BAR; PG8_SCHED;
            PG8_LDA(At, 0, 1); PG8_STAGE(PG8_SB(0, 0), b2, voffB); PG8_STAGE(PG8_SB(0, 1), b2 + hstepB, voffB); PG8_STAGE(PG8_SA(0, 0), a2, v2a);
            PG8_WAIT_V(8); PG8_WAIT_L(0); PG8_BAR; PG8_MMA(1, 0, At, B0); PG8_MMA(1, 1, At, B1); PG8_BAR; PG8_SCHED;
            PG8_LDB(B0, 1, 0); PG8_LDB(B1, 1, 1); PG8_SCHED; PG8_LDA(At, 1, 0); PG8_STAGE(PG8_SA(0, 1), a2, v2b);
            PG8_WAIT_V(8); PG8_WAIT_L(0); PG8_BAR; PG8_MMA(0, 0, At, B0); PG8_MMA(0, 1, At, B1); PG8_BAR; PG8_SCHED;
            PG8_LDA(At, 1, 1); PG8_STAGE(PG8_SB(1, 0), b3, voffB); PG8_STAGE(PG8_SB(1, 1), b3 + hstepB, voffB); PG8_STAGE(PG8_SA(1, 0), a3, v2a);
            PG8_WAIT_V(8); PG8_WAIT_L(0); PG8_BAR; PG8_MMA(1, 0, At, B0); PG8_MMA(1, 1, At, B1); PG8_BAR; PG8_SCHED;
        }
        if (wr == 0) PG8_BAR;
        if constexpr (FP8) asm volatile("s_nop 15\n\ts_nop 15" ::: "memory");
        E(acc, cur, wr, wc, fr, fq);
        if (!has_next) break;
#pragma unroll
        for (int a = 0; a < 2; ++a)
#pragma unroll
            for (int b = 0; b < 2; ++b)
#pragma unroll
                for (int m = 0; m < 4; ++m)
#pragma unroll
                    for (int n = 0; n < 2; ++n) acc[a][b][m][n] = (f32x4){0.f, 0.f, 0.f, 0.f};
        cur = nxt; cB = nB; ++ui;
        PG8_MKVA(vc, cur);
        if (wr == 1) PG8_BAR;
    }
    PG8_WAIT_V(0);
    PG8_BAR;
#undef PG8_SA
#undef PG8_SB
#undef PG8_STAGE
#undef PG8_LDA
#undef PG8_LD16
#undef PG8_LDB
#undef PG8_MMA
#undef PG8_WAIT_V
#undef PG8_WAIT_L
#undef PG8_BAR
#undef PG8_SCHED
#undef PG8_MKVA
}
}

#define XB_TMO      128
#define XB_XCNT(j)  (256  + 64 * (j))
#define XB_XSUB(j)  (1280 + 64 * (j))
#define XB_XGEN(j)  (2304 + 64 * (j))
#define XB_TOP      3328
#define XB_TOPGEN   3392
#define XCD_BAR_WORDS 3456
#define XB_SPIN_CAP (1u << 18)

__device__ __forceinline__ unsigned xb_ld(unsigned* p)              { return __hip_atomic_load(p, __ATOMIC_RELAXED, __HIP_MEMORY_SCOPE_AGENT); }
__device__ __forceinline__ unsigned xb_add(unsigned* p, unsigned v) { return __hip_atomic_fetch_add(p, v, __ATOMIC_RELAXED, __HIP_MEMORY_SCOPE_AGENT); }
__device__ __forceinline__ unsigned xb_xcc_id() { return (unsigned)__builtin_amdgcn_s_getreg((3 << 11) | 20) & 0xFu; }
#define XB_SPIN(cond, bar) do { unsigned _sp = 0; while (cond) { __builtin_amdgcn_s_sleep(1); \
    if ((++_sp & 255u) == 0u) { if (xb_ld(&(bar)[XB_TMO])) break; if (_sp > XB_SPIN_CAP) { atomicAdd(&(bar)[XB_TMO], 1u); break; } } } } while (0)

struct XcdBarrier {
    unsigned* bar; unsigned x;
    volatile LAS unsigned* st;
};
__device__ __forceinline__ XcdBarrier xcd_barrier_post(unsigned* bar, volatile LAS unsigned* st) {
    XcdBarrier b; b.bar = bar; b.x = xb_xcc_id(); b.st = st;
    if (threadIdx.x == 0) (void)xb_add(&bar[XB_XCNT(b.x)], 1u);
    return b;
}
__device__ __forceinline__ void xcd_barrier_complete(unsigned* bar, unsigned x, unsigned& nloc, unsigned& nx) {
    const unsigned G = gridDim.x * gridDim.y * gridDim.z;
    unsigned sum, cnt, mine, sp = 0u;
    for (;;) {
        sum = 0u; cnt = 0u; mine = 0u;
#pragma unroll
        for (unsigned j = 0; j < 16; ++j) { const unsigned c = xb_ld(&bar[XB_XCNT(j)]); sum += c; cnt += (c > 0u) ? 1u : 0u; mine = (j == x) ? c : mine; }
        if (sum == G) break;
        __builtin_amdgcn_s_sleep(1);
        if ((++sp & 255u) == 0u) { if (xb_ld(&bar[XB_TMO])) break; if (sp > XB_SPIN_CAP) { atomicAdd(&bar[XB_TMO], 1u); break; } }
    }
    nloc = mine > 0u ? mine : 1u; nx = cnt > 0u ? cnt : 1u;
}
__device__ __forceinline__ void xcd_barrier(const XcdBarrier& b) {
    asm volatile("s_waitcnt vmcnt(0)" ::: "memory");
    __syncthreads();
    if (threadIdx.x == 0) {
        unsigned* bar = b.bar;
        __builtin_amdgcn_s_waitcnt(0);
        unsigned nloc = b.st[0], nx = b.st[1];
        if (nloc == 0u) { xcd_barrier_complete(bar, b.x, nloc, nx); b.st[0] = nloc; b.st[1] = nx; }
        const unsigned old = xb_add(&bar[XB_XSUB(b.x)], 1u);
        const unsigned gen = old / nloc;
        if (old + 1u == (gen + 1u) * nloc) {
            __builtin_amdgcn_fence(__ATOMIC_RELEASE, "agent");
            asm volatile("s_waitcnt vmcnt(0)" ::: "memory");
            const unsigned og = xb_add(&bar[XB_TOP], 1u);
            const unsigned tg = og / nx;
            if (og + 1u == (tg + 1u) * nx) xb_add(&bar[XB_TOPGEN], 1u);
            else XB_SPIN(xb_ld(&bar[XB_TOPGEN]) == tg, bar);
            __builtin_amdgcn_fence(__ATOMIC_ACQUIRE, "agent");
            xb_add(&bar[XB_XGEN(b.x)], 1u);
            asm volatile("s_waitcnt vmcnt(0)" ::: "memory");
        } else {
            XB_SPIN(xb_ld(&bar[XB_XGEN(b.x)]) == gen, bar);
            __builtin_amdgcn_fence(__ATOMIC_ACQUIRE, "agent");
            asm volatile("s_waitcnt vmcnt(0)" ::: "memory");
        }
    }
    __syncthreads();
}

struct Frame {
    LAS unsigned char* lds;
    unsigned* ctl;
    unsigned char* ws;
    int tid, lane, wave, vcu, G;
    const float* const __attribute__((address_space(4)))* in;
    float* out;
};
#define LDS_WAIT() asm volatile("s_waitcnt lgkmcnt(0)" ::: "memory")
#define VM_WAIT() asm volatile("s_waitcnt vmcnt(0)" ::: "memory")

__device__ __forceinline__ int map_n(int mode, int n) {
    if (mode == 1) return n < 2048 ? n : (n < 2056 ? 3328 + (n - 2048) : (n < 3336 ? n - 8 : n));
    if (mode == 2) return n < 1024 ? ((n >> 7) * 256 + (n & 127)) : (((n - 1024) >> 7) * 256 + 128 + ((n - 1024) & 127));
    return n;
}
template <bool FP8>
__device__ __forceinline__ void p0_transpose_item(const float* W, int K, int N, void* WTv, int mode, LAS float* scr, int item, int lane) {
    const int nblk = N / 32, kb = item / nblk, nb = item % nblk, k0 = 64 * kb, n0 = 32 * nb;
    float tv_[32];
#pragma unroll
    for (int i = 0; i < 32; ++i) { const int kk = 2 * i + (lane >> 5); tv_[i] = W[(size_t)(k0 + kk) * N + n0 + (lane & 31)]; }
#pragma unroll
    for (int i = 0; i < 32; ++i) { const int kk = 2 * i + (lane >> 5); scr[kk * 33 + (lane & 31)] = tv_[i]; }
    LDS_WAIT(); asm volatile("" ::: "memory");
    const int c = lane & 7;
#pragma unroll
    for (int j = 0; j < 4; ++j) { const int n = (lane >> 3) + 8 * j; const LAS float* s = scr + (8 * c) * 33 + n;
        if constexpr (FP8) { u32x2 o; o.x = pk4_fp8(64.f * s[0 * 33], 64.f * s[1 * 33], 64.f * s[2 * 33], 64.f * s[3 * 33]); o.y = pk4_fp8(64.f * s[4 * 33], 64.f * s[5 * 33], 64.f * s[6 * 33], 64.f * s[7 * 33]);
            *(u32x2*)((unsigned char*)WTv + (size_t)map_n(mode, n0 + n) * K + k0 + 8 * c) = o; }
        else { u32x4 o; o.x = pk2(s[0 * 33], s[1 * 33]); o.y = pk2(s[2 * 33], s[3 * 33]); o.z = pk2(s[4 * 33], s[5 * 33]); o.w = pk2(s[6 * 33], s[7 * 33]);
            *(u32x4*)((bf16*)WTv + (size_t)map_n(mode, n0 + n) * K + k0 + 8 * c) = o; } }
    LDS_WAIT(); asm volatile("" ::: "memory");
}
__device__ __forceinline__ void p0_prologue(Frame& F) {
    LAS float* scr = (LAS float*)(F.lds + F.wave * 16384);
    const int gw = F.vcu * NWAVES + F.wave, NGW = F.G * NWAVES, lane = F.lane;
    constexpr int I_ADA = 192, I_CMP = 128, I_WRT = 32, I_PAD = 224, I_WIN = 16 * 105, I_WOUT = 16 * 32, I_WUP = 32 * 16 * 64, I_WDN = 32 * 16 * 32;
    unsigned char* ws = F.ws;
    for (int r = F.vcu; r < I_ADA; r += F.G) {
        const int ks = r / 24, jb = r % 24, j0 = jb * 256 + 4 * lane;
        const float* wa = F.in[2]; const float* c = F.in[1];
        f32x4 acc[4], w4[16];
#pragma unroll
        for (int b = 0; b < 4; ++b) acc[b] = (f32x4){0.f, 0.f, 0.f, 0.f};
#pragma unroll
        for (int kk = 0; kk < 16; ++kk) w4[kk] = __builtin_nontemporal_load((const f32x4*)(wa + (size_t)(ks * 128 + F.wave * 16 + kk) * 6144 + j0));
#pragma unroll
        for (int kk = 0; kk < 16; ++kk) {
#pragma unroll
            for (int b = 0; b < 4; ++b) { const float sv = siluf_(c[b * 1024 + ks * 128 + F.wave * 16 + kk]); acc[b] += w4[kk] * sv; } }
        LAS f32x4* red = (LAS f32x4*)F.lds;
#pragma unroll
        for (int b = 0; b < 4; ++b) red[(F.wave * 4 + b) * 64 + lane] = acc[b];
        __syncthreads();
        if (F.tid < 256) { const int b = F.tid >> 6, ln = F.tid & 63; f32x4 sum = red[b * 64 + ln];
#pragma unroll
            for (int w = 1; w < 8; ++w) sum += red[(w * 4 + b) * 64 + ln];
            *(f32x4*)((float*)(ws + WS_MODP) + (size_t)(ks * 4 + b) * 6144 + jb * 256 + 4 * ln) = sum; }
        __syncthreads();
    }
    for (int it = gw; it < I_CMP + I_WRT + I_PAD; it += NGW) {
        int r = it;
        if (r < I_CMP) {
            const int kv = r >> 6, e = r & 63; const float* w = kv ? F.in[12] : F.in[11]; const float* pos = kv ? F.in[14] : F.in[13];
            bf16* wt = (bf16*)(ws + WS_WCMP) + (size_t)(kv * 64 + e) * 2048; float s = 0.f;
            float wv[32], pv_[32];
#pragma unroll
            for (int i = 0; i < 32; ++i) { wv[i] = w[(size_t)(lane + 64 * i) * 64 + e]; pv_[i] = pos[lane + 64 * i]; }
#pragma unroll
            for (int i = 0; i < 32; ++i) { wt[lane + 64 * i] = (bf16)f2bf(wv[i]); s += pv_[i] * wv[i]; }
            s = wave_sum(s); if (lane == 0) ((float*)(ws + WS_CMPB))[kv * 64 + e] = s;
            continue; }
        r -= I_CMP;
        if (r < I_WRT) { const float* wr_ = F.in[17]; float* wt = (float*)(ws + WS_WRT) + (size_t)r * 1024;
            float wv[16];
#pragma unroll
            for (int i = 0; i < 16; ++i) wv[i] = wr_[(size_t)(lane + 64 * i) * 32 + r];
#pragma unroll
            for (int i = 0; i < 16; ++i) wt[lane + 64 * i] = wv[i];
            continue; }
        r -= I_WRT;
        { u32x4* p = (u32x4*)((bf16*)(ws + WS_WIN) + (size_t)(D_IN + r) * 1024); p[lane] = (u32x4){0u, 0u, 0u, 0u}; p[lane + 64] = (u32x4){0u, 0u, 0u, 0u}; }
    }
    constexpr int NT_ITEMS = I_WIN + I_WOUT;
    struct TItem { const float* src; unsigned char* dst; int N, mode, fp8, k0, n0; };
#define P0_DECODE(d, rr) do { int r_ = (rr); int item_; \
        if (r_ < I_WIN) { d.src = F.in[8]; d.dst = ws + WS_WIN; d.N = D_IN; d.mode = 1; d.fp8 = 0; item_ = r_; } \
        else { r_ -= I_WIN; d.src = F.in[16]; d.dst = ws + WS_WOUT; d.N = 1024; d.mode = 0; d.fp8 = 0; item_ = r_; } \
        const int nblk_ = d.N / 32; d.k0 = 64 * (item_ / nblk_); d.n0 = 32 * (item_ % nblk_); } while (0)
#define P0_LOAD(d, tv) do { _Pragma("unroll") for (int i = 0; i < 32; ++i) tv[i] = d.src[(size_t)(d.k0 + 2 * i + (lane >> 5)) * d.N + d.n0 + (lane & 31)]; } while (0)
    int itx = gw;
    if (itx < NT_ITEMS) {
        TItem d0, d1; float ta[32], tb[32];
        P0_DECODE(d0, itx); P0_LOAD(d0, ta);
        for (;;) {
            const int nx = itx + NGW; const bool has = nx < NT_ITEMS;
            if (has) { P0_DECODE(d1, nx); P0_LOAD(d1, tb); }
#pragma unroll
            for (int i = 0; i < 32; ++i) scr[(2 * i + (lane >> 5)) * 33 + (lane & 31)] = ta[i];
            LDS_WAIT(); asm volatile("" ::: "memory");
            const int c = lane & 7;
#pragma unroll
            for (int j = 0; j < 4; ++j) { const int n = (lane >> 3) + 8 * j; const LAS float* sp = scr + (8 * c) * 33 + n; const size_t orow = (size_t)map_n(d0.mode, d0.n0 + n) * 1024 + d0.k0 + 8 * c;
                if (d0.fp8) { u32x2 o; o.x = pk4_fp8(64.f * sp[0 * 33], 64.f * sp[1 * 33], 64.f * sp[2 * 33], 64.f * sp[3 * 33]); o.y = pk4_fp8(64.f * sp[4 * 33], 64.f * sp[5 * 33], 64.f * sp[6 * 33], 64.f * sp[7 * 33]);
                    *(u32x2*)(d0.dst + orow) = o; }
                else { u32x4 o; o.x = pk2(sp[0 * 33], sp[1 * 33]); o.y = pk2(sp[2 * 33], sp[3 * 33]); o.z = pk2(sp[4 * 33], sp[5 * 33]); o.w = pk2(sp[6 * 33], sp[7 * 33]);
                    *(u32x4*)(d0.dst + orow * 2) = o; } }
            LDS_WAIT(); asm volatile("" ::: "memory");
            if (!has) break;
            itx = nx; d0 = d1;
#pragma unroll
            for (int i = 0; i < 32; ++i) ta[i] = tb[i];
        }
    }
#undef P0_DECODE
#undef P0_LOAD
    {
        constexpr int NH = 2 * (32 * 8 * 32 + 32 * 8 * 16);
        LAS unsigned char* scr8 = (LAS unsigned char*)scr;
        struct HItem { const float* src; unsigned char* dst; int N, mode, k0, n0, half; };
#define P8_DECODE(d, hh) do { int it_ = (hh) >> 1; d.half = (hh) & 1; \
            if (it_ < 32 * 256) { const int e_ = it_ >> 8, q_ = it_ & 255; d.src = F.in[19] + (size_t)e_ * 1024 * 2048; d.dst = ws + WS_WUP + (size_t)e_ * 2048 * 1024; d.N = 2048; d.mode = 2; d.k0 = 128 * (q_ >> 5); d.n0 = 64 * (q_ & 31); } \
            else { it_ -= 32 * 256; const int e_ = it_ >> 7, q_ = it_ & 127; d.src = F.in[21] + (size_t)e_ * 1024 * 1024; d.dst = ws + WS_WDN + (size_t)e_ * 1024 * 1024; d.N = 1024; d.mode = 0; d.k0 = 128 * (q_ >> 4); d.n0 = 64 * (q_ & 15); } } while (0)
#define P8_LOAD(d, tv) do { _Pragma("unroll") for (int i = 0; i < 16; ++i) tv[i] = __builtin_nontemporal_load((const f32x4*)(d.src + (size_t)(d.k0 + 64 * d.half + 16 * (i >> 2) + 4 * (lane >> 4) + (i & 3)) * d.N + d.n0 + 4 * (lane & 15))); } while (0)
        int item = gw;
        if (item < NH / 2) {
            HItem d0, d1; f32x4 ta[16], tb[16];
            int hcur = 2 * item; P8_DECODE(d0, hcur); P8_LOAD(d0, ta);
            for (;;) {
                const bool has = (hcur & 1) == 0 || (item + NGW) < NH / 2;
                const int hn = (hcur & 1) == 0 ? hcur + 1 : 2 * (item + NGW);
                if (has) { P8_DECODE(d1, hn); P8_LOAD(d1, tb); }
#pragma unroll
                for (int g = 0; g < 4; ++g) {
                    const unsigned r0 = pk4_fp8(64.f * ta[4 * g][0], 64.f * ta[4 * g][1], 64.f * ta[4 * g][2], 64.f * ta[4 * g][3]);
                    const unsigned r1 = pk4_fp8(64.f * ta[4 * g + 1][0], 64.f * ta[4 * g + 1][1], 64.f * ta[4 * g + 1][2], 64.f * ta[4 * g + 1][3]);
                    const unsigned r2 = pk4_fp8(64.f * ta[4 * g + 2][0], 64.f * ta[4 * g + 2][1], 64.f * ta[4 * g + 2][2], 64.f * ta[4 * g + 2][3]);
                    const unsigned r3 = pk4_fp8(64.f * ta[4 * g + 3][0], 64.f * ta[4 * g + 3][1], 64.f * ta[4 * g + 3][2], 64.f * ta[4 * g + 3][3]);
                    const unsigned t01l = __builtin_amdgcn_perm(r1, r0, 0x05010400u), t01h = __builtin_amdgcn_perm(r1, r0, 0x07030602u), t23l = __builtin_amdgcn_perm(r3, r2, 0x05010400u), t23h = __builtin_amdgcn_perm(r3, r2, 0x07030602u);
                    const unsigned o0 = __builtin_amdgcn_perm(t23l, t01l, 0x05040100u), o1 = __builtin_amdgcn_perm(t23l, t01l, 0x07060302u), o2 = __builtin_amdgcn_perm(t23h, t01h, 0x05040100u), o3 = __builtin_amdgcn_perm(t23h, t01h, 0x07060302u);
                    LAS unsigned char* wp = scr8 + (4 * (lane & 15)) * 132 + 64 * d0.half + 16 * g + 4 * (lane >> 4);
                    *(LAS unsigned*)(wp) = o0; *(LAS unsigned*)(wp + 132) = o1; *(LAS unsigned*)(wp + 264) = o2; *(LAS unsigned*)(wp + 396) = o3; }
                if (d0.half == 1) {
                    LDS_WAIT(); asm volatile("" ::: "memory");
#pragma unroll
                    for (int i = 0; i < 8; ++i) { const int n = (lane >> 3) + 8 * i, ch = lane & 7; const LAS unsigned* rp = (const LAS unsigned*)(scr8 + n * 132 + ch * 16);
                        u32x4 o; o.x = rp[0]; o.y = rp[1]; o.z = rp[2]; o.w = rp[3];
                        __builtin_nontemporal_store(o, (u32x4*)(d0.dst + (size_t)map_n(d0.mode, d0.n0 + n) * 1024 + d0.k0 + ch * 16)); }
                    LDS_WAIT(); asm volatile("" ::: "memory");
                }
                if (!has) break;
                if (hcur & 1) item += NGW;
                hcur = hn; d0 = d1;
#pragma unroll
                for (int i = 0; i < 16; ++i) ta[i] = tb[i];
            }
        }
#undef P8_DECODE
#undef P8_LOAD
    }
}

__device__ __forceinline__ float mod_val(const Frame& F, int b, int j) {
    const float* mp = (const float*)(F.ws + WS_MODP); float s = F.in[3][j];
#pragma unroll
    for (int ks = 0; ks < 8; ++ks) s += mp[(size_t)(ks * 4 + b) * 6144 + j];
    return s;
}
__device__ __forceinline__ void p1_rows(Frame& F) {
    LAS float* A1 = (LAS float*)F.lds; LAS float* B1 = A1 + 1024;
    bf16* H = (bf16*)(F.ws + WS_H);
    for (int rb = F.vcu; rb < M / 64; rb += F.G) {
        const int b = (rb * 64) / SEQ;
        f32x4 v[8][4];
#pragma unroll
        for (int i = 0; i < 8; ++i) { const f32x4* xr = (const f32x4*)(F.in[0] + (size_t)(rb * 64 + F.wave * 8 + i) * 1024) + F.lane;
#pragma unroll
            for (int j = 0; j < 4; ++j) v[i][j] = __builtin_nontemporal_load(xr + 64 * j); }
        for (int col = F.tid; col < 1024; col += NTHR) { A1[col] = F.in[4][col] * (1.0f + mod_val(F, b, 1024 + col)); B1[col] = mod_val(F, b, col); }
        if (rb < 96 && F.tid < 256) { const int idx = rb * 256 + F.tid; ((float*)(F.ws + WS_MODF))[idx] = mod_val(F, idx / 6144, idx % 6144); }
        __syncthreads();
#pragma unroll
        for (int i = 0; i < 8; ++i) {
            const int row = rb * 64 + F.wave * 8 + i;
            float ss = 0.f;
#pragma unroll
            for (int j = 0; j < 4; ++j) ss += (v[i][j].x * v[i][j].x + v[i][j].y * v[i][j].y) + (v[i][j].z * v[i][j].z + v[i][j].w * v[i][j].w);
            const float rs = rsqrtf(wave_sum(ss) * (1.0f / 1024.0f) + EPS);
            u32x2* o8 = (u32x2*)(H + (size_t)row * 1024) + F.lane;
#pragma unroll
            for (int j = 0; j < 4; ++j) { const int c0 = 4 * F.lane + 256 * j;
                const f32x4 a = *(const LAS f32x4*)(A1 + c0), bb = *(const LAS f32x4*)(B1 + c0);
                const f32x4 y = v[i][j] * rs * a + bb; u32x2 w; w.x = pk2(y.x, y.y); w.y = pk2(y.z, y.w); o8[64 * j] = w; }
        }
        __syncthreads();
    }
}

__device__ __forceinline__ void p3_compress_item(Frame& F, int wi, const bool lds_only_tail = false) {
    const int lane = F.lane, r32 = lane & 31, hi = lane >> 5;
    const int nt = wi & 1, kv = (wi >> 1) & 1, it = (wi >> 2) & 7, g = (wi >> 5) & 1, b = wi >> 6;
    const bf16* Z = (const bf16*)(F.ws + WS_Z);
    const int i = it * 32 + r32; const bool ok = i < 255; const int ic = ok ? i : 0;
    const bf16* zrow0 = Z + (size_t)(b * SEQ + 16 * ic) * ZP + (kv ? ZC_VC : ZC_KC) + g * 64 + hi * 8;
    const bf16* wrow = (const bf16*)(F.ws + WS_WCMP) + (size_t)(kv * 64 + nt * 32 + r32) * 2048 + hi * 8;
    f32x16 acc = {};
    bf16x8 av[16], bv[16];
#pragma unroll
    for (int k = 0; k < 16; ++k) { const int ks = F.wave * 16 + k, l = ks >> 2, dq = ks & 3; av[k] = *(const bf16x8*)(zrow0 + (size_t)l * ZP + dq * 16); bv[k] = *(const bf16x8*)(wrow + ks * 16); }
#pragma unroll
    for (int k = 0; k < 16; ++k) { bf16x8 a = av[k]; if (!ok) a = (bf16x8){0, 0, 0, 0, 0, 0, 0, 0}; acc = __builtin_amdgcn_mfma_f32_32x32x16_bf16(a, bv[k], acc, 0, 0, 0); }
    LAS float* part = (LAS float*)F.lds;
#pragma unroll
    for (int r = 0; r < 16; ++r) part[(F.wave * 16 + r) * 64 + lane] = acc[r];
    __syncthreads();
    bf16* dst = (bf16*)(F.ws + (kv ? WS_VC : WS_KC)) + (size_t)((b * 2 + g) * 256) * 64;
#pragma unroll
    for (int k = 0; k < 2; ++k) { const int o = F.tid + NTHR * k, r = o >> 6, ln = o & 63; float v = 0.f;
#pragma unroll
        for (int w = 0; w < 8; ++w) v += part[(w * 16 + r) * 64 + ln];
        const int irow = it * 32 + crow(r, ln >> 5), e = nt * 32 + (ln & 31);
        dst[(size_t)irow * 64 + e] = (bf16)f2bf(irow < 255 ? v + ((const float*)(F.ws + WS_CMPB))[kv * 64 + e] : 0.f); }
    if (lds_only_tail) { asm volatile("s_waitcnt lgkmcnt(0)" ::: "memory"); __builtin_amdgcn_s_barrier(); asm volatile("" ::: "memory"); } else __syncthreads();
}
__device__ __forceinline__ void chunk_gates(const Frame& F, int b, int h, int c, float& ig, float& g) {
    const bf16* Z = (const bf16*)(F.ws + WS_Z); const size_t row = (size_t)(b * SEQ + c * 64 + F.lane) * ZP;
    ig = bf2f(Z[row + ZC_IG + h]) + F.in[9][h];
    const float fp = bf2f(Z[row + ZC_FG + h]) + F.in[9][4 + h];
    float v = logsigmoidf_(fp);
#pragma unroll
    for (int o = 1; o < 64; o <<= 1) { const float t = __shfl_up(v, o); if (F.lane >= o) v += t; }
    g = v;
}
__device__ __forceinline__ void conv8(const Frame& F, int b, int t, int zc, int cc, float (&o)[8]) {
    const bf16* Z = (const bf16*)(F.ws + WS_Z); const float* cw = F.in[10];
#pragma unroll
    for (int j = 0; j < 8; ++j) o[j] = 0.f;
#pragma unroll
    for (int jj = 0; jj < 4; ++jj) { const int tt = t - 3 + jj;
        if (tt >= 0) { const bf16x8 v = *(const bf16x8*)(Z + (size_t)(b * SEQ + tt) * ZP + zc);
            const f32x4 w0 = *(const f32x4*)(cw + jj * 1024 + cc), w1 = *(const f32x4*)(cw + jj * 1024 + cc + 4);
#pragma unroll
            for (int j = 0; j < 4; ++j) { o[j] += w0[j] * bf2f((unsigned short)v[j]); o[4 + j] += w1[j] * bf2f((unsigned short)v[4 + j]); } } }
#pragma unroll
    for (int j = 0; j < 8; ++j) o[j] = siluf_(o[j]);
}
struct ConvRaw { bf16x8 v[4]; };
__device__ __forceinline__ void conv8_load(const Frame& F, int b, int t, int zc, ConvRaw& r) {
    const bf16* Z = (const bf16*)(F.ws + WS_Z);
#pragma unroll
    for (int jj = 0; jj < 4; ++jj) { const int tt = t - 3 + jj; r.v[jj] = (bf16x8){0, 0, 0, 0, 0, 0, 0, 0}; if (tt >= 0) r.v[jj] = *(const bf16x8*)(Z + (size_t)(b * SEQ + tt) * ZP + zc); }
}
__device__ __forceinline__ void conv8_calc(const Frame& F, const ConvRaw& r, int cc, float (&o)[8]) {
    const float* cw = F.in[10];
#pragma unroll
    for (int j = 0; j < 8; ++j) o[j] = 0.f;
#pragma unroll
    for (int jj = 0; jj < 4; ++jj) { const f32x4 w0 = *(const f32x4*)(cw + jj * 1024 + cc), w1 = *(const f32x4*)(cw + jj * 1024 + cc + 4);
#pragma unroll
        for (int j = 0; j < 4; ++j) { o[j] += w0[j] * bf2f((unsigned short)r.v[jj][j]); o[4 + j] += w1[j] * bf2f((unsigned short)r.v[jj][4 + j]); } }
#pragma unroll
    for (int j = 0; j < 8; ++j) o[j] = siluf_(o[j]);
}
constexpr int KT_STRIDE = 72, QS_STRIDE = 136;
__device__ __forceinline__ void conv8_calc_lds(const LAS float* cwl, int nch, const ConvRaw& r, int lc, float (&o)[8]) {
#pragma unroll
    for (int j = 0; j < 8; ++j) o[j] = 0.f;
#pragma unroll
    for (int jj = 0; jj < 4; ++jj) { const f32x4 w0 = *(const LAS f32x4*)(cwl + jj * nch + lc), w1 = *(const LAS f32x4*)(cwl + jj * nch + lc + 4);
#pragma unroll
        for (int j = 0; j < 4; ++j) { o[j] += w0[j] * bf2f((unsigned short)r.v[jj][j]); o[4 + j] += w1[j] * bf2f((unsigned short)r.v[jj][4 + j]); } }
#pragma unroll
    for (int j = 0; j < 8; ++j) o[j] = siluf_(o[j]);
}
__device__ __forceinline__ void p3_mlstm_a_items(Frame& F) {
    const int tid = F.tid, lane = F.lane, r32 = lane & 31, hi = lane >> 5;
    LAS bf16* kT = (LAS bf16*)F.lds; LAS bf16* vwT = kT + 128 * KT_STRIDE; LAS float* wexA = (LAS float*)(F.lds + 2 * 128 * KT_STRIDE * 2);
    LAS float* cwl = wexA + 256;
    const bf16* Z = (const bf16*)(F.ws + WS_Z);
    float* SCG = (float*)(F.ws + WS_SC); float* SCM = SCG + 1024;
    int cur_h = -1;
#define P3_LBAR() do { asm volatile("s_waitcnt lgkmcnt(0)" ::: "memory"); __builtin_amdgcn_s_barrier(); asm volatile("" ::: "memory"); } while (0)
#define P3_LOAD(item_) do { const int b_ = (item_) >> 8, h_ = ((item_) >> 6) & 3, c_ = (item_) & 63; \
        _Pragma("unroll") for (int rep = 0; rep < 2; ++rep) { const int task = tid + NTHR * rep, l = task >> 4, ch = task & 15, t = c_ * 64 + l; \
            conv8_load(F, b_, t, ZC_KM + h_ * 128 + ch * 8, rk[rep]); rvv[rep] = *(const bf16x8*)(Z + (size_t)(b_ * SEQ + t) * ZP + ZC_VM + h_ * 128 + ch * 8); } } while (0)
    ConvRaw rk[2]; bf16x8 rvv[2];
    int item = F.vcu, kq = 0;
    if (item < 1024) {
        P3_LOAD(item);
        for (int wi = F.vcu; wi < 256; wi += F.G) p3_compress_item(F, wi, true);
        for (;;) {
            const int h = (item >> 6) & 3;
            if ((kq & 3) == 0) {
                P3_LBAR();
                if (F.wave < 4) { const int it2 = item + F.wave * F.G;
                    if (it2 < 1024) { const int b2 = it2 >> 8, h2 = (it2 >> 6) & 3, c2 = it2 & 63;
                        float ig, g; chunk_gates(F, b2, h2, c2, ig, g);
                        const float G = __shfl(g, 63), wl = G - g + ig, ml = wave_max(wl);
                        wexA[F.wave * 64 + lane] = __expf(wl - ml);
                        if (lane == 0) { SCG[it2] = G; SCM[it2] = ml; } } } }
            if (h != cur_h) { P3_LBAR(); cwl[tid] = F.in[10][(tid >> 7) * 1024 + 512 + h * 128 + (tid & 127)]; cur_h = h; }
            P3_LBAR();
            const LAS float* wex = wexA + (kq & 3) * 64;
#pragma unroll
            for (int rep = 0; rep < 2; ++rep) { const int task = tid + NTHR * rep, l = task >> 4, ch = task & 15;
                float kk[8]; conv8_calc_lds(cwl, 128, rk[rep], ch * 8, kk);
                const bf16x8 vv = rvv[rep]; const float we = wex[l];
                const int lsw = l ^ ((ch & 7) << 3);
#pragma unroll
                for (int j = 0; j < 8; ++j) { kT[(ch * 8 + j) * KT_STRIDE + lsw] = (bf16)f2bf(kk[j] * 0.08838834764831845f); vwT[(ch * 8 + j) * KT_STRIDE + lsw] = (bf16)f2bf(bf2f((unsigned short)vv[j]) * we); } }
            const int nitem = item + F.G;
            if (nitem < 1024) P3_LOAD(nitem);
            P3_LBAR();
            {
                const int et = F.wave >> 1; bf16* DC = (bf16*)(F.ws + WS_DC) + (size_t)item * 16384;
#pragma unroll
                for (int dt2 = 0; dt2 < 2; ++dt2) { const int dt = 2 * (F.wave & 1) + dt2; f32x16 acc = {};
#pragma unroll
                    for (int ks = 0; ks < 4; ++ks) { const int swa = ((et * 32 + r32) >> 3) & 7, swb = ((dt * 32 + r32) >> 3) & 7;
                        const bf16x8 a = *(const LAS bf16x8*)(vwT + (et * 32 + r32) * KT_STRIDE + ((ks * 2 + hi) ^ swa) * 8), bq = *(const LAS bf16x8*)(kT + (dt * 32 + r32) * KT_STRIDE + ((ks * 2 + hi) ^ swb) * 8);
                        acc = __builtin_amdgcn_mfma_f32_32x32x16_bf16(a, bq, acc, 0, 0, 0); }
#pragma unroll
                    for (int r = 0; r < 16; ++r) DC[(size_t)(et * 32 + crow(r, hi)) * 128 + dt * 32 + r32] = (bf16)f2bf(acc[r]); }
                { const int d = tid >> 2, part = tid & 3; float s = 0.f;
#pragma unroll
                    for (int l = 0; l < 16; ++l) s += wex[part * 16 + l] * bf2f(kT[d * KT_STRIDE + ((part * 16 + l) ^ (((d >> 3) & 7) << 3))]);
                    s += __shfl_xor(s, 1); s += __shfl_xor(s, 2);
                    if (part == 0) ((float*)(F.ws + WS_DN))[(size_t)item * 128 + d] = s; }
            }
            if (nitem >= 1024) break;
            item = nitem; ++kq;
        }
    }
#undef P3_LBAR
#undef P3_LOAD
    __syncthreads();
}

__device__ __forceinline__ void p4_scan(Frame& F) {
    const float* SCG = (const float*)(F.ws + WS_SC); const float* SCM = SCG + 1024; float* MP = (float*)(F.ws + WS_SC) + 2048;
    for (int it = F.vcu; it < 256; it += F.G) {
        const int bh = it >> 4, idx = (it & 15) * 512 + F.tid; const bool wmp = ((it & 15) == 0) && F.tid == 0;
        const unsigned* __restrict__ src = (const unsigned*)(F.ws + WS_DC) + idx; unsigned* __restrict__ dst = (unsigned*)(F.ws + WS_CP) + idx;
        float m = -INFINITY, s0 = 0.f, s1 = 0.f;
        for (int cb = 0; cb < 4; ++cb) {
            unsigned v[16];
#pragma unroll
            for (int i = 0; i < 16; ++i) v[i] = __builtin_nontemporal_load(src + (size_t)(bh * 64 + cb * 16 + i) * 8192);
#pragma unroll
            for (int i = 0; i < 16; ++i) { const int ci = bh * 64 + cb * 16 + i; const float G = SCG[ci], ml = SCM[ci];
                const float mn = fmaxf(G + m, ml), a = __expf(G + m - mn), bc = __expf(ml - mn);
                dst[(size_t)ci * 8192] = pk2(s0, s1); if (wmp) MP[ci] = m;
                s0 = a * s0 + bc * bf2f(v[i] & 0xffffu); s1 = a * s1 + bc * bf2f(v[i] >> 16); m = mn; }
        }
        if (F.tid < 8) { const int flat = it * 8 + F.tid, bhn = flat >> 7, d = flat & 127;
            const float* __restrict__ sn = (const float*)(F.ws + WS_DN) + d; float* __restrict__ dn = (float*)(F.ws + WS_NP) + d;
            float mN = -INFINITY, st = 0.f;
            for (int cb = 0; cb < 4; ++cb) { float v[16];
#pragma unroll
                for (int i = 0; i < 16; ++i) v[i] = sn[(size_t)(bhn * 64 + cb * 16 + i) * 128];
#pragma unroll
                for (int i = 0; i < 16; ++i) { const int ci = bhn * 64 + cb * 16 + i; const float G = SCG[ci], ml = SCM[ci];
                    const float mn = fmaxf(G + mN, ml), a = __expf(G + mN - mn), bc = __expf(ml - mn);
                    dn[(size_t)ci * 128] = st; st = a * st + bc * v[i]; mN = mn; } } }
    }
}

namespace nsa {
constexpr int KOFF = 0, VOFF = 32768, TBOFF = 65536, WSFOFF = 71680, MSKOFF = 73728, UNIOFF = 74240, JLOFF = 74304, OACCOFF = 74752, QOFF0 = 123904;
constexpr float LOG2E = 1.4426950408889634f, C2 = 0.125f * LOG2E;
typedef short v4i16_t __attribute__((ext_vector_type(4)));
#define NSA_WAITV(n) asm volatile("s_waitcnt vmcnt(" #n ")" ::: "memory")
#define NSA_BAR() do { asm volatile("s_waitcnt lgkmcnt(0)" ::: "memory"); __builtin_amdgcn_s_barrier(); asm volatile("" ::: "memory"); } while (0)

__device__ __forceinline__ void dma_k(LAS unsigned char* L, int buf, int wid, int lane, const bf16* Kt, size_t P) {
    __builtin_amdgcn_global_load_lds((const unsigned*)(Kt + (size_t)lane * P + wid * 8), (LAS unsigned*)(L + KOFF + buf * 8192 + wid * 1024), 16, 0, 0);
}
__device__ __forceinline__ void dma_v(LAS unsigned char* L, int buf, int wid, int lane, const bf16* Vt, size_t P) {
    __builtin_amdgcn_global_load_lds((const unsigned*)(Vt + (size_t)(16 * (wid & 3) + (lane >> 2)) * P + (wid >> 2) * 32 + (lane & 3) * 8), (LAS unsigned*)(L + VOFF + buf * 8192 + wid * 1024), 16, 0, 0);
}
__device__ __forceinline__ void qkt(f32x16& p0, f32x16& p1, const LAS unsigned char* L, int buf, const LAS bf16x8* qr, int r32, int hi) {
    const LAS unsigned char* kb = L + KOFF + buf * 8192 + hi * 1024 + r32 * 16;
    p0 = (f32x16){}; p1 = (f32x16){};
#pragma unroll
    for (int d0 = 0; d0 < 4; ++d0) {
        const bf16x8 b0 = *(const LAS bf16x8*)(kb + d0 * 2048), b1 = *(const LAS bf16x8*)(kb + d0 * 2048 + 512), q = qr[d0 * 64];
        p0 = __builtin_amdgcn_mfma_f32_32x32x16_bf16(b0, q, p0, 0, 0, 0);
        p1 = __builtin_amdgcn_mfma_f32_32x32x16_bf16(b1, q, p1, 0, 0, 0); }
}
__device__ __forceinline__ s16x4 vtr(const LAS unsigned char* p) { return __builtin_bit_cast(s16x4, __builtin_amdgcn_ds_read_tr16_b64_v4i16((LAS v4i16_t*)p)); }
__device__ __forceinline__ void pv(f32x16 (&o)[2], const LAS unsigned char* L, int buf, const u32x4 (&pw)[4], int lane, int hi) {
    const LAS unsigned char* vp = L + VOFF + buf * 8192 + ((lane >> 4) & 1) * 32 + (lane & 3) * 8 + (4 * hi + ((lane & 15) >> 2)) * 64;
#pragma unroll
    for (int dh = 0; dh < 2; ++dh)
#pragma unroll
        for (int ks = 0; ks < 4; ++ks) {
            const s16x4 lo = vtr(vp + dh * 4096 + ks * 1024), hh = vtr(vp + dh * 4096 + ks * 1024 + 512);
            const bf16x8 vf = (bf16x8){lo[0], lo[1], lo[2], lo[3], hh[0], hh[1], hh[2], hh[3]};
            o[dh] = __builtin_amdgcn_mfma_f32_32x32x16_bf16(__builtin_bit_cast(bf16x8, pw[ks]), vf, o[dh], 0, 0, 0); }
}
__device__ __forceinline__ float xhalf(float x, int hi) {
    auto rr = __builtin_amdgcn_permlane32_swap(__float_as_uint(x), __float_as_uint(x), false, false); return __uint_as_float(hi ? rr[0] : rr[1]); }
__device__ __forceinline__ float dpp_xor1(float x) { return __int_as_float(__builtin_amdgcn_mov_dpp(__float_as_int(x), 0xB1, 0xF, 0xF, true)); }
__device__ __forceinline__ float dpp_xor2(float x) { return __int_as_float(__builtin_amdgcn_mov_dpp(__float_as_int(x), 0x4E, 0xF, 0xF, true)); }
__device__ __forceinline__ void score_tile(f32x16& p0, f32x16& p1, int dist0, int step, int dmax, bool laneok, bool usebias, const LAS float* tbh, int hi) {
    const int dbase = dist0 + step * 4 * hi;
#pragma unroll
    for (int r = 0; r < 16; ++r) {
        const int kk = (r & 3) + 8 * (r >> 2); const int da = dbase + step * kk, db = da + step * 32;
        float sa = p0[r] * C2, sb = p1[r] * C2;
        if (usebias) { sa += tbh[min(max(da, 0), 127)]; sb += tbh[min(max(db, 0), 127)]; }
        p0[r] = (laneok && da >= 0 && da < dmax) ? sa : -INFINITY;
        p1[r] = (laneok && db >= 0 && db < dmax) ? sb : -INFINITY; }
}
template <bool DIAG>
__device__ __forceinline__ void near_scores(f32x16& p0, f32x16& p1, const LAS float* tbD, int D0) {
#pragma unroll
    for (int r = 0; r < 16; ++r) { const int kk = (r & 3) + 8 * (r >> 2);
        float sa = __builtin_fmaf(p0[r], C2, tbD[-kk]), sb = __builtin_fmaf(p1[r], C2, tbD[-kk - 32]);
        if (DIAG) { sa = (kk <= D0) ? sa : -INFINITY; sb = (kk + 32 <= D0) ? sb : -INFINITY; }
        p0[r] = sa; p1[r] = sb; }
}
__device__ __forceinline__ void wedge_mask(f32x16& p0, f32x16& p1, int D) {
#pragma unroll
    for (int r = 0; r < 16; ++r) { const int kk = (r & 3) + 8 * (r >> 2); p0[r] = (kk > D) ? p0[r] : -INFINITY; p1[r] = (kk + 32 > D) ? p1[r] : -INFINITY; }
}
__device__ __forceinline__ float rowmax32(const f32x16& p0, const f32x16& p1) {
    float a = fmaxf(p0[0], p1[0]);
#pragma unroll
    for (int r = 1; r < 16; ++r) a = fmaxf(a, fmaxf(p0[r], p1[r]));
    return fmaxf(a, xchg_f<32>(a, threadIdx.x & 63));
}
template <bool HAS_O>
__device__ __forceinline__ void softmax_step(f32x16& p0, f32x16& p1, float& m, float& l, f32x16 (&o)[2], u32x4 (&pw)[4], LAS float* wsf, int r32, int hi, bool sel = true) {
    const float rm = sel ? rowmax32(p0, p1) : -INFINITY, mn = fmaxf(m, rm);
    if (__any(mn > m + 8.0f)) {
        const float alpha = __builtin_amdgcn_exp2f(m - mn); l *= alpha; m = mn;
        if (HAS_O) { if (hi == 0) wsf[r32] = alpha; LDS_WAIT();
#pragma unroll
            for (int r = 0; r < 16; ++r) { const float f = wsf[crow(r, hi)]; o[0][r] *= f; o[1][r] *= f; }
            LDS_WAIT(); }
    }
    const float off = sel ? -m : -INFINITY;
    float s0 = 0.f, s1 = 0.f;
#pragma unroll
    for (int r = 0; r < 16; ++r) { p0[r] = __builtin_amdgcn_exp2f(p0[r] + off); p1[r] = __builtin_amdgcn_exp2f(p1[r] + off); s0 += p0[r]; s1 += p1[r]; }
    l += s0 + s1;
#pragma unroll
    for (int k = 0; k < 2; ++k) { pw[k] = (u32x4){pk2(p0[8 * k], p0[8 * k + 1]), pk2(p0[8 * k + 2], p0[8 * k + 3]), pk2(p0[8 * k + 4], p0[8 * k + 5]), pk2(p0[8 * k + 6], p0[8 * k + 7])};
        pw[2 + k] = (u32x4){pk2(p1[8 * k], p1[8 * k + 1]), pk2(p1[8 * k + 2], p1[8 * k + 3]), pk2(p1[8 * k + 4], p1[8 * k + 5]), pk2(p1[8 * k + 6], p1[8 * k + 7])}; }
}
template <bool HAS_O = true>
__device__ __forceinline__ void softmax_fast(f32x16& p0, f32x16& p1, float& m, float& l, f32x16 (&o)[2], u32x4 (&pw)[4], LAS float* wsf, int r32, int hi, bool sel) {
    float a = fmaxf(fmaxf(p0[0], p0[1]), p1[0]), bq = fmaxf(fmaxf(p0[2], p0[3]), p1[1]); a = fmaxf(fmaxf(a, p1[2]), p1[3]);
#pragma unroll
    for (int r = 4; r < 16; r += 4) { a = fmaxf(fmaxf(a, p0[r]), p0[r + 1]); bq = fmaxf(fmaxf(bq, p0[r + 2]), p0[r + 3]); a = fmaxf(fmaxf(a, p1[r]), p1[r + 1]); bq = fmaxf(fmaxf(bq, p1[r + 2]), p1[r + 3]); }
    a = fmaxf(a, bq); a = fmaxf(a, xchg_f<32>(a, threadIdx.x & 63));
    const float rm = sel ? a * C2 : -INFINITY, mn = fmaxf(m, rm);
    if (__any(mn > m + 8.0f)) {
        const float alpha = __builtin_amdgcn_exp2f(m - mn); l *= alpha; m = mn;
        if (HAS_O) { if (hi == 0) wsf[r32] = alpha; LDS_WAIT();
#pragma unroll
            for (int r = 0; r < 16; ++r) { const float f = wsf[crow(r, hi)]; o[0][r] *= f; o[1][r] *= f; }
            LDS_WAIT(); }
    }
    const float off = sel ? -m : -INFINITY;
    float s0 = 0.f, s1 = 0.f;
#pragma unroll
    for (int r = 0; r < 16; ++r) { p0[r] = __builtin_amdgcn_exp2f(__builtin_fmaf(p0[r], C2, off)); p1[r] = __builtin_amdgcn_exp2f(__builtin_fmaf(p1[r], C2, off)); s0 += p0[r]; s1 += p1[r]; }
    l += s0 + s1;
#pragma unroll
    for (int k = 0; k < 2; ++k) { pw[k] = (u32x4){pk2(p0[8 * k], p0[8 * k + 1]), pk2(p0[8 * k + 2], p0[8 * k + 3]), pk2(p0[8 * k + 4], p0[8 * k + 5]), pk2(p0[8 * k + 6], p0[8 * k + 7])};
        pw[2 + k] = (u32x4){pk2(p1[8 * k], p1[8 * k + 1]), pk2(p1[8 * k + 2], p1[8 * k + 3]), pk2(p1[8 * k + 4], p1[8 * k + 5]), pk2(p1[8 * k + 6], p1[8 * k + 7])}; }
}
template <bool FIRST>
__device__ __forceinline__ void branch_merge(LAS bf16* oa, const f32x16 (&o)[2], float l, float gate, LAS float* wsf, int r32, int hi, int lane) {
    const float lt = l + xchg_f<32>(l, lane); const float f = lt > 0.f ? gate / lt : 0.f;
    LDS_WAIT(); if (hi == 0) wsf[r32] = f; LDS_WAIT();
#pragma unroll
    for (int r = 0; r < 16; ++r) { const float ff = wsf[crow(r, hi)];
        float a0 = o[0][r] * ff, a1 = o[1][r] * ff;
        if (!FIRST) { a0 += bf2f(oa[(2 * r) * 64 + lane]); a1 += bf2f(oa[(2 * r + 1) * 64 + lane]); }
        oa[(2 * r) * 64 + lane] = (bf16)f2bf(a0); oa[(2 * r + 1) * 64 + lane] = (bf16)f2bf(a1); }
    LDS_WAIT();
}

__device__ __forceinline__ float rowmax_raw(const f32x16& p0, const f32x16& p1, int lane) {
    float a = fmaxf(fmaxf(p0[0], p0[1]), p1[0]), bq = fmaxf(fmaxf(p0[2], p0[3]), p1[1]); a = fmaxf(fmaxf(a, p1[2]), p1[3]);
#pragma unroll
    for (int r = 4; r < 16; r += 4) { a = fmaxf(fmaxf(a, p0[r]), p0[r + 1]); bq = fmaxf(fmaxf(bq, p0[r + 2]), p0[r + 3]); a = fmaxf(fmaxf(a, p1[r]), p1[r + 1]); bq = fmaxf(fmaxf(bq, p1[r + 2]), p1[r + 3]); }
    a = fmaxf(a, bq); return fmaxf(a, xchg_f<32>(a, lane));
}
__device__ __forceinline__ void rescale_o(f32x16 (&o)[2], float& m, float& l, float mn, LAS float* wsf, int r32, int hi) {
    const float alpha = __builtin_amdgcn_exp2f(m - mn); l *= alpha; m = mn;
    if (hi == 0) wsf[r32] = alpha; LDS_WAIT();
#pragma unroll
    for (int r = 0; r < 16; ++r) { const float f = wsf[crow(r, hi)]; float t0 = o[0][r], t1 = o[1][r];
        asm volatile("v_mul_f32 %0, %0, %1" : "+v"(t0) : "v"(f)); asm volatile("v_mul_f32 %0, %0, %1" : "+v"(t1) : "v"(f)); o[0][r] = t0; o[1][r] = t1; }
    LDS_WAIT();
}
template <bool QK>
__device__ __forceinline__ void exp_qk(f32x16& a0, f32x16& a1, f32x16& n0, f32x16& n1, const LAS unsigned char* L, int nbuf, const bf16x8 (&qf)[4], int r32, int hi, float cs, float off, float& l, u32x4 (&pw)[4]) {
    const LAS unsigned char* kb = L + KOFF + nbuf * 8192 + hi * 1024 + r32 * 16;
    float s0 = 0.f, s1 = 0.f;
    if (QK) { n0 = (f32x16){}; n1 = (f32x16){}; }
#pragma unroll
    for (int d0 = 0; d0 < 4; ++d0) {
        if (QK) { const bf16x8 b0 = *(const LAS bf16x8*)(kb + d0 * 2048), b1 = *(const LAS bf16x8*)(kb + d0 * 2048 + 512), q = qf[d0];
            n0 = __builtin_amdgcn_mfma_f32_32x32x16_bf16(b0, q, n0, 0, 0, 0);
            n1 = __builtin_amdgcn_mfma_f32_32x32x16_bf16(b1, q, n1, 0, 0, 0); }
#pragma unroll
        for (int r = 4 * d0; r < 4 * d0 + 4; ++r) { a0[r] = __builtin_amdgcn_exp2f(__builtin_fmaf(a0[r], cs, off)); a1[r] = __builtin_amdgcn_exp2f(__builtin_fmaf(a1[r], cs, off)); s0 += a0[r]; s1 += a1[r]; }
    }
    l += s0 + s1;
#pragma unroll
    for (int k = 0; k < 2; ++k) { pw[k] = (u32x4){pk2(a0[8 * k], a0[8 * k + 1]), pk2(a0[8 * k + 2], a0[8 * k + 3]), pk2(a0[8 * k + 4], a0[8 * k + 5]), pk2(a0[8 * k + 6], a0[8 * k + 7])};
        pw[2 + k] = (u32x4){pk2(a1[8 * k], a1[8 * k + 1]), pk2(a1[8 * k + 2], a1[8 * k + 3]), pk2(a1[8 * k + 4], a1[8 * k + 5]), pk2(a1[8 * k + 6], a1[8 * k + 7])}; }
}
template <bool MX>
__device__ __forceinline__ float pv_max(f32x16 (&o)[2], const LAS unsigned char* L, int buf, const u32x4 (&pw)[4], int lane, int hi, const f32x16& n0, const f32x16& n1) {
    const LAS unsigned char* vp = L + VOFF + buf * 8192 + ((lane >> 4) & 1) * 32 + (lane & 3) * 8 + (4 * hi + ((lane & 15) >> 2)) * 64;
    float a = -INFINITY, bq = -INFINITY;
#pragma unroll
    for (int dh = 0; dh < 2; ++dh)
#pragma unroll
        for (int ks = 0; ks < 4; ++ks) {
            const s16x4 lo = vtr(vp + dh * 4096 + ks * 1024), hh = vtr(vp + dh * 4096 + ks * 1024 + 512);
            const bf16x8 vf = (bf16x8){lo[0], lo[1], lo[2], lo[3], hh[0], hh[1], hh[2], hh[3]};
            o[dh] = __builtin_amdgcn_mfma_f32_32x32x16_bf16(__builtin_bit_cast(bf16x8, pw[ks]), vf, o[dh], 0, 0, 0);
            if (MX) { const int t = 2 * (dh * 4 + ks); a = fmaxf(fmaxf(a, n0[t]), n0[t + 1]); bq = fmaxf(fmaxf(bq, n1[t]), n1[t + 1]); } }
    if (!MX) return 0.f;
    a = fmaxf(a, bq); return fmaxf(a, xchg_f<32>(a, lane));
}
#define NSA2_X(i_, P0, P1, CS, SL) do { const int j_ = TILEJ(i_); SL = TSEL(j_); const int d_ = cur - j_; \
        if (d_ < 3) { const int D0 = tq - 64 * j_ - 4 * hi; if (d_ == 0) near_scores<true>(P0, P1, tbh + D0, D0); else near_scores<false>(P0, P1, tbh + D0, D0); CS = 1.0f; } \
        else { if (WEDGE && d_ >= 8) wedge_mask(P0, P1, tq - 64 * cur - 4 * hi); CS = C2; } } while (0)
#define NSA2_BODY(idx_, A0, A1, RMA, CSA, SLA, B0, B1, RMB, CSB, SLB) do { const int i_ = (idx_); \
        if (i_ + 2 < n_) NSA_WAITV(2); else NSA_WAITV(0); \
        NSA_BAR(); \
        if (i_ + 3 < n_) { ISSUE(i_ + 3, (i_ + 3) & 3); } \
        { const float mn_ = fmaxf(m, RMA); if (__any(mn_ > m + 8.0f)) rescale_o(o, m, l, mn_, wsf, r32, hi); } \
        const float off_ = SLA ? -m : -INFINITY; \
        exp_qk<true>(A0, A1, B0, B1, L, (i_ + 1) & 3, qf, r32, hi, CSA, off_, l, pw);        \
        SLB = false; CSB = C2; \
        if (i_ + 1 < n_) { NSA2_X(i_ + 1, B0, B1, CSB, SLB); } \
        { const float a_ = pv_max<true>(o, L, i_ & 3, pw, lane, hi, B0, B1); RMB = SLB ? a_ * CSB : -INFINITY; } \
    } while (0)
#define NSA2_LOOP(NTILES) do { const int n_ = (NTILES); \
        ISSUE(0, 0); if (n_ > 1) { ISSUE(1, 1); } if (n_ > 2) { ISSUE(2, 2); } \
        if (n_ > 2) NSA_WAITV(4); else if (n_ > 1) NSA_WAITV(2); else NSA_WAITV(0); \
        NSA_BAR(); \
        bf16x8 qf[4]; _Pragma("unroll") for (int d0_ = 0; d0_ < 4; ++d0_) qf[d0_] = qr[d0_ * 64]; \
        qkt(pa0, pa1, L, 0, qr, r32, hi); NSA2_X(0, pa0, pa1, csa, sla); rma = sla ? rowmax_raw(pa0, pa1, lane) * csa : -INFINITY; \
        for (int idx = 0; idx < n_; idx += 2) { \
            NSA2_BODY(idx, pa0, pa1, rma, csa, sla, pb0, pb1, rmb, csb, slb); \
            if (idx + 1 < n_) NSA2_BODY(idx + 1, pb0, pb1, rmb, csb, slb, pa0, pa1, rma, csa, sla); } \
        NSA_BAR(); } while (0)

#define NSA_LOOP(NTILES, NDMA, ISSUE, COMPUTE) do { const int n_ = (NTILES); \
        ISSUE(0, 0); if (n_ > 1) { ISSUE(1, 1); } \
        for (int idx = 0; idx < n_; ++idx) { \
            if (idx + 1 < n_) { if (NDMA == 2) NSA_WAITV(2); else NSA_WAITV(1); } else { NSA_WAITV(0); } \
            NSA_BAR(); \
            if (idx + 2 < n_) { ISSUE(idx + 2, (idx + 2) & 3); } \
            COMPUTE(idx, idx & 3); } \
        NSA_BAR(); } while (0)

template <int VAR>
__device__ __forceinline__ void attn_unit(const Frame& F, int b, int g, int cur, bf16* Y, bool FILL_TB) {
    LAS unsigned char* L = F.lds;
    int lane_ = F.lane; asm volatile("" : "+v"(lane_));
    const int lane = lane_, wid = F.wave, r32 = lane & 31, hi = lane >> 5, tid = F.tid;
    const bf16* Z = (const bf16*)(F.ws + WS_Z);
    const int qi = r32 >> 2, hp = r32 & 3, head = g * 4 + hp;
    const int tq = cur * 64 + wid * 8 + qi;
    const size_t zrow = (size_t)(b * SEQ + tq) * ZP;
    LAS float* tb = (LAS float*)(L + TBOFF);
    if (FILL_TB) for (int i = tid; i < 4 * 384; i += NTHR) { const int hpp = i / 384, dd = i % 384 - 64; tb[i] = (dd >= 0 && dd < 128) ? (F.in[15][T5B[dd & 127] * 8 + g * 4 + hpp] - F.in[15][31 * 8 + g * 4 + hpp]) * LOG2E : 0.f; }
    const LAS float* tbh = tb + hp * 384 + 64;
    LAS bf16x8* qr = (LAS bf16x8*)(L + (wid == 0 ? QOFF0 : TAB_OFF + (wid - 1) * 4096)) + lane;
#pragma unroll
    for (int d0 = 0; d0 < 4; ++d0) qr[d0 * 64] = *(const bf16x8*)(Z + zrow + ZC_QA + head * 64 + d0 * 16 + hi * 8);
#define NSA_GATE(br) sigmoidf_(bf2f(Z[zrow + ZC_GA + head * 3 + (br)]))
    LAS float* wsf = (LAS float*)(L + WSFOFF) + wid * 64;
    LAS unsigned long long* msk = (LAS unsigned long long*)(L + MSKOFF);
    LAS unsigned long long* uni = (LAS unsigned long long*)(L + UNIOFF);
    LAS int* jl = (LAS int*)(L + JLOFF);
    LAS bf16* oa = (LAS bf16*)(L + OACCOFF) + wid * 2048;
    LAS float* sc = (LAS float*)oa;
    f32x16 p0, p1, o[2]; u32x4 pw[4];
    NSA_BAR();

    {
        const bf16* KCb = (const bf16*)(F.ws + WS_KC) + (size_t)((b * 2 + g) * 256) * 64;
        const bf16* VCb = (const bf16*)(F.ws + WS_VC) + (size_t)((b * 2 + g) * 256) * 64;
        const int nT = (4 * cur + 2) / 64 + 1;
        float m = -1e30f, l = 0.f;
#define B1_COMP1(T, s) do { qkt(p0, p1, L, s, qr, r32, hi); \
            if (cur >= 16 * (T) + 19) softmax_fast<false>(p0, p1, m, l, o, pw, wsf, r32, hi, true); \
            else { score_tile(p0, p1, tq - 31 - 16 * 64 * (T), -16, 1 << 30, true, true, tbh, hi); softmax_step<false>(p0, p1, m, l, o, pw, wsf, r32, hi); } } while (0)
        for (int T = 0; T < nT; ++T) { dma_k(L, T, wid, lane, KCb + (size_t)T * 64 * 64, 64); dma_v(L, T, wid, lane, VCb + (size_t)T * 64 * 64, 64); }
        NSA_WAITV(0); NSA_BAR();
        for (int T = 0; T < nT; ++T) B1_COMP1(T, T);
        const float lt = l + xchg_f<32>(l, lane); const float inv_l = lt > 0.f ? 1.0f / lt : 0.f;
        o[0] = (f32x16){}; o[1] = (f32x16){};
        float carry = 0.f;
#define B1_COMP2(T, s) do { qkt(p0, p1, L, s, qr, r32, hi); \
            if (cur >= 16 * (T) + 19) { _Pragma("unroll") for (int r = 0; r < 16; ++r) { p0[r] *= C2; p1[r] *= C2; } } \
            else score_tile(p0, p1, tq - 31 - 16 * 64 * (T), -16, 1 << 30, true, true, tbh, hi); \
            float ps8[9]; \
            _Pragma("unroll") for (int i = 0; i < 9; ++i) ps8[i] = 0.f; \
            ps8[0] = (hi == 0) ? carry : 0.f; \
            _Pragma("unroll") for (int r = 0; r < 16; ++r) { p0[r] = __builtin_amdgcn_exp2f(p0[r] - m) * inv_l; p1[r] = __builtin_amdgcn_exp2f(p1[r] - m) * inv_l; } \
            _Pragma("unroll") for (int sub = 0; sub < 2; ++sub) _Pragma("unroll") for (int n = 0; n < 4; ++n) { \
                const float q0 = sub ? p1[4 * n] : p0[4 * n], q1 = sub ? p1[4 * n + 1] : p0[4 * n + 1], q2 = sub ? p1[4 * n + 2] : p0[4 * n + 2], q3 = sub ? p1[4 * n + 3] : p0[4 * n + 3]; \
                const float a = (q0 + q1) + (q2 + 0.5f * q3), bq = 0.5f * q3, bsw = xhalf(bq, hi); \
                if (hi == 1) ps8[sub * 4 + n] += a + bsw; else { ps8[sub * 4 + n] += a; ps8[sub * 4 + n + 1] += bsw; } } \
            carry = ps8[8]; \
            _Pragma("unroll") for (int i = 0; i < 8; ++i) { float v = ps8[i]; v += dpp_xor1(v); v += dpp_xor2(v); if (hp == 0) sc[qi * 64 + 16 * (T) + 2 * i + hi] = v; } \
            _Pragma("unroll") for (int k = 0; k < 2; ++k) { pw[k] = (u32x4){pk2(p0[8 * k], p0[8 * k + 1]), pk2(p0[8 * k + 2], p0[8 * k + 3]), pk2(p0[8 * k + 4], p0[8 * k + 5]), pk2(p0[8 * k + 6], p0[8 * k + 7])}; \
                pw[2 + k] = (u32x4){pk2(p1[8 * k], p1[8 * k + 1]), pk2(p1[8 * k + 2], p1[8 * k + 3]), pk2(p1[8 * k + 4], p1[8 * k + 5]), pk2(p1[8 * k + 6], p1[8 * k + 7])}; } \
            pv(o, L, s, pw, lane, hi); } while (0)
        for (int T = 0; T < nT; ++T) B1_COMP2(T, T);
        NSA_BAR();
    }
    unsigned long long mymask; int nsel;
    {
        LDS_WAIT();
        f32x4 va = {0.f, 0.f, 0.f, 0.f}, vb = va;
        if (cur >= 16) { va = *(const LAS f32x4*)(sc + (lane >> 3) * 64 + (lane & 7) * 8); vb = *(const LAS f32x4*)(sc + (lane >> 3) * 64 + (lane & 7) * 8 + 4); }
        branch_merge<true>(oa, o, 0.5f, NSA_GATE(0), wsf, r32, hi, lane);
        if (cur >= 16) {
            {
                const int q = lane >> 3, ch = lane & 7;
                unsigned bits[8]; unsigned vmask = 0u;
#pragma unroll
                for (int j = 0; j < 8; ++j) { const int blk = ch * 8 + j; const bool valid = blk <= cur; const bool forced = (blk == 0) || (blk == cur) || (blk == cur - 1);
                    const float v = (j < 4 ? va[j & 3] : vb[j & 3]) + (forced ? 1000.f : 0.f);
                    bits[j] = valid ? (__float_as_uint(v) & 0xfffff000u) : 0u; vmask |= valid ? (1u << j) : 0u; }
#define SUM8(x) do { x += __builtin_amdgcn_mov_dpp(x, 0xB1, 0xF, 0xF, true); x += __builtin_amdgcn_mov_dpp(x, 0x4E, 0xF, 0xF, true); x += __builtin_amdgcn_mov_dpp(x, 0x141, 0xF, 0xF, true); } while (0)
                unsigned T = 0u;
#pragma unroll
                for (int bt = 30; bt >= 12; --bt) { const unsigned cand = T | (1u << bt); int cnt = 0;
#pragma unroll
                    for (int j = 0; j < 8; ++j) cnt += (bits[j] >= cand) ? 1 : 0;
                    SUM8(cnt); T = (cnt >= 16) ? cand : T; }
                int ngt = 0, eqc = 0; unsigned gtm = 0u, eqm = 0u;
#pragma unroll
                for (int j = 0; j < 8; ++j) { const bool g_ = bits[j] > T, e_ = (bits[j] == T) && ((vmask >> j) & 1u); gtm |= g_ ? (1u << j) : 0u; eqm |= e_ ? (1u << j) : 0u; ngt += g_ ? 1 : 0; eqc += e_ ? 1 : 0; }
                SUM8(ngt);
                int pre = eqc;
                { int t = __builtin_amdgcn_mov_dpp(pre, 0x111, 0xF, 0xF, true); if (ch >= 1) pre += t; t = __builtin_amdgcn_mov_dpp(pre, 0x112, 0xF, 0xF, true); if (ch >= 2) pre += t; t = __builtin_amdgcn_mov_dpp(pre, 0x114, 0xF, 0xF, true); if (ch >= 4) pre += t; }
                int run = pre - eqc; const int need = 16 - ngt; unsigned m8 = gtm;
#pragma unroll
                for (int j = 0; j < 8; ++j) { const bool e_ = (eqm >> j) & 1u; if (e_ && run < need) m8 |= 1u << j; run += e_ ? 1 : 0; }
                ((LAS unsigned char*)msk)[(wid * 8 + q) * 8 + ch] = (unsigned char)m8;
#undef SUM8
            }
        } else {
            if (lane < 8) msk[wid * 8 + lane] = (2ull << cur) - 1ull;
        }
        LDS_WAIT();
        mymask = msk[wid * 8 + qi];
        unsigned long long u = mymask;
#pragma unroll
        for (int o_ = 4; o_ < 32; o_ <<= 1) { const unsigned lo = __shfl_xor((unsigned)u, o_), hh = __shfl_xor((unsigned)(u >> 32), o_); u |= ((unsigned long long)hh << 32) | lo; }
        if (lane == 0) uni[wid] = u;
        NSA_BAR();
        unsigned long long umask = 0ull;
#pragma unroll
        for (int w = 0; w < 8; ++w) umask |= uni[w];
        umask = ((unsigned long long)__builtin_amdgcn_readfirstlane((unsigned)(umask >> 32)) << 32) | (unsigned)__builtin_amdgcn_readfirstlane((unsigned)umask);
        nsel = __builtin_popcountll(umask);
        if (wid == 0 && ((umask >> lane) & 1ull)) jl[__builtin_popcountll(umask & ((1ull << lane) - 1ull))] = lane;
        NSA_BAR();
    }
    {
        const bf16* Kb = Z + (size_t)(b * SEQ) * ZP + ZC_KS + g * 64; const bf16* Vb = Z + (size_t)(b * SEQ) * ZP + ZC_VS + g * 64;
        float m = -1e30f, l = 0.f; o[0] = (f32x16){}; o[1] = (f32x16){};
f32x16 pa0, pa1, pb0, pb1; float rma, rmb = 0.f, csa, csb = 0.f; bool sla, slb = false;
#define ISSUE(i_, s) do { const int jj_ = __builtin_amdgcn_readfirstlane(jl[i_]); dma_k(L, s, wid, lane, Kb + (size_t)(64 * jj_) * ZP, ZP); dma_v(L, s, wid, lane, Vb + (size_t)(64 * jj_) * ZP, ZP); } while (0)
#define TILEJ(i_) __builtin_amdgcn_readfirstlane(jl[i_])
#define TSEL(j_) (((mymask >> (j_)) & 1ull) != 0ull)
#define WEDGE false
        NSA2_LOOP(nsel);
#undef ISSUE
#undef TILEJ
#undef TSEL
#undef WEDGE
        branch_merge<false>(oa, o, l, NSA_GATE(1), wsf, r32, hi, lane);
    }
    {
        const bf16* Kb = Z + (size_t)(b * SEQ) * ZP + ZC_KW + g * 64; const bf16* Vb = Z + (size_t)(b * SEQ) * ZP + ZC_VW + g * 64;
        float m = -1e30f, l = 0.f; o[0] = (f32x16){}; o[1] = (f32x16){};
        const int j0 = cur >= 8 ? cur - 8 : 0, nT = cur - j0 + 1;
f32x16 pa0, pa1, pb0, pb1; float rma, rmb = 0.f, csa, csb = 0.f; bool sla, slb = false;
#define ISSUE(T, s) do { dma_k(L, s, wid, lane, Kb + (size_t)(64 * (j0 + (T))) * ZP, ZP); dma_v(L, s, wid, lane, Vb + (size_t)(64 * (j0 + (T))) * ZP, ZP); } while (0)
#define TILEJ(i_) (j0 + (i_))
#define TSEL(j_) true
#define WEDGE true
        NSA2_LOOP(nT);
#undef ISSUE
#undef TILEJ
#undef TSEL
#undef WEDGE
        branch_merge<false>(oa, o, l, NSA_GATE(2), wsf, r32, hi, lane);
    }
#pragma unroll
    for (int r = 0; r < 16; ++r) { const int row = crow(r, hi), q_ = row >> 2, hp_ = row & 3;
        bf16* dst = Y + (size_t)(b * SEQ + cur * 64 + wid * 8 + q_) * 1024 + 512 + (g * 4 + hp_) * 64 + r32;
        dst[0] = oa[(2 * r) * 64 + lane]; dst[32] = oa[(2 * r + 1) * 64 + lane]; }
#undef B1_COMP1
#undef B1_COMP2
#undef NSA_GATE
}
template <int VAR>
__device__ __forceinline__ void p4_attention(Frame& F, bf16* Y) {
    for (int v = F.vcu; v < 256; v += F.G) {
        const int bg = v >> 5, s = v & 31;
#pragma unroll 1
        for (int u2 = 0; u2 < 2; ++u2) attn_unit<VAR>(F, bg >> 1, bg & 1, u2 ? s : 63 - s, Y, u2 == 0);
    }
}
}

__device__ __forceinline__ f32x16 mma32_lds(const LAS bf16* A, int sa, const LAS bf16* Bt, int sb, int ksteps, int r32, int hi, f32x16 acc) {
#pragma unroll
    for (int ks = 0; ks < 8; ++ks) if (ks < ksteps) {
        const bf16x8 a = *(const LAS bf16x8*)(A + r32 * sa + ks * 16 + hi * 8), bq = *(const LAS bf16x8*)(Bt + r32 * sb + ks * 16 + hi * 8);
        acc = __builtin_amdgcn_mfma_f32_32x32x16_bf16(a, bq, acc, 0, 0, 0); }
    return acc;
}
__device__ __forceinline__ f32x16 mma32_lds_swzb(const LAS bf16* A, int sa, const LAS bf16* Bt, int sb, int ksteps, int r32, int hi, int swz, f32x16 acc) {
#pragma unroll
    for (int ks = 0; ks < 8; ++ks) if (ks < ksteps) {
        const bf16x8 a = *(const LAS bf16x8*)(A + r32 * sa + ks * 16 + hi * 8), bq = *(const LAS bf16x8*)(Bt + r32 * sb + ((ks * 2 + hi) ^ swz) * 8);
        acc = __builtin_amdgcn_mfma_f32_32x32x16_bf16(a, bq, acc, 0, 0, 0); }
    return acc;
}
__device__ __forceinline__ void p5_mlstm_c_items(Frame& F) {
    const int tid = F.tid, lane = F.lane, r32 = lane & 31, hi = lane >> 5, wid = F.wave;
    LAS bf16* Qs = (LAS bf16*)F.lds;
    LAS bf16* Qp = Qs + 64 * QS_STRIDE;
    LAS bf16* Ks = Qp + 64 * QS_STRIDE;
    LAS bf16* VT = Ks + 64 * QS_STRIDE;
    LAS bf16* CT = VT + 128 * KT_STRIDE;
    LAS bf16* Wm = CT + 128 * QS_STRIDE;
    LAS float* fu = (LAS float*)(Wm + 64 * KT_STRIDE);
    LAS float* frd = fu + 256; LAS float* fnp = fu + 320;
    LAS float* gtab = (LAS float*)(F.lds + 120 * 1024);
    LAS float* cwl = (LAS float*)(F.lds + 124 * 1024);
    const bf16* Z = (const bf16*)(F.ws + WS_Z);
    ConvRaw rq[2], rk[2]; bf16x8 rvv[2]; u32x4 cpv[4]; unsigned short ogn[16]; float np_n = 0.f;
#define P5_LOAD(item_) do { const int b_ = (item_) >> 8, h_ = ((item_) >> 6) & 3, c_ = (item_) & 63; \
    _Pragma("unroll") for (int rep = 0; rep < 2; ++rep) { const int task = tid + NTHR * rep, l = task >> 4, ch = task & 15, t = c_ * 64 + l; \
        conv8_load(F, b_, t, ZC_QM + h_ * 128 + ch * 8, rq[rep]); conv8_load(F, b_, t, ZC_KM + h_ * 128 + ch * 8, rk[rep]); \
        rvv[rep] = *(const bf16x8*)(Z + (size_t)(b_ * SEQ + t) * ZP + ZC_VM + h_ * 128 + ch * 8); } \
    { const bf16* cp = (const bf16*)(F.ws + WS_CP) + (size_t)(item_) * 16384; \
      _Pragma("unroll") for (int i = 0; i < 4; ++i) { const int q = tid + NTHR * i; cpv[i] = *(const u32x4*)(cp + q * 8); } } \
    { const int lt = wid & 1, et = wid >> 1; \
      _Pragma("unroll") for (int r = 0; r < 16; ++r) ogn[r] = Z[(size_t)(b_ * SEQ + c_ * 64 + lt * 32 + crow(r, hi)) * ZP + ZC_OM + h_ * 128 + et * 32 + r32]; } \
    if (tid >= 64 && tid < 192) np_n = ((const float*)(F.ws + WS_NP))[(size_t)(item_) * 128 + tid - 64]; } while (0)
    int item = F.vcu, kb = 0, cur_h = -1;
    if (item >= 1024) return;
    P5_LOAD(item);
    for (;;) {
    const int b = item >> 8, h = (item >> 6) & 3, c = item & 63;
    if ((kb & 3) == 0 && wid < 4) {
        const int it2 = item + wid * F.G;
        if (it2 < 1024) { const int b2 = it2 >> 8, h2 = (it2 >> 6) & 3, c2 = it2 & 63; const size_t zr = (size_t)(b2 * SEQ + c2 * 64 + lane) * ZP;
            const float ig = bf2f(Z[zr + ZC_IG + h2]) + F.in[9][h2]; float g = logsigmoidf_(bf2f(Z[zr + ZC_FG + h2]) + F.in[9][4 + h2]);
            const float Mp = ((const float*)(F.ws + WS_SC))[2048 + it2];
#pragma unroll
            for (int o = 1; o < 64; o <<= 1) { const float t = __shfl_up(g, o); if (lane >= o) g += t; }
            const float u = ig - g; float pm = u;
#pragma unroll
            for (int o = 1; o < 64; o <<= 1) { const float t = __shfl_up(pm, o); if (lane >= o) pm = fmaxf(pm, t); }
            const float mm = fmaxf(Mp, pm);
            LAS float* gt = gtab + wid * 256;
            gt[lane] = u; gt[64 + lane] = mm; gt[128 + lane] = __expf(Mp - mm); gt[192 + lane] = __expf(-(g + mm)); } }
    if (h != cur_h) {
#pragma unroll
        for (int k = 0; k < 2; ++k) { const int i = tid + NTHR * k, tap = i >> 8, lc = i & 255; cwl[i] = F.in[10][tap * 1024 + (lc < 128 ? h * 128 + lc : 512 + h * 128 + lc - 128)]; }
        cur_h = h; }
    const LAS float* fu = gtab + (kb & 3) * 256; const LAS float* fmm = fu + 64; const LAS float* fiw = fu + 128; const LAS float* ffl = fu + 192;
    if (tid >= 64 && tid < 192) fnp[tid - 64] = np_n;
    __syncthreads();
#pragma unroll
    for (int rep = 0; rep < 2; ++rep) { const int task = tid + NTHR * rep, l = task >> 4, ch = task & 15;
        float qq[8], kk[8];
        conv8_calc_lds(cwl, 256, rq[rep], ch * 8, qq);
        conv8_calc_lds(cwl, 256, rk[rep], 128 + ch * 8, kk);
        const float iw = fiw[l];
        u32x4 wq, wp, wk;
        wq.x = pk2(qq[0], qq[1]); wq.y = pk2(qq[2], qq[3]); wq.z = pk2(qq[4], qq[5]); wq.w = pk2(qq[6], qq[7]);
        wp.x = pk2(qq[0] * iw, qq[1] * iw); wp.y = pk2(qq[2] * iw, qq[3] * iw); wp.z = pk2(qq[4] * iw, qq[5] * iw); wp.w = pk2(qq[6] * iw, qq[7] * iw);
        const float sk = 0.08838834764831845f;
        wk.x = pk2(kk[0] * sk, kk[1] * sk); wk.y = pk2(kk[2] * sk, kk[3] * sk); wk.z = pk2(kk[4] * sk, kk[5] * sk); wk.w = pk2(kk[6] * sk, kk[7] * sk);
        *(LAS u32x4*)(Qs + l * QS_STRIDE + ch * 8) = wq; *(LAS u32x4*)(Qp + l * QS_STRIDE + ch * 8) = wp; *(LAS u32x4*)(Ks + l * QS_STRIDE + ch * 8) = wk;
        const bf16x8 vv = rvv[rep];
#pragma unroll
        for (int j = 0; j < 8; ++j) VT[(ch * 8 + j) * KT_STRIDE + (l ^ ((ch & 7) << 3))] = (bf16)vv[j]; }
    {
#pragma unroll
        for (int i = 0; i < 4; ++i) { const int q = tid + NTHR * i, e = q >> 4, d8 = (q & 15) * 8; *(LAS u32x4*)(CT + e * QS_STRIDE + d8) = cpv[i]; } }
    unsigned short og[16];
#pragma unroll
    for (int r = 0; r < 16; ++r) og[r] = ogn[r];
    const int nitem = item + F.G;
    if (nitem < 1024) P5_LOAD(nitem);
    __syncthreads();
    if (wid < 4) {
        const int lt = wid >> 1, st = wid & 1;
        f32x16 acc = {}; acc = mma32_lds(Qs + lt * 32 * QS_STRIDE, QS_STRIDE, Ks + st * 32 * QS_STRIDE, QS_STRIDE, 8, r32, hi, acc);
        const int s = st * 32 + r32; const float us = fu[s];
#pragma unroll
        for (int r = 0; r < 16; ++r) { const int l = lt * 32 + crow(r, hi); const float w = (s <= l) ? __expf(us - fmm[l]) * acc[r] : 0.f; Wm[l * KT_STRIDE + s] = (bf16)f2bf(w); }
    }
    __syncthreads();
    {
        const int l = tid >> 3, part = tid & 7; float dsum = 0.f;
#pragma unroll
        for (int s = 0; s < 8; ++s) dsum += bf2f(Wm[l * KT_STRIDE + part * 8 + s]);
#pragma unroll
        for (int d = 0; d < 16; ++d) dsum += bf2f(Qp[l * QS_STRIDE + part * 16 + d]) * fnp[part * 16 + d];
        dsum += __shfl_xor(dsum, 1); dsum += __shfl_xor(dsum, 2); dsum += __shfl_xor(dsum, 4);
        if (part == 0) frd[l] = 1.0f / fmaxf(fabsf(dsum), ffl[l]);
    }
    f32x16 acc = {};
    {
        const int lt = wid & 1, et = wid >> 1;
        acc = mma32_lds_swzb(Wm + lt * 32 * KT_STRIDE, KT_STRIDE, VT + et * 32 * KT_STRIDE, KT_STRIDE, 4, r32, hi, ((et * 32 + r32) >> 3) & 7, acc);
        acc = mma32_lds(Qp + lt * 32 * QS_STRIDE, QS_STRIDE, CT + et * 32 * QS_STRIDE, QS_STRIDE, 8, r32, hi, acc);
        __syncthreads();
        bf16* Y = (bf16*)(F.ws + WS_YMIX);
        const int e = et * 32 + r32;
#pragma unroll
        for (int r = 0; r < 16; ++r) { const int l = lt * 32 + crow(r, hi); const size_t row = (size_t)(b * SEQ + c * 64 + l);
            Y[row * 1024 + h * 128 + e] = (bf16)f2bf(acc[r] * frd[l] * sigmoidf_(bf2f(og[r]))); }
    }
    __syncthreads();
    if (nitem >= 1024) break;
    item = nitem; ++kb;
    }
#undef P5_LOAD
}

template <int L> __device__ __forceinline__ float rtree(const LAS float* WR, const f32x4 (&h2)[4], int base, int lane) {
    if constexpr (L == 0) { float s = 0.f;
#pragma unroll
        for (int j = 0; j < 4; ++j) { const f32x4 w = *(const LAS f32x4*)(WR + base * 1024 + 4 * lane + 256 * j); s += (h2[j].x * w.x + h2[j].y * w.y) + (h2[j].z * w.z + h2[j].w * w.w); }
        return s;
    } else {
        const float lo = rtree<L - 1>(WR, h2, base, lane), hh = rtree<L - 1>(WR, h2, base + (1 << (L - 1)), lane);
        const bool up = (lane & (1 << L)) != 0;
        return (up ? hh : lo) + __shfl_xor(up ? lo : hh, 1 << L);
    }
}
__device__ __forceinline__ void wave_sum2(float (&v)[2]) {
    const int lane = threadIdx.x & 63;
#define WS2_STEP(M) do { const float a = xchg_f<M>(v[0], lane), b = xchg_f<M>(v[1], lane); v[0] += a; v[1] += b; } while (0)
    WS2_STEP(1); WS2_STEP(2); WS2_STEP(4); WS2_STEP(8); WS2_STEP(16); WS2_STEP(32);
#undef WS2_STEP
}
#define RT_MASK(L) ((L) == 1 ? 1 : (L) == 2 ? 2 : (L) == 3 ? 32 : (L) == 4 ? 4 : 8)
__device__ __forceinline__ int router_expert(int lane) { return (lane & 3) | (((lane >> 5) & 1) << 2) | (((lane >> 2) & 3) << 3); }
template <int L> __device__ __forceinline__ f32x2 rtree2(const LAS float* WR, const f32x4 (&h2)[2][4], int base, int lane) {
    if constexpr (L == 0) { f32x2 a0 = {0.f, 0.f}, a1 = {0.f, 0.f};
#pragma unroll
        for (int j = 0; j < 4; ++j) { const f32x4 w = *(const LAS f32x4*)(WR + base * 1024 + 4 * lane + 256 * j);
            const f32x2 wl = {w.x, w.y}, wh = {w.z, w.w};
            a0 = __builtin_elementwise_fma((f32x2){h2[0][j].x, h2[0][j].y}, wl, a0); a0 = __builtin_elementwise_fma((f32x2){h2[0][j].z, h2[0][j].w}, wh, a0);
            a1 = __builtin_elementwise_fma((f32x2){h2[1][j].x, h2[1][j].y}, wl, a1); a1 = __builtin_elementwise_fma((f32x2){h2[1][j].z, h2[1][j].w}, wh, a1); }
        f32x2 s; s.x = a0.x + a0.y; s.y = a1.x + a1.y;
        return s;
    } else {
        const f32x2 lo = rtree2<L - 1>(WR, h2, base, lane), hh = rtree2<L - 1>(WR, h2, base + (1 << (L - 1)), lane);
        const bool up = (lane & RT_MASK(L)) != 0;
        f32x2 r; r.x = (up ? hh.x : lo.x) + xchg_f<RT_MASK(L)>(up ? lo.x : hh.x, lane); r.y = (up ? hh.y : lo.y) + xchg_f<RT_MASK(L)>(up ? lo.y : hh.y, lane);
        return r;
    }
}
__device__ __forceinline__ void p7_rows(Frame& F) {
    LAS float* WR = (LAS float*)F.lds;
    LAS int* lcnt = (LAS int*)(F.lds + TAB_OFF);
    LAS int* gbase = lcnt + 32;
    LAS int* rinfo = gbase + 32;
    const float* MODF = (const float*)(F.ws + WS_MODF);
    const int lane = F.lane, tid = F.tid;
    {
        f32x4 wv[16];
#pragma unroll
        for (int i = 0; i < 16; ++i) wv[i] = ((const f32x4*)(F.ws + WS_WRT))[tid + NTHR * i];
#pragma unroll
        for (int i = 0; i < 16; ++i) ((LAS f32x4*)WR)[tid + NTHR * i] = wv[i]; }
    for (int rb = F.vcu; rb < M / 64; rb += F.G) {
        const int b = (rb * 64) / SEQ;
        if (tid < 32) lcnt[tid] = 0;
        __syncthreads();
        LAS float* A7 = (LAS float*)(F.lds + TAB_OFF + 4096); LAS float* G2 = A7 + 1024; LAS float* S2 = G2 + 1024;
        for (int c0 = tid; c0 < 1024; c0 += NTHR) { A7[c0] = F.in[5][c0] * MODF[b * 6144 + 2048 + c0]; G2[c0] = F.in[6][c0] * (MODF[b * 6144 + 4096 + c0] + 1.0f); S2[c0] = MODF[b * 6144 + 3072 + c0]; }
        __syncthreads();
        u32x2 yw[2][2][4]; f32x4 xw[2][2][4];
        const int row0 = rb * 64 + F.wave * 8;
#pragma unroll
        for (int r = 0; r < 2; ++r) { const u32x2* yr = (const u32x2*)((const bf16*)(F.ws + WS_Y) + (size_t)(row0 + r) * 1024) + lane; const f32x4* xr = (const f32x4*)(F.in[0] + (size_t)(row0 + r) * 1024) + lane;
#pragma unroll
            for (int j = 0; j < 4; ++j) { yw[0][r][j] = yr[64 * j]; xw[0][r][j] = xr[64 * j]; } }
        const float brt = F.in[18][router_expert(lane)];
#pragma unroll
        for (int ip = 0; ip < 4; ++ip) {
            const int rl0 = F.wave * 8 + 2 * ip, rowp = rb * 64 + rl0;
            if (ip < 3) {
#pragma unroll
                for (int r = 0; r < 2; ++r) { const u32x2* yr = (const u32x2*)((const bf16*)(F.ws + WS_Y) + (size_t)(rowp + 2 + r) * 1024) + lane; const f32x4* xr = (const f32x4*)(F.in[0] + (size_t)(rowp + 2 + r) * 1024) + lane;
#pragma unroll
                    for (int j = 0; j < 4; ++j) { yw[(ip + 1) & 1][r][j] = yr[64 * j]; xw[(ip + 1) & 1][r][j] = xr[64 * j]; } } }
            f32x4 y[2][4], x1[2][4], h2[2][4]; float ss[2] = {0.f, 0.f};
#pragma unroll
            for (int r = 0; r < 2; ++r)
#pragma unroll
                for (int j = 0; j < 4; ++j) { const u32x2 w = yw[ip & 1][r][j]; y[r][j] = (f32x4){bf2f(w.x & 0xffffu), bf2f(w.x >> 16), bf2f(w.y & 0xffffu), bf2f(w.y >> 16)};
                    ss[r] += (y[r][j].x * y[r][j].x + y[r][j].y * y[r][j].y) + (y[r][j].z * y[r][j].z + y[r][j].w * y[r][j].w); }
            wave_sum2(ss);
            float s1[2] = {0.f, 0.f};
#pragma unroll
            for (int r = 0; r < 2; ++r) { const float rs = rsqrtf(ss[r] * (1.0f / 1024.0f) + EPS);
#pragma unroll
                for (int j = 0; j < 4; ++j) { x1[r][j] = xw[ip & 1][r][j] + *(const LAS f32x4*)(A7 + 4 * lane + 256 * j) * (y[r][j] * rs); s1[r] += (x1[r][j].x * x1[r][j].x + x1[r][j].y * x1[r][j].y) + (x1[r][j].z * x1[r][j].z + x1[r][j].w * x1[r][j].w);
                    { u32x2 w; w.x = pk2(x1[r][j].x, x1[r][j].y); w.y = pk2(x1[r][j].z, x1[r][j].w); ((u32x2*)((bf16*)(F.ws + WS_YMIX) + (size_t)(rowp + r) * 1024))[lane + 64 * j] = w; } } }
            wave_sum2(s1);
#pragma unroll
            for (int r = 0; r < 2; ++r) { const float rs1 = rsqrtf(s1[r] * (1.0f / 1024.0f) + EPS);
                unsigned* ho = (unsigned*)(F.ws + WS_H + (size_t)(rowp + r) * 1024) + lane;
#pragma unroll
                for (int j = 0; j < 4; ++j) { h2[r][j] = x1[r][j] * rs1 * *(const LAS f32x4*)(G2 + 4 * lane + 256 * j) + *(const LAS f32x4*)(S2 + 4 * lane + 256 * j); ho[64 * j] = pk4_fp8(h2[r][j].x, h2[r][j].y, h2[r][j].z, h2[r][j].w); } }
            f32x2 lg = rtree2<5>(WR, h2, 0, lane);
            lg.x += __shfl_xor(lg.x, 16); lg.y += __shfl_xor(lg.y, 16);
            lg.x += brt; lg.y += brt;
            const int e = router_expert(lane);
            float tvv[2][4]; int tee[2][4]; float cand0 = lg.x, cand1 = lg.y;
#define TOPK_STEP(MASK) do { const float ov0 = xchg_f<MASK>(v0, lane), ov1 = xchg_f<MASK>(v1, lane); const int oi0 = xchg_i<MASK>(i0, lane), oi1 = xchg_i<MASK>(i1, lane); \
                    if (ov0 > v0 || (ov0 == v0 && oi0 < i0)) { v0 = ov0; i0 = oi0; } if (ov1 > v1 || (ov1 == v1 && oi1 < i1)) { v1 = ov1; i1 = oi1; } } while (0)
#pragma unroll
            for (int k = 0; k < 4; ++k) { float v0 = cand0, v1 = cand1; int i0 = e, i1 = e;
                TOPK_STEP(1); TOPK_STEP(2); TOPK_STEP(32); TOPK_STEP(4); TOPK_STEP(8);
                tvv[0][k] = v0; tee[0][k] = i0; tvv[1][k] = v1; tee[1][k] = i1; if (e == i0) cand0 = -INFINITY; if (e == i1) cand1 = -INFINITY; }
#undef TOPK_STEP
#pragma unroll
            for (int r = 0; r < 2; ++r) { int te[4]; float tv[4];
#pragma unroll
                for (int k = 0; k < 4; ++k) { te[k] = tee[r][k]; tv[k] = tvv[r][k]; }
                const float e1 = __expf(tv[1] - tv[0]), e2 = __expf(tv[2] - tv[0]), e3 = __expf(tv[3] - tv[0]); const float inv = 1.0f / (1.0f + e1 + e2 + e3);
                if (lane < 4) { const int ek = lane == 0 ? te[0] : lane == 1 ? te[1] : lane == 2 ? te[2] : te[3]; const float gk = (lane == 0 ? 1.0f : lane == 1 ? e1 : lane == 2 ? e2 : e3) * inv;
                    const int lr = __hip_atomic_fetch_add(&lcnt[ek], 1, __ATOMIC_RELAXED, __HIP_MEMORY_SCOPE_WORKGROUP); const int rl = rl0 + r;
                    rinfo[(rl * 4 + lane) * 3 + 0] = ek; rinfo[(rl * 4 + lane) * 3 + 1] = lr; rinfo[(rl * 4 + lane) * 3 + 2] = __float_as_int(gk); } }
        }
        __syncthreads();
        if (tid < 32) gbase[tid] = (int)__hip_atomic_fetch_add(F.ctl + CW_CNT + 64 * tid, (unsigned)lcnt[tid], RLX_AGENT);
        __syncthreads();
        if (tid < 256) { const int rl = tid >> 2, k = tid & 3, row = rb * 64 + rl; const int ek = rinfo[tid * 3], rank = gbase[ek] + rinfo[tid * 3 + 1];
            ((int*)(F.ws + WS_TOKE))[row * 4 + k] = ek; ((int*)(F.ws + WS_TOKR))[row * 4 + k] = rank; ((int*)(F.ws + WS_TOKG))[row * 4 + k] = rinfo[tid * 3 + 2];
            ((int*)(F.ws + WS_ROWTOK))[(size_t)ek * ECAP + rank] = row; }
        __syncthreads();
    }
}

struct MoeTabs { LAS int* cnt; LAS int* tbase; LAS int* tile_e; LAS int* tile_r0; LAS int* idx; };
__device__ __forceinline__ MoeTabs moe_tabs(const Frame& F) { MoeTabs t; t.cnt = (LAS int*)(F.lds + TAB_OFF); t.tbase = t.cnt + 32; t.tile_e = t.tbase + 40; t.tile_r0 = t.tile_e + MAXT; t.idx = t.tile_r0 + MAXT; return t; }
__device__ __forceinline__ int moe_build_tabs(const Frame& F, const MoeTabs& T) {
    if (F.tid < 32) T.cnt[F.tid] = (int)__hip_atomic_load(F.ctl + CW_CNT + 64 * F.tid, RLX_AGENT);
    __syncthreads();
    if (F.tid < 32) { int s0 = 0, tot = 0;
#pragma unroll
        for (int e = 0; e < 32; ++e) { const int n = (T.cnt[e] + 255) >> 8; s0 += (e < F.tid) ? n : 0; tot += n; }
        T.tbase[F.tid] = s0; if (F.tid == 0) T.tbase[32] = tot;
        const int n = (T.cnt[F.tid] + 255) >> 8; for (int t = 0; t < n; ++t) { T.tile_e[s0 + t] = F.tid; T.tile_r0[s0 + t] = t * 256; } }
    __syncthreads();
    return T.tbase[32];
}
constexpr int MAXU = 12;
struct MoeUpSched {
    int NT, G, c; LAS const int* tile_e; LAS const int* idx;
    __device__ __forceinline__ bool next(int i, pg8::Unit& u) const { const int L = i * G + c; if (L >= NT * 8 || i >= MAXU) return false; u.pm = L >> 3; u.pn = L & 7; u.e = tile_e[u.pm]; u.ui = i; return true; }
    __device__ __forceinline__ unsigned arow(const pg8::Unit& u, int r) const { return (unsigned)idx[u.ui * 256 + r]; }
    __device__ __forceinline__ size_t boff(const pg8::Unit& u) const { return ((size_t)u.e * 2048 + (size_t)u.pn * 256) * 1024; }
};
struct MoeDownSched {
    int NT, G, c; LAS const int* tile_e;
    __device__ __forceinline__ bool next(int i, pg8::Unit& u) const { const int L = i * G + c; if (L >= NT * 4) return false; u.pm = L >> 2; u.pn = L & 3; u.e = tile_e[u.pm]; u.ui = i; return true; }
    __device__ __forceinline__ unsigned arow(const pg8::Unit& u, int r) const { return (unsigned)(u.pm * 256 + r); }
    __device__ __forceinline__ size_t boff(const pg8::Unit& u) const { return ((size_t)u.e * 1024 + (size_t)u.pn * 256) * 1024; }
};

__device__ __forceinline__ void p11_final(Frame& F, float* dstp) {
    const MoeTabs T = moe_tabs(F); (void)moe_build_tabs(F, T);
    const float* MODF = (const float*)(F.ws + WS_MODF); const int lane = F.lane;
    const unsigned char* YB = F.ws + WS_YB;
    for (int rb = F.vcu; rb < M / 64; rb += F.G) {
        const int b = (rb * 64) / SEQ;
        LAS float* A9 = (LAS float*)(F.lds + TAB_OFF + 16384);
        __syncthreads();
        for (int c0 = F.tid; c0 < 1024; c0 += NTHR) A9[c0] = F.in[7][c0] * MODF[b * 6144 + 5120 + c0];
        __syncthreads();
        const int row0 = rb * 64 + F.wave * 8;
        unsigned myoff = 0u; float mygate = 0.f;
        if (lane < 32) { const int e = ((const int*)(F.ws + WS_TOKE))[row0 * 4 + lane], r = ((const int*)(F.ws + WS_TOKR))[row0 * 4 + lane]; mygate = ((const float*)(F.ws + WS_TOKG))[row0 * 4 + lane];
            myoff = (unsigned)(T.tbase[e] * 256 + r) * 1024u; mygate *= 1.0f / YB_SCALE; }
        u32x4 yw[3][4]; u32x4 xw[3][2];
#define P10_ISSUE(i_, s_) do { \
            _Pragma("unroll") for (int k = 0; k < 4; ++k) { const unsigned off = (unsigned)__builtin_amdgcn_readlane((int)myoff, (i_) * 4 + k); yw[s_][k] = ((const u32x4*)(YB + off))[lane]; } \
            { const u32x4* xr = (const u32x4*)((const bf16*)(F.ws + WS_YMIX) + (size_t)(row0 + (i_)) * 1024) + 2 * lane; xw[s_][0] = xr[0]; xw[s_][1] = xr[1]; } } while (0)
        P10_ISSUE(0, 0); P10_ISSUE(1, 1);
#pragma unroll
        for (int i = 0; i < 8; ++i) {
            const int row = row0 + i, sl = i % 3;
            if (i + 2 < 8) P10_ISSUE(i + 2, (i + 2) % 3);
            float gk[4];
#pragma unroll
            for (int k = 0; k < 4; ++k) gk[k] = __int_as_float(__builtin_amdgcn_readlane(__float_as_int(mygate), i * 4 + k));
            f32x4 y[4];
#pragma unroll
            for (int j = 0; j < 4; ++j) y[j] = (f32x4){0.f, 0.f, 0.f, 0.f};
#pragma unroll
            for (int k = 0; k < 4; ++k)
#pragma unroll
                for (int q = 0; q < 4; ++q) { const int w = (int)yw[sl][k][q];
                    const f32x2 lo = __builtin_amdgcn_cvt_pk_f32_fp8(w, false), hh = __builtin_amdgcn_cvt_pk_f32_fp8(w, true);
                    y[q] += (f32x4){lo.x, lo.y, hh.x, hh.y} * gk[k]; }
            float ss = 0.f;
#pragma unroll
            for (int j = 0; j < 4; ++j) ss += (y[j].x * y[j].x + y[j].y * y[j].y) + (y[j].z * y[j].z + y[j].w * y[j].w);
            const float rs = rsqrtf(wave_sum(ss) * (1.0f / 1024.0f) + EPS);
            f32x4* orow = (f32x4*)(dstp + (size_t)row * 1024) + 4 * lane; const LAS f32x4* a9 = (const LAS f32x4*)(A9 + 16 * lane);
#pragma unroll
            for (int q = 0; q < 4; ++q) { const unsigned w0 = xw[sl][q >> 1][2 * (q & 1)], w1 = xw[sl][q >> 1][2 * (q & 1) + 1];
                orow[q] = (f32x4){bf2f(w0 & 0xffffu), bf2f(w0 >> 16), bf2f(w1 & 0xffffu), bf2f(w1 >> 16)} + a9[q] * (y[q] * rs); }
        }
#undef P10_ISSUE
    }
}

#ifndef MLSTM_FUSED
#define MLSTM_FUSED 0
#endif
__device__ __forceinline__ void mlstm_fused(Frame& F, int b, int h, int eh) {
    const int tid = F.tid, lane = F.lane, r32 = lane & 31, hi = lane >> 5, wid = F.wave;
    LAS bf16* Qs = (LAS bf16*)F.lds;
    LAS bf16* Qp = Qs + 64 * QS_STRIDE;
    LAS bf16* Ks = Qp + 64 * QS_STRIDE;
    LAS bf16* KT = Ks + 64 * QS_STRIDE;
    LAS bf16* VT = KT + 128 * KT_STRIDE;
    LAS bf16* VwT = VT + 64 * KT_STRIDE;
    LAS bf16* CT = VwT + 64 * KT_STRIDE;
    LAS bf16* Wm = CT + 64 * QS_STRIDE;
    LAS float* fu = (LAS float*)(Wm + 64 * KT_STRIDE);
    LAS float* fmm = fu + 64; LAS float* fiw = fu + 128; LAS float* ffl = fu + 192; LAS float* frd = fu + 256; LAS float* fwx = fu + 320; LAS float* fnp = fu + 384; LAS float* ms = fu + 512;
    const bf16* Z = (const bf16*)(F.ws + WS_Z);
    bf16* Y = (bf16*)(F.ws + WS_YMIX);
    const int e0 = eh * 64;
    for (int i = tid; i < 64 * QS_STRIDE; i += NTHR) CT[i] = 0;
    if (tid < 128) fnp[tid] = 0.f;
    if (tid == 0) ms[0] = -INFINITY;
    f32x16 st = {};
    ConvRaw rq[2], rk[2]; bf16x8 rv; unsigned short og[16]; unsigned short gi_raw = 0, gf_raw = 0;
#define MF_PREFETCH(c_) do { \
        _Pragma("unroll") for (int rep = 0; rep < 2; ++rep) { const int task = tid + NTHR * rep, l = task >> 4, ch = task & 15, t = (c_) * 64 + l; \
            conv8_load(F, b, t, ZC_QM + h * 128 + ch * 8, rq[rep]); conv8_load(F, b, t, ZC_KM + h * 128 + ch * 8, rk[rep]); } \
        { const int l = tid >> 3, chv = tid & 7; rv = *(const bf16x8*)(Z + (size_t)(b * SEQ + (c_) * 64 + l) * ZP + ZC_VM + h * 128 + e0 + chv * 8); } \
        if (wid < 4) { _Pragma("unroll") for (int r = 0; r < 16; ++r) { const int l = (wid & 1) * 32 + crow(r, hi); og[r] = Z[(size_t)(b * SEQ + (c_) * 64 + l) * ZP + ZC_OM + h * 128 + e0 + (wid >> 1) * 32 + r32]; } } \
        if (wid == 0) { const size_t zr_ = (size_t)(b * SEQ + (c_) * 64 + lane) * ZP; gi_raw = Z[zr_ + ZC_IG + h]; gf_raw = Z[zr_ + ZC_FG + h]; } } while (0)
    MF_PREFETCH(0);
    __syncthreads();
    for (int c = 0; c < 64; ++c) {
        if (wid == 0) {
            const float ig = bf2f(gi_raw) + F.in[9][h]; float g = logsigmoidf_(bf2f(gf_raw) + F.in[9][4 + h]);
#pragma unroll
            for (int o = 1; o < 64; o <<= 1) { const float t = __shfl_up(g, o); if (lane >= o) g += t; }
            const float u = ig - g; float pm = u;
#pragma unroll
            for (int o = 1; o < 64; o <<= 1) { const float t = __shfl_up(pm, o); if (lane >= o) pm = fmaxf(pm, t); }
            const float G = __shfl(g, 63), wl = G - g + ig, ml = wave_max(wl);
            const float m_old = ms[0], mm = fmaxf(m_old, pm), m_new = fmaxf(G + m_old, ml);
            fu[lane] = u; fmm[lane] = mm; fiw[lane] = __expf(m_old - mm); ffl[lane] = __expf(-(g + mm)); fwx[lane] = __expf(wl - m_new);
            if (lane == 0) { ms[1] = __expf(G + m_old - m_new); ms[2] = m_new; }
        }
        __syncthreads();
#pragma unroll
        for (int rep = 0; rep < 2; ++rep) { const int task = tid + NTHR * rep, l = task >> 4, ch = task & 15;
            float qq[8], kk[8];
            conv8_calc(F, rq[rep], h * 128 + ch * 8, qq); conv8_calc(F, rk[rep], 512 + h * 128 + ch * 8, kk);
            const float iw = fiw[l], sk = 0.08838834764831845f;
            u32x4 wq, wp, wk;
            wq.x = pk2(qq[0], qq[1]); wq.y = pk2(qq[2], qq[3]); wq.z = pk2(qq[4], qq[5]); wq.w = pk2(qq[6], qq[7]);
            wp.x = pk2(qq[0] * iw, qq[1] * iw); wp.y = pk2(qq[2] * iw, qq[3] * iw); wp.z = pk2(qq[4] * iw, qq[5] * iw); wp.w = pk2(qq[6] * iw, qq[7] * iw);
            wk.x = pk2(kk[0] * sk, kk[1] * sk); wk.y = pk2(kk[2] * sk, kk[3] * sk); wk.z = pk2(kk[4] * sk, kk[5] * sk); wk.w = pk2(kk[6] * sk, kk[7] * sk);
            *(LAS u32x4*)(Qs + l * QS_STRIDE + ch * 8) = wq; *(LAS u32x4*)(Qp + l * QS_STRIDE + ch * 8) = wp; *(LAS u32x4*)(Ks + l * QS_STRIDE + ch * 8) = wk;
#pragma unroll
            for (int j = 0; j < 8; ++j) KT[(ch * 8 + j) * KT_STRIDE + l] = (bf16)f2bf(kk[j] * sk); }
        { const int l = tid >> 3, chv = tid & 7; const float we = fwx[l];
#pragma unroll
            for (int j = 0; j < 8; ++j) { VT[(chv * 8 + j) * KT_STRIDE + l] = (bf16)rv[j]; VwT[(chv * 8 + j) * KT_STRIDE + l] = (bf16)f2bf(bf2f((unsigned short)rv[j]) * we); } }
        unsigned short ogc[16];
#pragma unroll
        for (int r = 0; r < 16; ++r) ogc[r] = og[r];
        if (c + 1 < 64) MF_PREFETCH(c + 1);
        __syncthreads();
        if (wid < 4) {
            const int lt = wid >> 1, stl = wid & 1;
            f32x16 acc = {}; acc = mma32_lds(Qs + lt * 32 * QS_STRIDE, QS_STRIDE, Ks + stl * 32 * QS_STRIDE, QS_STRIDE, 8, r32, hi, acc);
            const int s_ = stl * 32 + r32; const float us = fu[s_];
#pragma unroll
            for (int r = 0; r < 16; ++r) { const int l = lt * 32 + crow(r, hi); const float w = (s_ <= l) ? __expf(us - fmm[l]) * acc[r] : 0.f; Wm[l * KT_STRIDE + s_] = (bf16)f2bf(w); }
        }
        __syncthreads();
        if (tid < 64) { float dsum = 0.f;
#pragma unroll 8
            for (int s_ = 0; s_ < 64; ++s_) dsum += bf2f(Wm[tid * KT_STRIDE + s_]);
#pragma unroll 8
            for (int d = 0; d < 128; ++d) dsum += bf2f(Qp[tid * QS_STRIDE + d]) * fnp[d];
            frd[tid] = 1.0f / fmaxf(fabsf(dsum), ffl[tid]); }
        f32x16 num = {};
        if (wid < 4) { const int lt = wid & 1, et = wid >> 1;
            num = mma32_lds(Wm + lt * 32 * KT_STRIDE, KT_STRIDE, VT + et * 32 * KT_STRIDE, KT_STRIDE, 4, r32, hi, num);
            num = mma32_lds(Qp + lt * 32 * QS_STRIDE, QS_STRIDE, CT + et * 32 * QS_STRIDE, QS_STRIDE, 8, r32, hi, num); }
        { const float a = ms[1];
#pragma unroll
            for (int r = 0; r < 16; ++r) st[r] *= a;
            st = mma32_lds(VwT + (wid & 1) * 32 * KT_STRIDE, KT_STRIDE, KT + (wid >> 1) * 32 * KT_STRIDE, KT_STRIDE, 4, r32, hi, st); }
        __syncthreads();
        if (wid < 4) { const int lt = wid & 1, et = wid >> 1, e = e0 + et * 32 + r32;
#pragma unroll
            for (int r = 0; r < 16; ++r) { const int l = lt * 32 + crow(r, hi); const size_t row = (size_t)(b * SEQ + c * 64 + l);
                Y[row * 1024 + h * 128 + e] = (bf16)f2bf(num[r] * frd[l] * sigmoidf_(bf2f(ogc[r]))); } }
#pragma unroll
        for (int r = 0; r < 16; ++r) CT[((wid & 1) * 32 + crow(r, hi)) * QS_STRIDE + (wid >> 1) * 32 + r32] = (bf16)f2bf(st[r]);
        if (tid >= 256 && tid < 384) { const int d = tid - 256; float s_ = 0.f;
#pragma unroll 8
            for (int l = 0; l < 64; ++l) s_ += fwx[l] * bf2f(KT[d * KT_STRIDE + l]);
            fnp[d] = ms[1] * fnp[d] + s_; }
        __syncthreads();
        if (tid == 0) ms[0] = ms[2];
    }
    __syncthreads();
#undef MF_PREFETCH
}

__device__ __forceinline__ void ph2_zgemm(Frame& F) {
    unsigned char* ws = F.ws;
    pg8::StaticSched S; S.init(M, ZP, 1024, F.G, (int)blockIdx.x);
    pg8::EpiBf16 E{(bf16*)(ws + WS_Z), ZP, nullptr, 0};
    pg8::gemm_phase<false>(F.lds, (const bf16*)(ws + WS_H), (const bf16*)(ws + WS_WIN), 1024, S, E);
}
__device__ __forceinline__ void ph3_local(Frame& F) {
#if !MLSTM_FUSED
    p3_mlstm_a_items(F);
#else
    for (int wi = F.vcu; wi < 256; wi += F.G) p3_compress_item(F, wi);
#endif
}
#ifndef ATT_PROBE
#define ATT_PROBE -1
#endif
constexpr int CW_AQ = 20480;
__device__ __forceinline__ void ph4_scan_attn(Frame& F) {
#if MLSTM_FUSED
    if (F.vcu < 32) mlstm_fused(F, F.vcu >> 3, (F.vcu >> 1) & 3, F.vcu & 1);
    volatile LAS unsigned* qslot = (volatile LAS unsigned*)(F.lds + LDSCTL_OFF + 512);
    for (;;) {
        __syncthreads();
        if (F.tid == 0) qslot[0] = __hip_atomic_fetch_add(F.ctl + CW_AQ, 1u, RLX_AGENT);
        __syncthreads();
        const int q = (int)qslot[0];
        if (q >= 512) break;
        const int cur = 63 - (q >> 3), bg = q & 7;
        nsa::attn_unit<0>(F, bg >> 1, bg & 1, cur, (bf16*)(F.ws + WS_YMIX), true);
    }
#else
    p4_scan(F); __syncthreads();
    if (ATT_PROBE >= 0) { nsa::p4_attention<(ATT_PROBE < 0 ? 0 : ATT_PROBE)>(F, (bf16*)(F.ws + WS_ACT)); __syncthreads(); }
    nsa::p4_attention<0>(F, (bf16*)(F.ws + WS_YMIX));
#endif
}
__device__ __forceinline__ void ph5_mlstm_out(Frame& F) {
#if !MLSTM_FUSED
    p5_mlstm_c_items(F);
#endif
}
__device__ __forceinline__ void ph6_wout(Frame& F) {
    unsigned char* ws = F.ws;
    pg8::StaticSched S; S.init(M, 1024, 1024, F.G, (int)blockIdx.x);
    pg8::EpiBf16 E{(bf16*)(ws + WS_Y), 1024, nullptr, 0};
    pg8::gemm_phase<false>(F.lds, (const bf16*)(ws + WS_YMIX), (const bf16*)(ws + WS_WOUT), 1024, S, E);
}
__device__ __forceinline__ void ph8_up(Frame& F) {
    unsigned char* ws = F.ws;
    const MoeTabs T = moe_tabs(F); const int NT = moe_build_tabs(F, T);
    const int* rowtok = (const int*)(ws + WS_ROWTOK);
    for (int i = 0; i < MAXU; ++i) { const int L = i * F.G + F.vcu; if (L >= NT * 8) break; const int t = L >> 3, e = T.tile_e[t], r0 = T.tile_r0[t];
        for (int r = F.tid; r < 256; r += NTHR) { const int gi = r0 + r; T.idx[i * 256 + r] = gi < T.cnt[e] ? rowtok[(size_t)e * ECAP + gi] : 0; } }
    __syncthreads();
    MoeUpSched S{NT, F.G, F.vcu, T.tile_e, T.idx};
    pg8::EpiSwiglu E{(unsigned char*)(ws + WS_ACT), F.in[20]};
    pg8::gemm_phase<true>(F.lds, (const bf16*)(ws + WS_H), (const bf16*)(ws + WS_WUP), 512, S, E);
}
__device__ __forceinline__ void ph9_down(Frame& F) {
    unsigned char* ws = F.ws;
    const MoeTabs T = moe_tabs(F); const int NT = moe_build_tabs(F, T);
    MoeDownSched S{NT, F.G, F.vcu, T.tile_e};
    pg8::EpiFp8 E{ws + WS_YB, 1024, F.in[22], 1024, YB_SCALE};
    pg8::gemm_phase<true>(F.lds, (const bf16*)(ws + WS_ACT), (const bf16*)(ws + WS_WDN), 512, S, E);
}

constexpr int N_PHASES = 11;
struct Args { const float* in[23]; float* out; unsigned char* ws; int ph_lo, ph_hi; };
__global__ void __launch_bounds__(NTHR, 2) hybrid_fwd(Args args) {
    extern __shared__ __attribute__((aligned(16))) unsigned char lds_raw[];
    Frame F;
    F.lds = (LAS unsigned char*)lds_raw;
    F.tid = threadIdx.x; F.lane = F.tid & 63; F.wave = __builtin_amdgcn_readfirstlane(F.tid >> 6);
    F.G = gridDim.x; { const int bx = blockIdx.x; F.vcu = (F.G % 8 == 0) ? (bx % 8) * (F.G / 8) + bx / 8 : bx; }
    F.ws = args.ws; F.ctl = (unsigned*)(args.ws + WS_CTL); F.out = args.out;
    F.in = (const float* const __attribute__((address_space(4)))*)__builtin_amdgcn_kernarg_segment_ptr();
    for (int u = F.tid; u < (LDS_BYTES - LDSCTL_OFF) / 4; u += NTHR) ((LAS unsigned*)(F.lds + LDSCTL_OFF))[u] = 0u;
    __syncthreads();
    volatile LAS unsigned* MISC = (volatile LAS unsigned*)(F.lds + MISC_OFF);
    XcdBarrier bar; bar.bar = F.ctl + CW_BAR; bar.x = 0; bar.st = nullptr;
    if (!MK_PER_PHASE) bar = xcd_barrier_post(F.ctl + CW_BAR, MISC + 8);
    const int lo = args.ph_lo, hi = args.ph_hi;
#ifndef PH_MASK
#define PH_MASK 0x7ff
#endif
#define IN(k) (((PH_MASK >> (k)) & 1) && lo <= (k) && (k) < hi)
#define SEAM(k) do { if (IN(k) && IN((k) + 1)) xcd_barrier(bar); } while (0)
#ifndef PH_TWICE
#define PH_TWICE 0
#endif
#define RUNPH(k, call) do { if (IN(k)) { call; if ((PH_TWICE >> (k)) & 1) { xcd_barrier(bar); call; } } } while (0)
    RUNPH(0, p0_prologue(F)); SEAM(0);
    RUNPH(1, p1_rows(F)); SEAM(1);
    RUNPH(2, ph2_zgemm(F)); SEAM(2);
    RUNPH(3, ph3_local(F)); SEAM(3);
    RUNPH(4, ph4_scan_attn(F));
#if !MLSTM_FUSED
    SEAM(4);
#endif
    RUNPH(5, ph5_mlstm_out(F)); SEAM(5);
    RUNPH(6, ph6_wout(F)); SEAM(6);
    RUNPH(7, p7_rows(F)); SEAM(7);
    RUNPH(8, ph8_up(F)); SEAM(8);
    RUNPH(9, ph9_down(F)); SEAM(9);
#ifdef P10_TWICE
    if (IN(10)) { p11_final(F, (float*)(F.ws + WS_DC)); xcd_barrier(bar); }
#endif
    RUNPH(10, p11_final(F, F.out));
#ifdef EXTRA_BARS
#pragma unroll 1
    for (int eb = 0; eb < EXTRA_BARS; ++eb) xcd_barrier(bar);
#endif
#undef RUNPH
#undef IN
#undef SEAM
}

extern "C" void kernel_launch(void* const* d_in, const int* in_sizes, int n_in, void* d_out, int out_size, void* d_ws, size_t ws_size, hipStream_t stream) {
    static int grid = 0;
    if (grid == 0) {
        if (n_in != 23 || out_size != M * D || ws_size < WS_END) { fprintf(stderr, "kernel_launch: unexpected shapes (n_in %d out %d ws %zu)\n", n_in, out_size, ws_size); grid = -1; return; }
        int dev = 0, cus = 0;
        if (hipGetDevice(&dev) != hipSuccess || hipDeviceGetAttribute(&cus, hipDeviceAttributeMultiprocessorCount, dev) != hipSuccess) { grid = -1; return; }
        if (hipFuncSetAttribute((const void*)hybrid_fwd, hipFuncAttributeMaxDynamicSharedMemorySize, LDS_BYTES) != hipSuccess) { fprintf(stderr, "kernel_launch: hipFuncSetAttribute failed\n"); grid = -1; return; }
        int per_cu = 0;
        if (hipOccupancyMaxActiveBlocksPerMultiprocessor(&per_cu, (const void*)hybrid_fwd, NTHR, LDS_BYTES) != hipSuccess || per_cu < 1) fprintf(stderr, "kernel_launch: occupancy query reports %d\n", per_cu);
        (void)hipGetLastError();
        grid = cus > 256 ? 256 : cus;
    }
    if (grid < 0) return;
    (void)hipMemsetAsync((char*)d_ws + WS_CTL, 0, CTL_ZERO_BYTES, stream);
    Args a{};
    for (int i = 0; i < 23; ++i) a.in[i] = (const float*)d_in[i];
    a.out = (float*)d_out; a.ws = (unsigned char*)d_ws;
#if MK_PER_PHASE
    for (int p = 0; p < N_PHASES; ++p) { a.ph_lo = p; a.ph_hi = p + 1; hipLaunchKernelGGL(hybrid_fwd, dim3(grid), dim3(NTHR), LDS_BYTES, stream, a); }
#else
    a.ph_lo = 0; a.ph_hi = N_PHASES;
    hipLaunchKernelGGL(hybrid_fwd, dim3(grid), dim3(NTHR), LDS_BYTES, stream, a);
#endif
}
```
